# Optimizing an MI355X kernel written in HIP

```python
import math
import jax
import jax.numpy as jnp
from jax import lax
import numpy as np

D_MODEL = 1024
BATCH = 32
SEQ = 256
DEPTH = 2
DEC_BATCH = 8
DEC_SEQ = 1024
PAST_LEN = 256

GRID_W = 64
HEAD_DIM = 64
ROPE_BASE = 10000.0
EPS = 1e-6
GN_EPS = 1e-5
RET_HEADS = 8
RET_DK = 64
RET_DV = 128
RET_CHUNK = 128
GQA_HEADS = 8
GQA_KV_HEADS = 2
Q_BLOCK = 128
NA_HEADS = 16
NA_KH = 8
NA_KW = 16
NA_WIDTH = NA_HEADS * HEAD_DIM
D_FF = 2816
CONV_WIDTH = 3
N_EVEN = (DEPTH + 1) // 2
N_ODD = DEPTH // 2
EVEN_SPLITS = (RET_HEADS * RET_DK, RET_HEADS * RET_DK, RET_HEADS * RET_DV, RET_HEADS * RET_DV,
               GQA_HEADS * HEAD_DIM, GQA_KV_HEADS * HEAD_DIM, GQA_KV_HEADS * HEAD_DIM)
EVEN_IN = 3840
EVEN_OUT_IN = 1536

kernel_name = 'hybrid_diffusion_retention_gqa_natten_step'

F32 = jnp.float32


def rms_norm(x, g):
    x32 = x.astype(F32)
    y = x32 * lax.rsqrt(jnp.mean(x32 * x32, axis=-1, keepdims=True) + EPS)
    return (y * g.astype(F32)).astype(x.dtype)


def to_heads(x, n, d):
    b, t, _ = x.shape
    return x.reshape(b, t, n, d).transpose(0, 2, 1, 3)


def from_heads(x):
    b, h, t, d = x.shape
    return x.transpose(0, 2, 1, 3).reshape(b, t, h * d)


def axial_angles(n, head_dim):
    t = jnp.arange(n)
    row = (t // GRID_W).astype(F32)
    col = (t % GRID_W).astype(F32)
    half = head_dim // 2
    inv = ROPE_BASE ** (-jnp.arange(0, half, 2, dtype=F32) / half)
    return row[:, None] * inv, col[:, None] * inv


def _rotate(x, ang):
    x1, x2 = jnp.split(x, 2, axis=-1)
    cos = jnp.cos(ang).astype(x.dtype)
    sin = jnp.sin(ang).astype(x.dtype)
    return jnp.concatenate([x1 * cos - x2 * sin, x2 * cos + x1 * sin], axis=-1)


def apply_axial_rope(x, ang):
    ang_r, ang_c = ang
    half = x.shape[-1] // 2
    return jnp.concatenate([_rotate(x[..., :half], ang_r), _rotate(x[..., half:], ang_c)], axis=-1)


def retention_chunkwise(q, k, v, decay_logit, s0):
    b, h, n, _ = q.shape
    dv = v.shape[-1]
    c = RET_CHUNK
    nc = n // c
    log_g = jax.nn.log_sigmoid(decay_logit.astype(F32))
    pos = jnp.arange(c, dtype=F32)
    diff = pos[:, None] - pos[None, :]
    inner_decay = jnp.where(diff >= 0, jnp.exp(log_g[:, None, None] * jnp.maximum(diff, 0.0)),
                            0.0).astype(q.dtype)
    q_decay = jnp.exp(log_g[:, None] * (pos + 1.0))[..., None].astype(q.dtype)
    k_decay = jnp.exp(log_g[:, None] * (c - 1.0 - pos))[..., None].astype(q.dtype)
    chunk_decay = jnp.exp(log_g * c)[:, None, None].astype(q.dtype)

    def chunks(x):
        return x.reshape(b, h, nc, c, x.shape[-1]).transpose(2, 0, 1, 3, 4)

    def step(s, inp):
        qc, kc, vc = inp
        scores = jnp.einsum('bhid,bhjd->bhij', qc, kc) * inner_decay
        o = (jnp.einsum('bhij,bhje->bhie', scores, vc)
             + jnp.einsum('bhid,bhde->bhie', qc * q_decay, s))
        s = s * chunk_decay + jnp.einsum('bhjd,bhje->bhde', kc * k_decay, vc)
        return s, o

    s_fin, o = lax.scan(step, s0.astype(q.dtype), (chunks(q), chunks(k), chunks(v)))
    return o.transpose(1, 2, 0, 3, 4).reshape(b, h, n, dv), s_fin


def retention_group_norm(o, gain):
    o32 = o.astype(F32)
    mu = jnp.mean(o32, axis=-1, keepdims=True)
    var = jnp.mean(jnp.square(o32 - mu), axis=-1, keepdims=True)
    y = (o32 - mu) * lax.rsqrt(var + GN_EPS)
    return (from_heads(y) * gain.astype(F32)).astype(o.dtype)


def attention_blocked(q, k, v):
    b, h, n, d = q.shape
    kv = k.shape[1]
    g = h // kv
    nb = n // Q_BLOCK
    qb = q.reshape(b, kv, g, nb, Q_BLOCK, d).transpose(3, 0, 1, 2, 4, 5)
    scale = d ** -0.5

    def block(qi):
        s = jnp.einsum('bkgqd,bkmd->bkgqm', qi, k).astype(F32) * scale
        p = jax.nn.softmax(s, axis=-1).astype(v.dtype)
        return jnp.einsum('bkgqm,bkmd->bkgqd', p, v)

    o = lax.map(block, qb)
    return o.transpose(1, 2, 3, 0, 4, 5).reshape(b, h, n, d)


def na_tables(rows):
    kh = min(NA_KH, rows)
    kw = NA_KW
    r = np.arange(rows)
    cidx = np.arange(GRID_W)
    rs = np.clip(r - kh // 2, 0, rows - kh)
    cs = np.clip(cidx - kw // 2, 0, GRID_W - kw)
    key_r = rs[:, None] + np.arange(kh)
    key_c = cs[:, None] + np.arange(kw)
    idx = (key_r[:, None, :, None] * GRID_W + key_c[None, :, None, :]).reshape(rows, GRID_W, kh * kw)
    rel_r = key_r - r[:, None] + NA_KH - 1
    rel_c = key_c - cidx[:, None] + NA_KW - 1
    return (jnp.asarray(idx, jnp.int32), jnp.asarray(rel_r, jnp.int32), jnp.asarray(rel_c, jnp.int32))


def neighbourhood_attention(q, k, v, ctx_k, ctx_v, rpb):
    b, h, n, d = q.shape
    rows = n // GRID_W
    idx, rel_r, rel_c = na_tables(rows)
    n_win = idx.shape[-1]
    scale = d ** -0.5
    q_rows = q.reshape(b, h, rows, GRID_W, d).transpose(2, 0, 1, 3, 4)

    def row_block(inp):
        qi, idx_i, rel_r_i = inp
        kg = jnp.take(k, idx_i, axis=2)
        vg = jnp.take(v, idx_i, axis=2)
        bias = rpb[:, rel_r_i[None, :, None], rel_c[:, None, :]].reshape(h, GRID_W, n_win)
        s_win = jnp.einsum('bhwd,bhwkd->bhwk', qi, kg).astype(F32) * scale + bias.astype(F32)
        s_ctx = jnp.einsum('bhwd,bhmd->bhwm', qi, ctx_k).astype(F32) * scale
        p = jax.nn.softmax(jnp.concatenate([s_win, s_ctx], axis=-1), axis=-1).astype(v.dtype)
        return (jnp.einsum('bhwk,bhwkd->bhwd', p[..., :n_win], vg)
                + jnp.einsum('bhwm,bhmd->bhwd', p[..., n_win:], ctx_v))

    o = lax.map(row_block, (q_rows, idx, rel_r))
    return o.transpose(1, 2, 0, 3, 4).reshape(b, h, n, d)


def even_mixer(h, w_in, w_out, decay_f, decay_b, gn, q_gain, k_gain, s0_f, s0_b, ctx_k, ctx_v, ang):
    split_idx = [int(i) for i in np.cumsum(EVEN_SPLITS)[:-1]]
    qr, kr, vr, gr, qa, ka, va = jnp.split(h @ w_in, split_idx, axis=-1)
    qr = to_heads(qr, RET_HEADS, RET_DK)
    kr = to_heads(kr, RET_HEADS, RET_DK) * (RET_DK ** -0.5)
    vr = to_heads(vr, RET_HEADS, RET_DV)
    qa = rms_norm(to_heads(qa, GQA_HEADS, HEAD_DIM), q_gain)
    ka = rms_norm(to_heads(ka, GQA_KV_HEADS, HEAD_DIM), k_gain)
    va = to_heads(va, GQA_KV_HEADS, HEAD_DIM)
    if ang is None:
        keys, vals = ka, va
    else:
        qr = apply_axial_rope(qr, ang)
        kr = apply_axial_rope(kr, ang)
        qa = apply_axial_rope(qa, ang)
        keys = jnp.concatenate([apply_axial_rope(ka, ang), ctx_k], axis=2)
        vals = jnp.concatenate([va, ctx_v], axis=2)
    o_f, s_f = retention_chunkwise(qr, kr, vr, decay_f, s0_f)
    o_b, s_b = retention_chunkwise(qr[:, :, ::-1], kr[:, :, ::-1], vr[:, :, ::-1], decay_b, s0_b)
    ret = retention_group_norm(o_f + o_b[:, :, ::-1], gn) * jax.nn.silu(gr)
    att = from_heads(attention_blocked(qa, keys, vals))
    out = jnp.concatenate([ret, att], axis=-1) @ w_out
    return out, s_f, s_b, ka, va


def odd_mixer(h, w_in, w_out, rpb, ctx_k, ctx_v):
    q, k, v = jnp.split(h @ w_in, 3, axis=-1)
    q = to_heads(q, NA_HEADS, HEAD_DIM)
    k = to_heads(k, NA_HEADS, HEAD_DIM)
    v = to_heads(v, NA_HEADS, HEAD_DIM)
    if ctx_k is None:
        o = attention_blocked(q, k, v)
    else:
        o = neighbourhood_attention(q, k, v, ctx_k, ctx_v, rpb)
    return from_heads(o) @ w_out, k, v


def conv_ffn(h, w_up, conv_w, conv_b, w_down):
    u = h @ w_up
    up = jnp.pad(u, ((0, 0), (1, 1), (0, 0)))
    u = up[:, :-2] * conv_w[0] + up[:, 1:-1] * conv_w[1] + up[:, 2:] * conv_w[2] + conv_b
    a, g = jnp.split(u, 2, axis=-1)
    return (jax.nn.silu(a) * g) @ w_down


def ada_params(cond, w, b):
    m = jax.nn.silu(cond) @ w + b
    return jnp.split(m[:, None, :], 6, axis=-1)


def setup_inputs(seed: int = 0) -> dict:
    key = jax.random.key(seed)
    ks = iter(jax.random.split(key, 40))

    def nrm(shape, scale):
        return jax.random.normal(next(ks), shape, F32) * scale

    def gain(shape):
        return 1.0 + nrm(shape, 0.05)

    gam = 1.0 - 2.0 ** (-5.0 - jnp.arange(RET_HEADS, dtype=F32))
    decay_logit = jnp.log(gam) - jnp.log(1.0 - gam)
    conv_base = jnp.array([0.25, 0.5, 0.25], F32)[:, None]
    return {
        'x_prompt': nrm((BATCH, SEQ, D_MODEL), 1.0),
        'x_sample': nrm((DEC_BATCH, DEC_SEQ, D_MODEL), 1.0),
        'state_ret_fwd': nrm((DEC_BATCH, N_EVEN, RET_HEADS, RET_DK, RET_DV), 0.5),
        'state_ret_bwd': nrm((DEC_BATCH, N_EVEN, RET_HEADS, RET_DK, RET_DV), 0.5),
        'cache_gqa_k': nrm((DEC_BATCH, N_EVEN, GQA_KV_HEADS, PAST_LEN, HEAD_DIM), 1.0),
        'cache_gqa_v': nrm((DEC_BATCH, N_EVEN, GQA_KV_HEADS, PAST_LEN, HEAD_DIM), 1.0),
        'cache_na_k': nrm((DEC_BATCH, N_ODD, NA_HEADS, PAST_LEN, HEAD_DIM), 1.0),
        'cache_na_v': nrm((DEC_BATCH, N_ODD, NA_HEADS, PAST_LEN, HEAD_DIM), 1.0),
        'c': nrm((DEC_BATCH, D_MODEL), 1.0),
        'c_ctx': nrm((D_MODEL,), 1.0),
        'ada_w': nrm((DEPTH, D_MODEL, 6 * D_MODEL), 0.5 * D_MODEL ** -0.5),
        'ada_b': nrm((DEPTH, 6 * D_MODEL), 0.01),
        'norm_mix': gain((DEPTH, D_MODEL)),
        'norm_ffn': gain((DEPTH, D_MODEL)),
        'norm_final': gain((D_MODEL,)),
        'even_w_in': nrm((N_EVEN, D_MODEL, EVEN_IN), D_MODEL ** -0.5),
        'even_w_out': nrm((N_EVEN, EVEN_OUT_IN, D_MODEL), EVEN_OUT_IN ** -0.5),
        'ret_decay_fwd': decay_logit[None, :] + nrm((N_EVEN, RET_HEADS), 0.05),
        'ret_decay_bwd': decay_logit[None, :] + nrm((N_EVEN, RET_HEADS), 0.05),
        'ret_gn': gain((N_EVEN, RET_HEADS * RET_DV)),
        'gqa_q_norm': gain((N_EVEN, HEAD_DIM)),
        'gqa_k_norm': gain((N_EVEN, HEAD_DIM)),
        'odd_w_in': nrm((N_ODD, D_MODEL, 3 * NA_WIDTH), D_MODEL ** -0.5),
        'odd_w_out': nrm((N_ODD, NA_WIDTH, D_MODEL), NA_WIDTH ** -0.5),
        'na_rpb': nrm((N_ODD, NA_HEADS, 2 * NA_KH - 1, 2 * NA_KW - 1), 0.5),
        'ffn_w_up': nrm((DEPTH, D_MODEL, 2 * D_FF), D_MODEL ** -0.5),
        'ffn_conv_w': conv_base[None] + nrm((DEPTH, CONV_WIDTH, 2 * D_FF), 0.3),
        'ffn_conv_b': nrm((DEPTH, 2 * D_FF), 0.01),
        'ffn_w_down': nrm((DEPTH, D_FF, D_MODEL), D_FF ** -0.5),
    }


def reference(x_prompt, x_sample, state_ret_fwd, state_ret_bwd, cache_gqa_k, cache_gqa_v,
              cache_na_k, cache_na_v, c, c_ctx, ada_w, ada_b, norm_mix, norm_ffn, norm_final,
              even_w_in, even_w_out, ret_decay_fwd, ret_decay_bwd, ret_gn, gqa_q_norm, gqa_k_norm,
              odd_w_in, odd_w_out, na_rpb, ffn_w_up, ffn_conv_w, ffn_conv_b, ffn_w_down):
    xc = x_prompt
    xs = x_sample
    ang = axial_angles(x_sample.shape[1], HEAD_DIM)
    sf_list, sb_list, gk_list, gv_list, nk_list, nv_list = [], [], [], [], [], []
    for l in range(DEPTH):
        mc = ada_params(c_ctx[None, :], ada_w[l], ada_b[l])
        ms = ada_params(c, ada_w[l], ada_b[l])
        hc = rms_norm(xc, norm_mix[l]) * (1.0 + mc[1]) + mc[0]
        hs = rms_norm(xs, norm_mix[l]) * (1.0 + ms[1]) + ms[0]
        if l % 2 == 0:
            e = l // 2
            zeros = jnp.zeros((xc.shape[0], RET_HEADS, RET_DK, RET_DV), xc.dtype)
            oc, s_f, s_b, kc, vc = even_mixer(hc, even_w_in[e], even_w_out[e], ret_decay_fwd[e],
                                              ret_decay_bwd[e], ret_gn[e], gqa_q_norm[e], gqa_k_norm[e],
                                              zeros, zeros, None, None, None)
            os_, _, _, _, _ = even_mixer(hs, even_w_in[e], even_w_out[e], ret_decay_fwd[e],
                                         ret_decay_bwd[e], ret_gn[e], gqa_q_norm[e], gqa_k_norm[e],
                                         state_ret_fwd[:, e], state_ret_bwd[:, e],
                                         cache_gqa_k[:, e], cache_gqa_v[:, e], ang)
            sf_list.append(s_f)
            sb_list.append(s_b)
            gk_list.append(kc)
            gv_list.append(vc)
        else:
            o = l // 2
            oc, kc, vc = odd_mixer(hc, odd_w_in[o], odd_w_out[o], na_rpb[o], None, None)
            os_, _, _ = odd_mixer(hs, odd_w_in[o], odd_w_out[o], na_rpb[o], cache_na_k[:, o], cache_na_v[:, o])
            nk_list.append(kc)
            nv_list.append(vc)
        xc = xc + mc[2] * oc
        xs = xs + ms[2] * os_
        xc = xc + mc[5] * conv_ffn(rms_norm(xc, norm_ffn[l]) * (1.0 + mc[4]) + mc[3],
                                   ffn_w_up[l], ffn_conv_w[l], ffn_conv_b[l], ffn_w_down[l])
        xs = xs + ms[5] * conv_ffn(rms_norm(xs, norm_ffn[l]) * (1.0 + ms[4]) + ms[3],
                                   ffn_w_up[l], ffn_conv_w[l], ffn_conv_b[l], ffn_w_down[l])
    y_prompt = rms_norm(xc, norm_final)
    y_sample = rms_norm(xs, norm_final)
    new_state_ret_fwd = jnp.stack(sf_list, axis=1)
    new_state_ret_bwd = jnp.stack(sb_list, axis=1)
    new_cache_gqa_k = jnp.stack(gk_list, axis=1)
    new_cache_gqa_v = jnp.stack(gv_list, axis=1)
    new_cache_na_k = jnp.stack(nk_list, axis=1)
    new_cache_na_v = jnp.stack(nv_list, axis=1)
    return (y_prompt, y_sample, new_state_ret_fwd, new_state_ret_bwd, new_cache_gqa_k, new_cache_gqa_v, new_cache_na_k, new_cache_na_v)
```

```cpp
#include <hip/hip_runtime.h>
#include <stdint.h>
#include <stdio.h>

typedef unsigned short bf16;
typedef __attribute__((ext_vector_type(8))) short bf16x8;
typedef __attribute__((ext_vector_type(4))) float f32x4;
typedef __attribute__((ext_vector_type(4))) unsigned u32x4;

#define DEV __device__ __forceinline__
#define LOG2E 1.4426950408889634f

#define OFF_BAR    0ull
#define OFF_ROPE   16384ull
#define OFF_LG2    (16384ull + 8192ull)
#define OFF_MOD    32768ull
#define OFF_MODP   491520ull
#define OFF_WT     4194304ull
#define WT_EIN     (OFF_WT)
#define WT_EOUT    (WT_EIN + 7864320ull)
#define WT_OIN     (WT_EOUT + 3145728ull)
#define WT_OOUT    (WT_OIN + 6291456ull)
#define WT_UP      (WT_OOUT + 2097152ull)
#define WT_DN      (WT_UP + 2ull * 11534336ull)
#define OFF_CACHE  (WT_DN + 2ull * 5767168ull)
#define CK_GQA     (OFF_CACHE)
#define CVT_GQA    (CK_GQA + 524288ull)
#define CK_NA      (CVT_GQA + 524288ull)
#define CVT_NA     (CK_NA + 4194304ull)
#define S0T_F      (CVT_NA + 4194304ull)
#define S0T_B      (S0T_F + 1048576ull)
#define OFF_R1     (S0T_B + 1048576ull)
#define OFF_R2     (OFF_R1 + 50331648ull)
#define B_QR       (OFF_R2)
#define B_KR       (B_QR + 16777216ull)
#define B_VRT      (B_KR + 16777216ull)
#define B_GR       (B_VRT + 33554432ull)
#define B_QA       (B_GR + 33554432ull)
#define B_KA       (B_QA + 16777216ull)
#define B_VAT      (B_KA + 4194304ull)
#define B_KTFB     (B_VAT + 4194304ull)
#define R2_END     (B_KTFB + 16777216ull)
#define B_Q        (OFF_R2)
#define B_K        (B_Q + 33554432ull)
#define B_VT       (B_K + 33554432ull)
#define B_ACT      (OFF_R2)
#define B_HALO     (B_ACT + 92274688ull)
#define WS_NEEDED  (R2_END)

#define O_YP 0ull
#define O_SF 16777216ull
#define O_SB 18874368ull
#define O_GK 20971520ull
#define O_GV 22020096ull
#define O_NK 23068672ull
#define O_NV 31457280ull

#define SMEM_BYTES 73728

struct Params {
  const float *x_prompt, *x_sample, *state_f, *state_b, *cgk, *cgv, *cnk, *cnv, *c, *c_ctx, *ada_w, *ada_b,
      *norm_mix, *norm_ffn, *norm_final, *even_w_in, *even_w_out, *decay_f, *decay_b, *ret_gn, *q_norm, *k_norm,
      *odd_w_in, *odd_w_out, *na_rpb, *w_up, *conv_w, *conv_b, *w_down;
  float* out;
  unsigned char* ws;
};

DEV unsigned short f2bf(float f) { unsigned u = __float_as_uint(f); u += 0x7fffu + ((u >> 16) & 1u); return (unsigned short)(u >> 16); }
DEV float bf2f(unsigned short h) { return __uint_as_float(((unsigned)h) << 16); }
DEV unsigned pack2(float a, float b) { return (unsigned)f2bf(a) | ((unsigned)f2bf(b) << 16); }
DEV uint4 pack8(const float* v) { uint4 o; o.x = pack2(v[0], v[1]); o.y = pack2(v[2], v[3]); o.z = pack2(v[4], v[5]); o.w = pack2(v[6], v[7]); return o; }
DEV float fexp2(float x) { return __builtin_amdgcn_exp2f(x); }
DEV float silu_f(float x) { return x / (1.0f + __expf(-x)); }

#define XB_TMO      128
#define XB_XCNT(j)  (256  + 64 * (j))
#define XB_XSUB(j)  (1280 + 64 * (j))
#define XB_XGEN(j)  (2304 + 64 * (j))
#define XB_TOP      3328
#define XB_TOPGEN   3392
#define XCD_BAR_WORDS 3456
#define XB_SPIN_CAP (1u << 22)
#define LAS __attribute__((address_space(3)))

DEV unsigned xb_ld(unsigned* p) { return __hip_atomic_load(p, __ATOMIC_RELAXED, __HIP_MEMORY_SCOPE_AGENT); }
DEV unsigned xb_add(unsigned* p, unsigned v) { return __hip_atomic_fetch_add(p, v, __ATOMIC_RELAXED, __HIP_MEMORY_SCOPE_AGENT); }
DEV unsigned xb_xcc_id() { return (unsigned)__builtin_amdgcn_s_getreg((3 << 11) | 20) & 0xFu; }
#define XB_SPIN(cond, bar) do { unsigned _sp = 0; while (cond) { __builtin_amdgcn_s_sleep(1); \
    if ((++_sp & 255u) == 0u) { if (xb_ld(&(bar)[XB_TMO])) break; if (_sp > XB_SPIN_CAP) { atomicAdd(&(bar)[XB_TMO], 1u); break; } } } } while (0)

struct XcdBarrier { unsigned* bar; unsigned x; volatile LAS unsigned* st; };

DEV XcdBarrier xcd_barrier_post(unsigned* bar, volatile LAS unsigned* st) {
  XcdBarrier b; b.bar = bar; b.x = xb_xcc_id(); b.st = st;
  if (threadIdx.x == 0) (void)xb_add(&bar[XB_XCNT(b.x)], 1u);
  return b;
}
DEV void xcd_barrier_complete(unsigned* bar, unsigned x, unsigned& nloc, unsigned& nx) {
  const unsigned G = gridDim.x * gridDim.y * gridDim.z;
  unsigned sum, cnt, mine, sp = 0u;
  for (;;) {
    sum = 0u; cnt = 0u; mine = 0u;
#pragma unroll
    for (unsigned j = 0; j < 16; ++j) { const unsigned c = xb_ld(&bar[XB_XCNT(j)]); sum += c; cnt += (c > 0u) ? 1u : 0u; mine = (j == x) ? c : mine; }
    if (sum == G) break;
    __builtin_amdgcn_s_sleep(1);
    if ((++sp & 255u) == 0u) { if (xb_ld(&bar[XB_TMO])) break; if (sp > XB_SPIN_CAP) { atomicAdd(&bar[XB_TMO], 1u); break; } }
  }
  nloc = mine > 0u ? mine : 1u; nx = cnt > 0u ? cnt : 1u;
}
DEV void xcd_barrier(const XcdBarrier& b) {
  asm volatile("s_waitcnt vmcnt(0)" ::: "memory");
  __syncthreads();
  if (threadIdx.x == 0) {
    unsigned* bar = b.bar;
    __builtin_amdgcn_s_waitcnt(0);
    unsigned nloc = b.st[0], nx = b.st[1];
    if (nloc == 0u) { xcd_barrier_complete(bar, b.x, nloc, nx); b.st[0] = nloc; b.st[1] = nx; }
    const unsigned old = xb_add(&bar[XB_XSUB(b.x)], 1u);
    const unsigned gen = old / nloc;
    if (old + 1u == (gen + 1u) * nloc) {
      __builtin_amdgcn_fence(__ATOMIC_RELEASE, "agent");
      asm volatile("s_waitcnt vmcnt(0)" ::: "memory");
      const unsigned og = xb_add(&bar[XB_TOP], 1u);
      const unsigned tg = og / nx;
      if (og + 1u == (tg + 1u) * nx) xb_add(&bar[XB_TOPGEN], 1u);
      else XB_SPIN(xb_ld(&bar[XB_TOPGEN]) == tg, bar);
      __builtin_amdgcn_fence(__ATOMIC_ACQUIRE, "agent");
      xb_add(&bar[XB_XGEN(b.x)], 1u);
      asm volatile("s_waitcnt vmcnt(0)" ::: "memory");
    } else {
      XB_SPIN(xb_ld(&bar[XB_XGEN(b.x)]) == gen, bar);
      __builtin_amdgcn_fence(__ATOMIC_ACQUIRE, "agent");
      asm volatile("s_waitcnt vmcnt(0)" ::: "memory");
    }
  }
  __syncthreads();
}

DEV void p0_transpose(const float* __restrict__ src, int ld, bf16* __restrict__ dst, int ldd, float* sm) {
  const int tid = threadIdx.x;
#pragma unroll
  for (int i = 0; i < 4; ++i) {
    int idx = tid + 256 * i; int r = idx >> 4, c4 = idx & 15;
    float4 v = *(const float4*)(src + (size_t)r * ld + c4 * 4);
    float* d = sm + r * 65 + c4 * 4; d[0] = v.x; d[1] = v.y; d[2] = v.z; d[3] = v.w;
  }
  __syncthreads();
#pragma unroll
  for (int i = 0; i < 2; ++i) {
    int idx = tid + 256 * i; int c = idx >> 3, rc = idx & 7; float v[8];
#pragma unroll
    for (int e = 0; e < 8; ++e) v[e] = sm[(rc * 8 + e) * 65 + c];
    *(uint4*)(dst + (size_t)c * ldd + rc * 8) = pack8(v);
  }
  __syncthreads();
}

DEV void p0_item(const Params& p, int item, unsigned char* smem) {
  const int tid = threadIdx.x, lane = tid & 63, w = tid >> 6;
  unsigned char* ws = p.ws;
  if (item < 384) {
    const int l = item / 192, rem = item % 192, cb = rem >> 3, kq = rem & 7;
    float* sc = (float*)smem;
    float* red = sc + 9 * 128;
    for (int idx = tid; idx < 9 * 128; idx += 256) {
      int crow = idx >> 7, kk = idx & 127, k = kq * 128 + kk;
      float v = crow < 8 ? p.c[crow * 1024 + k] : p.c_ctx[k];
      sc[idx] = silu_f(v);
    }
    __syncthreads();
    float acc[9][4];
#pragma unroll
    for (int r = 0; r < 9; ++r) { acc[r][0] = 0.f; acc[r][1] = 0.f; acc[r][2] = 0.f; acc[r][3] = 0.f; }
    const float* wp = p.ada_w + ((size_t)(l * 1024 + kq * 128 + w * 32)) * 6144 + cb * 256 + lane * 4;
#pragma unroll 8
    for (int kk = 0; kk < 32; ++kk) {
      float4 wv = *(const float4*)(wp + (size_t)kk * 6144);
#pragma unroll
      for (int r = 0; r < 9; ++r) {
        float s = sc[r * 128 + w * 32 + kk];
        acc[r][0] += s * wv.x; acc[r][1] += s * wv.y; acc[r][2] += s * wv.z; acc[r][3] += s * wv.w;
      }
    }
#pragma unroll
    for (int r = 0; r < 9; ++r) {
      float* d = red + (w * 9 + r) * 256 + lane * 4;
      d[0] = acc[r][0]; d[1] = acc[r][1]; d[2] = acc[r][2]; d[3] = acc[r][3];
    }
    __syncthreads();
    float* modp = (float*)(ws + OFF_MODP);
    for (int idx = tid; idx < 9 * 256; idx += 256) {
      int r = idx >> 8, cc = idx & 255;
      float s = red[(0 * 9 + r) * 256 + cc] + red[(1 * 9 + r) * 256 + cc] + red[(2 * 9 + r) * 256 + cc] + red[(3 * 9 + r) * 256 + cc];
      modp[((size_t)(kq * 2 + l) * 9 + r) * 6144 + cb * 256 + cc] = s;
    }
    __syncthreads();
    return;
  }
  item -= 384;
  if (item < 7424) {
    const float* src; bf16* dst; int R, C, remap = 0; int t = item;
    if (t < 960) { src = p.even_w_in; R = 1024; C = 3840; dst = (bf16*)(ws + WT_EIN); }
    else if ((t -= 960) < 384) { src = p.even_w_out; R = 1536; C = 1024; dst = (bf16*)(ws + WT_EOUT); }
    else if ((t -= 384) < 768) { src = p.odd_w_in; R = 1024; C = 3072; dst = (bf16*)(ws + WT_OIN); }
    else if ((t -= 768) < 256) { src = p.odd_w_out; R = 1024; C = 1024; dst = (bf16*)(ws + WT_OOUT); }
    else if ((t -= 256) < 2816) { int l = t / 1408; t %= 1408; src = p.w_up + (size_t)l * 1024 * 5632; R = 1024; C = 5632; dst = (bf16*)(ws + WT_UP) + (size_t)l * 5632 * 1024; remap = 1; }
    else if ((t -= 2816) < 1408) { int l = t / 704; t %= 704; src = p.w_down + (size_t)l * 2816 * 1024; R = 2816; C = 1024; dst = (bf16*)(ws + WT_DN) + (size_t)l * 1024 * 2816; }
    else if ((t -= 1408) < 64) { int mat = t >> 2; t &= 3; src = p.cgv + (size_t)mat * 256 * 64; R = 256; C = 64; dst = (bf16*)(ws + CVT_GQA) + (size_t)mat * 64 * 256; }
    else if ((t -= 64) < 512) { int mat = t >> 2; t &= 3; src = p.cnv + (size_t)mat * 256 * 64; R = 256; C = 64; dst = (bf16*)(ws + CVT_NA) + (size_t)mat * 64 * 256; }
    else { t -= 512; int which = t >> 7; t &= 127; int mat = t >> 1; t &= 1; src = (which ? p.state_b : p.state_f) + (size_t)mat * 64 * 128; R = 64; C = 128; dst = (bf16*)(ws + (which ? S0T_B : S0T_F)) + (size_t)mat * 128 * 64; }
    const int tcn = C >> 6; const int rt = t / tcn, ct = t % tcn;
    const int drow = remap ? ((ct % 44) * 128 + (ct / 44) * 64) : ct * 64;
    p0_transpose(src + (size_t)rt * 64 * C + ct * 64, C, dst + (size_t)drow * R + rt * 64, R, (float*)smem);
    return;
  }
  item -= 7424;
  if (item < 288) {
    const float* src; bf16* dst; size_t base;
    if (item < 32) { src = p.cgk; dst = (bf16*)(ws + CK_GQA); base = (size_t)item * 8192; }
    else { src = p.cnk; dst = (bf16*)(ws + CK_NA); base = (size_t)(item - 32) * 8192; }
#pragma unroll
    for (int i = 0; i < 4; ++i) {
      size_t o = base + (size_t)(i * 256 + tid) * 8;
      float4 a = *(const float4*)(src + o), b = *(const float4*)(src + o + 4);
      float v[8] = {a.x, a.y, a.z, a.w, b.x, b.y, b.z, b.w};
      *(uint4*)(dst + o) = pack8(v);
    }
    return;
  }
  {
    float2* rope = (float2*)(ws + OFF_ROPE);
    for (int idx = tid; idx < 1024; idx += 256) {
      int pos = idx >> 4, fi = idx & 15;
      float inv = exp2f(-(float)fi * 0.8304820237218406f);
      float ang = (float)pos * inv;
      float k = rintf(ang * 0.15915494309189535f);
      float r = fmaf(-k, 6.2831854820251465f, ang);
      r = fmaf(-k, -1.7484556e-7f, r);
      rope[idx] = make_float2(__cosf(r), __sinf(r));
    }
    if (tid < 16) {
      int fb = tid >> 3, h = tid & 7;
      float x = (fb ? p.decay_b : p.decay_f)[h];
      float lg = -log1pf(expf(-x)) * LOG2E;
      ((float*)(ws + OFF_LG2))[tid] = lg;
    }
  }
}

DEV float modval(const Params& p, int l, int crow, int n, bool partial) {
  if (!partial) return ((const float*)(p.ws + OFF_MOD))[(size_t)(l * 9 + crow) * 6144 + n];
  const float* mp = (const float*)(p.ws + OFF_MODP);
  float s = p.ada_b[l * 6144 + n];
#pragma unroll
  for (int kq = 0; kq < 8; ++kq) s += mp[((size_t)(kq * 2 + l) * 9 + crow) * 6144 + n];
  return s;
}

DEV void norm_phase(const Params& p, int l, int si, int sci, const float* g, const float* xc, const float* xs, bool partial, unsigned char* smem) {
  const int tid = threadIdx.x, lane = tid & 63, w = tid >> 6;
  float* ssh = (float*)smem; float* ssc = ssh + 1024;
  bf16* H = (bf16*)(p.ws + OFF_R1);
  for (int chunk = blockIdx.x; chunk < 512; chunk += gridDim.x) {
    const int row0 = chunk * 32; const int crow = row0 < 8192 ? 8 : ((row0 - 8192) >> 10);
    for (int idx = tid; idx < 1024; idx += 256) {
      ssh[idx] = modval(p, l, crow, si * 1024 + idx, partial);
      ssc[idx] = (1.0f + modval(p, l, crow, sci * 1024 + idx, partial)) * g[idx];
    }
    __syncthreads();
    for (int rr = 0; rr < 8; ++rr) {
      const int row = row0 + w * 8 + rr;
      const float* xp = row < 8192 ? xc + (size_t)row * 1024 : xs + (size_t)(row - 8192) * 1024;
      float4 v[4]; float ss = 0.f;
#pragma unroll
      for (int i = 0; i < 4; ++i) { v[i] = *(const float4*)(xp + lane * 4 + 256 * i); ss += v[i].x * v[i].x + v[i].y * v[i].y + v[i].z * v[i].z + v[i].w * v[i].w; }
#pragma unroll
      for (int o = 1; o < 64; o <<= 1) ss += __shfl_xor(ss, o);
      const float rstd = rsqrtf(ss * (1.0f / 1024.0f) + 1e-6f);
#pragma unroll
      for (int i = 0; i < 4; ++i) {
        const int col = lane * 4 + 256 * i;
        float4 sc = *(const float4*)(ssc + col), sh = *(const float4*)(ssh + col);
        uint2 o; o.x = pack2(v[i].x * rstd * sc.x + sh.x, v[i].y * rstd * sc.y + sh.y);
        o.y = pack2(v[i].z * rstd * sc.z + sh.z, v[i].w * rstd * sc.w + sh.w);
        *(uint2*)(H + (size_t)row * 1024 + col) = o;
      }
    }
    __syncthreads();
  }
}

DEV void final_norm_phase(const Params& p) {
  const int tid = threadIdx.x, lane = tid & 63, w = tid >> 6;
  for (int row = blockIdx.x * 4 + w; row < 16384; row += gridDim.x * 4) {
    float* xp = p.out + (size_t)row * 1024;
    float4 v[4]; float ss = 0.f;
#pragma unroll
    for (int i = 0; i < 4; ++i) { v[i] = *(const float4*)(xp + lane * 4 + 256 * i); ss += v[i].x * v[i].x + v[i].y * v[i].y + v[i].z * v[i].z + v[i].w * v[i].w; }
#pragma unroll
    for (int o = 1; o < 64; o <<= 1) ss += __shfl_xor(ss, o);
    const float rstd = rsqrtf(ss * (1.0f / 1024.0f) + 1e-6f);
#pragma unroll
    for (int i = 0; i < 4; ++i) {
      const int col = lane * 4 + 256 * i;
      float4 g = *(const float4*)(p.norm_final + col);
      float4 o = make_float4(v[i].x * rstd * g.x, v[i].y * rstd * g.y, v[i].z * rstd * g.z, v[i].w * rstd * g.w);
      *(float4*)(xp + col) = o;
    }
  }
}

#define CT_LD 132
DEV void gemm_core(const bf16* __restrict__ A, int lda, const bf16* __restrict__ B, int ldb, int K, unsigned char* smem) {
  const int tid = threadIdx.x, lane = tid & 63, w = tid >> 6;
  const int wr = w >> 1, wc = w & 1, lr = lane & 15, lq = lane >> 4;
  bf16* As = (bf16*)smem;
  bf16* Bs = As + 2 * 128 * 72;
  const int ldr = tid >> 3, ldc = (tid & 7) * 8;
  const bf16* Ap = A + (size_t)ldr * lda + ldc;
  const bf16* Bp = B + (size_t)ldr * ldb + ldc;
  uint4 ra[4], rb[4];
#pragma unroll
  for (int i = 0; i < 4; ++i) { ra[i] = *(const uint4*)(Ap + (size_t)(32 * i) * lda); rb[i] = *(const uint4*)(Bp + (size_t)(32 * i) * ldb); }
#pragma unroll
  for (int i = 0; i < 4; ++i) { *(uint4*)(As + (ldr + 32 * i) * 72 + ldc) = ra[i]; *(uint4*)(Bs + (ldr + 32 * i) * 72 + ldc) = rb[i]; }
  __syncthreads();
  f32x4 acc[4][4];
#pragma unroll
  for (int i = 0; i < 4; ++i)
#pragma unroll
    for (int j = 0; j < 4; ++j) acc[i][j] = (f32x4){0.f, 0.f, 0.f, 0.f};
  const int nk = K >> 6;
  for (int kt = 0; kt < nk; ++kt) {
    const int cur = kt & 1;
    const bool more = (kt + 1 < nk);
    if (more) {
#pragma unroll
      for (int i = 0; i < 4; ++i) { ra[i] = *(const uint4*)(Ap + (size_t)(32 * i) * lda + (kt + 1) * 64); rb[i] = *(const uint4*)(Bp + (size_t)(32 * i) * ldb + (kt + 1) * 64); }
    }
    const bf16* as = As + cur * 128 * 72 + (wr * 64 + lr) * 72 + lq * 8;
    const bf16* bs = Bs + cur * 128 * 72 + (wc * 64 + lr) * 72 + lq * 8;
#pragma unroll
    for (int ks = 0; ks < 2; ++ks) {
      bf16x8 a[4], b[4];
#pragma unroll
      for (int i = 0; i < 4; ++i) { a[i] = *(const bf16x8*)(as + i * 16 * 72 + ks * 32); b[i] = *(const bf16x8*)(bs + i * 16 * 72 + ks * 32); }
#pragma unroll
      for (int mi = 0; mi < 4; ++mi)
#pragma unroll
        for (int ni = 0; ni < 4; ++ni) acc[mi][ni] = __builtin_amdgcn_mfma_f32_16x16x32_bf16(a[mi], b[ni], acc[mi][ni], 0, 0, 0);
    }
    if (more) {
      bf16* ad = As + (cur ^ 1) * 128 * 72; bf16* bd = Bs + (cur ^ 1) * 128 * 72;
#pragma unroll
      for (int i = 0; i < 4; ++i) { *(uint4*)(ad + (ldr + 32 * i) * 72 + ldc) = ra[i]; *(uint4*)(bd + (ldr + 32 * i) * 72 + ldc) = rb[i]; }
    }
    __syncthreads();
  }
  float* Ct = (float*)smem;
#pragma unroll
  for (int mi = 0; mi < 4; ++mi)
#pragma unroll
    for (int ni = 0; ni < 4; ++ni)
#pragma unroll
      for (int j = 0; j < 4; ++j) Ct[(wr * 64 + mi * 16 + lq * 4 + j) * CT_LD + wc * 64 + ni * 16 + lr] = acc[mi][ni][j];
  __syncthreads();
}

DEV void ld8(const float* Ct, int r, int c, float* v) {
  float4 a = *(const float4*)(Ct + r * CT_LD + c), b = *(const float4*)(Ct + r * CT_LD + c + 4);
  v[0] = a.x; v[1] = a.y; v[2] = a.z; v[3] = a.w; v[4] = b.x; v[5] = b.y; v[6] = b.z; v[7] = b.w;
}

template <class F>
DEV void epi_transposed(const float* Ct, F dstrow) {
  const int tid = threadIdx.x;
#pragma unroll
  for (int i = 0; i < 8; ++i) {
    int idx = tid + 256 * i; int tcl = idx & 3, c = (idx >> 2) & 127, tch = idx >> 9; int tc = tch * 4 + tcl;
    float v[8];
#pragma unroll
    for (int e = 0; e < 8; ++e) v[e] = Ct[(tc * 8 + e) * CT_LD + c];
    *(uint4*)(dstrow(c) + tc * 8) = pack8(v);
  }
}

DEV void epi_even(const Params& p, int mt, int nt, const float* Ct) {
  const int tid = threadIdx.x, cg = tid & 15, rg = tid >> 4;
  unsigned char* ws = p.ws;
  const int m0 = mt * 128; const bool lat = m0 >= 8192;
  const int bseq = lat ? ((m0 - 8192) >> 10) : (m0 >> 8);
  const int t0 = lat ? ((m0 - 8192) & 1023) : (m0 & 255);
  int type; int cb;
  if (nt < 4) { type = 0; cb = nt * 128; } else if (nt < 8) { type = 1; cb = (nt - 4) * 128; } else if (nt < 16) { type = 2; cb = (nt - 8) * 128; }
  else if (nt < 24) { type = 3; cb = (nt - 16) * 128; } else if (nt < 28) { type = 4; cb = (nt - 24) * 128; } else if (nt == 28) { type = 5; cb = 0; } else { type = 6; cb = 0; }
  if (type == 2) {
    const int h = nt - 8;
    if (!lat) { bf16* base = (bf16*)(ws + B_VRT) + ((size_t)(bseq * 8 + h) * 128) * 256 + t0; epi_transposed(Ct, [&](int c) { return base + (size_t)c * 256; }); }
    else { bf16* base = (bf16*)(ws + B_VRT) + (size_t)8192 * 1024 + ((size_t)(bseq * 8 + h) * 128) * 1024 + t0; epi_transposed(Ct, [&](int c) { return base + (size_t)c * 1024; }); }
  } else if (type == 6) {
    if (!lat) { bf16* base = (bf16*)(ws + B_VAT) + ((size_t)(bseq * 2) * 64) * 256 + t0; epi_transposed(Ct, [&](int c) { return base + (size_t)c * 256; }); }
    else { bf16* base = (bf16*)(ws + B_VAT) + (size_t)32 * 2 * 64 * 256 + ((size_t)(bseq * 2) * 64) * 1024 + t0; epi_transposed(Ct, [&](int c) { return base + (size_t)c * 1024; }); }
    if (!lat) {
#pragma unroll
      for (int i = 0; i < 8; ++i) {
        const int r = rg + 16 * i; float v[8]; ld8(Ct, r, cg * 8, v);
        const int kvh = cg >> 3, d0 = (cg & 7) * 8;
        float* o = p.out + O_GV + ((size_t)(bseq * 2 + kvh) * 256 + t0 + r) * 64 + d0;
        *(float4*)o = make_float4(v[0], v[1], v[2], v[3]); *(float4*)(o + 4) = make_float4(v[4], v[5], v[6], v[7]);
      }
    }
  } else {
    const int j0 = (cg * 8) & 63;
    const float2* rope = (const float2*)(ws + OFF_ROPE);
    const bool dorope = lat && (type == 0 || type == 1 || type == 4 || type == 5);
    float gain[8], pgain[8];
#pragma unroll
    for (int e = 0; e < 8; ++e) { gain[e] = 1.f; pgain[e] = 1.f; }
    if (type == 4 || type == 5) {
      const float* gp = (type == 4) ? p.q_norm : p.k_norm;
#pragma unroll
      for (int e = 0; e < 8; ++e) { gain[e] = gp[j0 + e]; pgain[e] = gp[(j0 ^ 16) + e]; }
    }
    bf16* dst; int ldd;
    if (type == 0) { dst = (bf16*)(ws + B_QR); ldd = 512; } else if (type == 1) { dst = (bf16*)(ws + B_KR); ldd = 512; }
    else if (type == 3) { dst = (bf16*)(ws + B_GR); ldd = 1024; } else if (type == 4) { dst = (bf16*)(ws + B_QA); ldd = 512; } else { dst = (bf16*)(ws + B_KA); ldd = 128; }
#pragma unroll
    for (int i = 0; i < 8; ++i) {
      const int r = rg + 16 * i; const int row = m0 + r;
      float v[8]; ld8(Ct, r, cg * 8, v);
      float mul = (type == 1) ? 0.125f : 1.0f;
      if (type == 4 || type == 5) {
        float ss = 0.f;
#pragma unroll
        for (int e = 0; e < 8; ++e) ss += v[e] * v[e];
        ss += __shfl_xor(ss, 1); ss += __shfl_xor(ss, 2); ss += __shfl_xor(ss, 4);
        mul = rsqrtf(ss * (1.0f / 64.0f) + 1e-6f);
      }
#pragma unroll
      for (int e = 0; e < 8; ++e) v[e] *= mul * gain[e];
      if (type == 5 && !lat) {
        const int kvh = cg >> 3;
        float* o = p.out + O_GK + ((size_t)(bseq * 2 + kvh) * 256 + t0 + r) * 64 + j0;
        *(float4*)o = make_float4(v[0], v[1], v[2], v[3]); *(float4*)(o + 4) = make_float4(v[4], v[5], v[6], v[7]);
      }
      if (dorope) {
        float pv[8]; ld8(Ct, r, (cg * 8) ^ 16, pv);
        const int t = t0 + r; const int pos = (j0 & 32) ? (t & 63) : (t >> 6); const int f0 = j0 & 15;
        const float sgn = (j0 & 16) ? 1.0f : -1.0f;
#pragma unroll
        for (int e = 0; e < 8; ++e) {
          float2 cs = rope[pos * 16 + f0 + e];
          float pe = pv[e] * mul * pgain[e];
          v[e] = v[e] * cs.x + sgn * pe * cs.y;
        }
      }
      *(uint4*)(dst + (size_t)row * ldd + cb + cg * 8) = pack8(v);
    }
    if (type == 1 && !lat) {
      const float* lg2 = (const float*)(ws + OFF_LG2);
      bf16* base = (bf16*)(ws + B_KTFB);
#pragma unroll
      for (int i = 0; i < 8; ++i) {
        int idx = tid + 256 * i; int tcl = idx & 3, c = (idx >> 2) & 127, tch = idx >> 9; int tc = tch * 4 + tcl;
        const int h = (nt - 4) * 2 + (c >> 6), d = c & 63;
        const float lgf = lg2[h], lgb = lg2[8 + h];
        float f[8], g[8];
#pragma unroll
        for (int e = 0; e < 8; ++e) {
          const int tt = t0 + tc * 8 + e; const float val = Ct[(tc * 8 + e) * CT_LD + c] * 0.125f;
          f[e] = val * fexp2(lgf * (float)(255 - tt)); g[e] = val * fexp2(lgb * (float)tt);
        }
        bf16* o = base + (((size_t)(bseq * 8 + h) * 2) * 64 + d) * 256 + t0 + tc * 8;
        *(uint4*)o = pack8(f); *(uint4*)(o + 64 * 256) = pack8(g);
      }
    }
  }
  __syncthreads();
}

DEV void epi_odd(const Params& p, int mt, int nt, const float* Ct) {
  const int tid = threadIdx.x, cg = tid & 15, rg = tid >> 4;
  unsigned char* ws = p.ws;
  const int m0 = mt * 128; const bool lat = m0 >= 8192;
  const int bseq = lat ? ((m0 - 8192) >> 10) : (m0 >> 8);
  const int t0 = lat ? ((m0 - 8192) & 1023) : (m0 & 255);
  if (nt < 16) {
    bf16* dst = (bf16*)(ws + (nt < 8 ? B_Q : B_K)); const int cb = (nt & 7) * 128;
#pragma unroll
    for (int i = 0; i < 8; ++i) {
      const int r = rg + 16 * i; float v[8]; ld8(Ct, r, cg * 8, v);
      *(uint4*)(dst + (size_t)(m0 + r) * 1024 + cb + cg * 8) = pack8(v);
      if (nt >= 8 && !lat) {
        const int h = (nt - 8) * 2 + (cg >> 3), d0 = (cg & 7) * 8;
        float* o = p.out + O_NK + ((size_t)(bseq * 16 + h) * 256 + t0 + r) * 64 + d0;
        *(float4*)o = make_float4(v[0], v[1], v[2], v[3]); *(float4*)(o + 4) = make_float4(v[4], v[5], v[6], v[7]);
      }
    }
  } else {
    const int h0 = (nt - 16) * 2;
    if (!lat) { bf16* base = (bf16*)(ws + B_VT) + ((size_t)(bseq * 16 + h0) * 64) * 256 + t0; epi_transposed(Ct, [&](int c) { return base + (size_t)c * 256; }); }
    else { bf16* base = (bf16*)(ws + B_VT) + (size_t)8192 * 1024 + ((size_t)(bseq * 16 + h0) * 64) * 1024 + t0; epi_transposed(Ct, [&](int c) { return base + (size_t)c * 1024; }); }
    if (!lat) {
#pragma unroll
      for (int i = 0; i < 8; ++i) {
        const int r = rg + 16 * i; float v[8]; ld8(Ct, r, cg * 8, v);
        const int h = h0 + (cg >> 3), d0 = (cg & 7) * 8;
        float* o = p.out + O_NV + ((size_t)(bseq * 16 + h) * 256 + t0 + r) * 64 + d0;
        *(float4*)o = make_float4(v[0], v[1], v[2], v[3]); *(float4*)(o + 4) = make_float4(v[4], v[5], v[6], v[7]);
      }
    }
  }
  __syncthreads();
}

DEV void epi_resid(const Params& p, int mt, int nt, const float* Ct, int l, int gi, const float* xc, const float* xs) {
  const int tid = threadIdx.x, cg = tid & 15, rg = tid >> 4;
  const int m0 = mt * 128; const int col = nt * 128 + cg * 8;
  const int crow = m0 < 8192 ? 8 : ((m0 - 8192) >> 10);
  const float* gp = (const float*)(p.ws + OFF_MOD) + (size_t)(l * 9 + crow) * 6144 + gi * 1024 + col;
  const float4 g0 = *(const float4*)gp, g1 = *(const float4*)(gp + 4);
#pragma unroll
  for (int i = 0; i < 8; ++i) {
    const int r = rg + 16 * i; const int row = m0 + r; float v[8]; ld8(Ct, r, cg * 8, v);
    const float* xp = (row < 8192 ? xc + (size_t)row * 1024 : xs + (size_t)(row - 8192) * 1024) + col;
    float4 a = *(const float4*)xp, b = *(const float4*)(xp + 4);
    float* o = p.out + (size_t)row * 1024 + col;
    *(float4*)o = make_float4(a.x + g0.x * v[0], a.y + g0.y * v[1], a.z + g0.z * v[2], a.w + g0.w * v[3]);
    *(float4*)(o + 4) = make_float4(b.x + g1.x * v[4], b.y + g1.y * v[5], b.z + g1.z * v[6], b.w + g1.w * v[7]);
  }
  __syncthreads();
}

DEV void epi_ffn_up(const Params& p, int mt, int nt, const float* Ct, int l) {
  const int tid = threadIdx.x;
  const int m0 = mt * 128; const bool lat = m0 >= 8192;
  const int t0 = lat ? ((m0 - 8192) & 1023) : (m0 & 255); const int L = lat ? 1024 : 256;
  const float* cw = p.conv_w + (size_t)l * 3 * 5632; const float* cbp = p.conv_b + (size_t)l * 5632;
  bf16* act = (bf16*)(p.ws + B_ACT);
#pragma unroll
  for (int i = 0; i < 4; ++i) {
    const int idx = tid + 256 * i; const int r = idx >> 3, j0 = (idx & 7) * 8;
    const bool first = (t0 + r == 0), last = (t0 + r == L - 1);
    if ((r == 0 && !first) || (r == 127 && !last)) continue;
    float res[8];
    float ac[8], gc[8];
    const int oca = nt * 64 + j0, ocg = 2816 + nt * 64 + j0;
    {
      float u[8], g[8]; ld8(Ct, r, j0, u); ld8(Ct, r, 64 + j0, g);
#pragma unroll
      for (int e = 0; e < 8; ++e) { ac[e] = cbp[oca + e] + cw[5632 + oca + e] * u[e]; gc[e] = cbp[ocg + e] + cw[5632 + ocg + e] * g[e]; }
    }
    if (r > 0) {
      float u[8], g[8]; ld8(Ct, r - 1, j0, u); ld8(Ct, r - 1, 64 + j0, g);
#pragma unroll
      for (int e = 0; e < 8; ++e) { ac[e] += cw[oca + e] * u[e]; gc[e] += cw[ocg + e] * g[e]; }
    }
    if (r < 127) {
      float u[8], g[8]; ld8(Ct, r + 1, j0, u); ld8(Ct, r + 1, 64 + j0, g);
#pragma unroll
      for (int e = 0; e < 8; ++e) { ac[e] += cw[2 * 5632 + oca + e] * u[e]; gc[e] += cw[2 * 5632 + ocg + e] * g[e]; }
    }
#pragma unroll
    for (int e = 0; e < 8; ++e) res[e] = silu_f(ac[e]) * gc[e];
    *(uint4*)(act + (size_t)(m0 + r) * 2816 + nt * 64 + j0) = pack8(res);
  }
  float* halo = (float*)(p.ws + B_HALO);
  for (int idx = tid; idx < 512; idx += 256) {
    const int hr = idx >> 7, c = idx & 127; const int r = (hr < 2) ? hr : 124 + hr;
    halo[((size_t)(mt * 4 + hr)) * 5632 + nt * 128 + c] = Ct[r * CT_LD + c];
  }
  __syncthreads();
}

DEV void ffn_fixup_phase(const Params& p, int l) {
  const int tid = threadIdx.x;
  const float* cw = p.conv_w + (size_t)l * 3 * 5632; const float* cbp = p.conv_b + (size_t)l * 5632;
  const float* halo = (const float*)(p.ws + B_HALO);
  bf16* act = (bf16*)(p.ws + B_ACT);
  for (int item = blockIdx.x; item < 254; item += gridDim.x) {
    const int mt = 1 + (item >> 1), which = item & 1;
    const bool boundary = (mt < 64) ? ((mt & 1) != 0) : (((mt - 64) & 7) != 0);
    if (!boundary) continue;
    const float *up, *uc, *un; int row;
    if (which == 0) { up = halo + (size_t)((mt - 1) * 4 + 2) * 5632; uc = halo + (size_t)((mt - 1) * 4 + 3) * 5632; un = halo + (size_t)(mt * 4 + 0) * 5632; row = mt * 128 - 1; }
    else { up = halo + (size_t)((mt - 1) * 4 + 3) * 5632; uc = halo + (size_t)(mt * 4 + 0) * 5632; un = halo + (size_t)(mt * 4 + 1) * 5632; row = mt * 128; }
    for (int j = tid; j < 2816; j += 256) {
      const int ca = (j >> 6) * 128 + (j & 63), cgi = ca + 64;
      const float a = cbp[j] + cw[j] * up[ca] + cw[5632 + j] * uc[ca] + cw[2 * 5632 + j] * un[ca];
      const float g = cbp[2816 + j] + cw[2816 + j] * up[cgi] + cw[5632 + 2816 + j] * uc[cgi] + cw[2 * 5632 + 2816 + j] * un[cgi];
      act[(size_t)row * 2816 + j] = f2bf(silu_f(a) * g);
    }
  }
}

DEV void epi_state(const Params& p, int b, int h, const float* Ct) {
  const int tid = threadIdx.x, cg = tid & 15, rg = tid >> 4;
#pragma unroll
  for (int i = 0; i < 8; ++i) {
    const int r = rg + 16 * i; float v[8]; ld8(Ct, r, cg * 8, v);
    float* o = p.out + (r < 64 ? O_SF : O_SB) + ((size_t)(b * 8 + h) * 64 + (r & 63)) * 128 + cg * 8;
    *(float4*)o = make_float4(v[0], v[1], v[2], v[3]); *(float4*)(o + 4) = make_float4(v[4], v[5], v[6], v[7]);
  }
  __syncthreads();
}

template <int EPI>
DEV void gemm_phase(const Params& p, const bf16* A, int lda, const bf16* B, int ldb, int K, int NT, int l, int gi, const float* xc, const float* xs, unsigned char* smem) {
  const int total = 128 * NT;
  for (int T = blockIdx.x; T < total; T += gridDim.x) {
    const int x = T & 7, Lc = T >> 3; const int mt = 16 * x + (Lc & 15), nt = Lc >> 4;
    gemm_core(A + (size_t)mt * 128 * lda, lda, B + (size_t)nt * 128 * ldb, ldb, K, smem);
    const float* Ct = (const float*)smem;
    if (EPI == 0) epi_even(p, mt, nt, Ct);
    else if (EPI == 1) epi_odd(p, mt, nt, Ct);
    else if (EPI == 2) epi_resid(p, mt, nt, Ct, l, gi, xc, xs);
    else epi_ffn_up(p, mt, nt, Ct, l);
  }
}

struct AttnArgs {
  const bf16* q; int ldq;
  const bf16* k0; const bf16* vt0; int ldk0, ldvt0, n0;
  const bf16* k1; const bf16* vt1; int ldk1, ldvt1, n1;
  const bf16* vt2; int ldvt2, n2;
  float scale;
  int qpos0, seqN; float lgf, lgb;
  int r0, lo;
  bf16* out; int ldo;
  const bf16* gr; const float* gn; int tok0; int h;
};


struct AttRegs { uint4 k0, k1, v0, v1, v2, v3; };
template <int NV>
DEV void att_load(const AttnArgs& a, int ti, int krow, int kch, AttRegs& R) {
  const bf16* kp; const bf16* vp; int ldk, ldv;
  if (ti < a.n0) { kp = a.k0 + (size_t)ti * 64 * a.ldk0; ldk = a.ldk0; vp = a.vt0 + ti * 64; ldv = a.ldvt0; }
  else if (ti < a.n0 + a.n1) { const int j = ti - a.n0; kp = a.k1 ? a.k1 + (size_t)j * 64 * a.ldk1 : (const bf16*)0; ldk = a.ldk1; vp = a.vt1 + j * 64; ldv = a.ldvt1; }
  else { const int j = ti - a.n0 - a.n1; kp = (const bf16*)0; ldk = 0; vp = a.vt2 + j * 64; ldv = a.ldvt2; }
  if (kp) {
    R.k0 = *(const uint4*)(kp + (size_t)(krow) * ldk + kch * 8);
    R.k1 = *(const uint4*)(kp + (size_t)(krow + 32) * ldk + kch * 8);
  } else {
    {
      const int d = krow - kch * 8; const unsigned one = (d & 1) ? 0x3F800000u : 0x00003F80u; const bool in = (d >= 0 && d < 8);
      R.k0 = make_uint4((in && (d >> 1) == 0) ? one : 0u, (in && (d >> 1) == 1) ? one : 0u, (in && (d >> 1) == 2) ? one : 0u, (in && (d >> 1) == 3) ? one : 0u);
    }
    {
      const int d = krow + 32 - kch * 8; const unsigned one = (d & 1) ? 0x3F800000u : 0x00003F80u; const bool in = (d >= 0 && d < 8);
      R.k1 = make_uint4((in && (d >> 1) == 0) ? one : 0u, (in && (d >> 1) == 1) ? one : 0u, (in && (d >> 1) == 2) ? one : 0u, (in && (d >> 1) == 3) ? one : 0u);
    }
  }
  R.v0 = *(const uint4*)(vp + (size_t)(krow) * ldv + kch * 8);
  R.v1 = *(const uint4*)(vp + (size_t)(krow + 32) * ldv + kch * 8);
  if (NV > 2) {
    R.v2 = *(const uint4*)(vp + (size_t)(krow + 64) * ldv + kch * 8);
    R.v3 = *(const uint4*)(vp + (size_t)(krow + 96) * ldv + kch * 8);
  }
}
template <int DV, int NV>
DEV void att_store(bf16* Ks, bf16* Vs, int buf, int krow, int kch, const AttRegs& R) {
  bf16* kd = Ks + buf * 64 * 72 + krow * 72 + kch * 8;
  *(uint4*)(kd) = R.k0; *(uint4*)(kd + 32 * 72) = R.k1;
  bf16* vd = Vs + buf * DV * 72 + krow * 72 + kch * 8;
  *(uint4*)(vd) = R.v0; *(uint4*)(vd + 32 * 72) = R.v1;
  if (NV > 2) { *(uint4*)(vd + 64 * 72) = R.v2; *(uint4*)(vd + 96 * 72) = R.v3; }
}

template <int DV, int MODE>
DEV void attn_item(const AttnArgs& a, unsigned char* smem, const float* rpbs) {
  constexpr int NB = DV / 16, NV = DV / 32;
  const int tid = threadIdx.x, lane = tid & 63, w = tid >> 6, lr = lane & 15, lq = lane >> 4;
  bf16* Ks = (bf16*)smem;
  bf16* Vs = Ks + 2 * 64 * 72;
  const int ntiles = a.n0 + a.n1 + a.n2;
  bf16x8 qf[2][2];
#pragma unroll
  for (int rb = 0; rb < 2; ++rb)
#pragma unroll
    for (int ds = 0; ds < 2; ++ds) qf[rb][ds] = *(const bf16x8*)(a.q + (size_t)(w * 32 + rb * 16 + lr) * a.ldq + ds * 32 + lq * 8);
  f32x4 o[NB][2];
#pragma unroll
  for (int nb = 0; nb < NB; ++nb) { o[nb][0] = (f32x4){0.f, 0.f, 0.f, 0.f}; o[nb][1] = (f32x4){0.f, 0.f, 0.f, 0.f}; }
  float mrow[2] = {-1e30f, -1e30f}, lrow[2] = {0.f, 0.f};
  AttRegs R;
  R.v2 = make_uint4(0u, 0u, 0u, 0u); R.v3 = R.v2;
  const int krow = tid >> 3, kch = tid & 7;
#define ATT_LOAD(ti) att_load<NV>(a, (ti), krow, kch, R)
#define ATT_STORE(buf) att_store<DV, NV>(Ks, Vs, (buf), krow, kch, R)

  ATT_LOAD(0);
  ATT_STORE(0);
  __syncthreads();
  for (int ti = 0; ti < ntiles; ++ti) {
    const int cur = ti & 1; const bool more = (ti + 1 < ntiles);
    if (more) ATT_LOAD(ti + 1);
    bool active = true;
    const int myrow = a.r0 + (w >> 1);
    int rs_ = myrow - 4; rs_ = rs_ < 0 ? 0 : (rs_ > 8 ? 8 : rs_);
    const int kr = a.lo + ti;
    if (MODE == 1 && ti < a.n0) active = (kr >= rs_ && kr < rs_ + 8);
    if (active) {
      const bf16* ks = Ks + cur * 64 * 72 + lr * 72 + lq * 8;
      f32x4 s[4][2];
#pragma unroll
      for (int kb = 0; kb < 4; ++kb) { s[kb][0] = (f32x4){0.f, 0.f, 0.f, 0.f}; s[kb][1] = (f32x4){0.f, 0.f, 0.f, 0.f}; }
#pragma unroll
      for (int ds = 0; ds < 2; ++ds)
#pragma unroll
        for (int kb = 0; kb < 4; ++kb) {
          bf16x8 kf = *(const bf16x8*)(ks + kb * 16 * 72 + ds * 32);
          s[kb][0] = __builtin_amdgcn_mfma_f32_16x16x32_bf16(kf, qf[0][ds], s[kb][0], 0, 0, 0);
          s[kb][1] = __builtin_amdgcn_mfma_f32_16x16x32_bf16(kf, qf[1][ds], s[kb][1], 0, 0, 0);
        }
      if (MODE == 2) {
#pragma unroll
        for (int rb = 0; rb < 2; ++rb) {
          const int n = a.qpos0 + w * 32 + rb * 16 + lr;
          if (ti < a.n0) {
#pragma unroll
            for (int kb = 0; kb < 4; ++kb)
#pragma unroll
              for (int j = 0; j < 4; ++j) {
                const int m = ti * 64 + kb * 16 + lq * 4 + j; const int d = n - m;
                const float fac = d > 0 ? fexp2(a.lgf * (float)d) : (d < 0 ? fexp2(a.lgb * (float)(-d)) : 2.0f);
                s[kb][rb][j] *= fac;
              }
          } else {
            const float fac = (ti < a.n0 + a.n1) ? fexp2(a.lgf * (float)(n + 1)) : fexp2(a.lgb * (float)(a.seqN - n));
#pragma unroll
            for (int kb = 0; kb < 4; ++kb)
#pragma unroll
              for (int j = 0; j < 4; ++j) s[kb][rb][j] *= fac;
          }
        }
      } else {
        if (MODE == 1 && ti < a.n0) {
#pragma unroll
          for (int rb = 0; rb < 2; ++rb) {
            const int c = (w & 1) * 32 + rb * 16 + lr;
            int cs = c - 8; cs = cs < 0 ? 0 : (cs > 48 ? 48 : cs);
            const float* bp = rpbs + (kr - myrow + 7) * 31 + (15 - c);
#pragma unroll
            for (int kb = 0; kb < 4; ++kb)
#pragma unroll
              for (int j = 0; j < 4; ++j) {
                const int kc = kb * 16 + lq * 4 + j;
                const bool valid = (kc >= cs) && (kc < cs + 16);
                const float bias = valid ? bp[kc] : 0.f;
                s[kb][rb][j] = valid ? (s[kb][rb][j] * a.scale + bias) : -1e30f;
              }
          }
        } else {
#pragma unroll
          for (int kb = 0; kb < 4; ++kb)
#pragma unroll
            for (int j = 0; j < 4; ++j) { s[kb][0][j] *= a.scale; s[kb][1][j] *= a.scale; }
        }
#pragma unroll
        for (int rb = 0; rb < 2; ++rb) {
          float mx = -1e30f;
#pragma unroll
          for (int kb = 0; kb < 4; ++kb)
#pragma unroll
            for (int j = 0; j < 4; ++j) mx = fmaxf(mx, s[kb][rb][j]);
          mx = fmaxf(mx, __shfl_xor(mx, 16)); mx = fmaxf(mx, __shfl_xor(mx, 32));
          const float mn = fmaxf(mrow[rb], mx); const float alpha = fexp2(mrow[rb] - mn); mrow[rb] = mn;
          float rs = 0.f;
#pragma unroll
          for (int kb = 0; kb < 4; ++kb)
#pragma unroll
            for (int j = 0; j < 4; ++j) { const float pv = fexp2(s[kb][rb][j] - mn); s[kb][rb][j] = pv; rs += pv; }
          lrow[rb] = lrow[rb] * alpha + rs;
#pragma unroll
          for (int nb = 0; nb < NB; ++nb) o[nb][rb] *= alpha;
        }
      }
      const bf16* vs = Vs + cur * DV * 72 + lr * 72 + lq * 4;
#pragma unroll
      for (int pp = 0; pp < 2; ++pp) {
        bf16x8 pf[2];
#pragma unroll
        for (int rb = 0; rb < 2; ++rb) {
          u32x4 t; t.x = pack2(s[2 * pp][rb][0], s[2 * pp][rb][1]); t.y = pack2(s[2 * pp][rb][2], s[2 * pp][rb][3]);
          t.z = pack2(s[2 * pp + 1][rb][0], s[2 * pp + 1][rb][1]); t.w = pack2(s[2 * pp + 1][rb][2], s[2 * pp + 1][rb][3]);
          pf[rb] = __builtin_bit_cast(bf16x8, t);
        }
#pragma unroll
        for (int nb = 0; nb < NB; ++nb) {
          const uint2 vlo = *(const uint2*)(vs + nb * 16 * 72 + (2 * pp) * 16);
          const uint2 vhi = *(const uint2*)(vs + nb * 16 * 72 + (2 * pp + 1) * 16);
          u32x4 t; t.x = vlo.x; t.y = vlo.y; t.z = vhi.x; t.w = vhi.y;
          const bf16x8 vf = __builtin_bit_cast(bf16x8, t);
          o[nb][0] = __builtin_amdgcn_mfma_f32_16x16x32_bf16(vf, pf[0], o[nb][0], 0, 0, 0);
          o[nb][1] = __builtin_amdgcn_mfma_f32_16x16x32_bf16(vf, pf[1], o[nb][1], 0, 0, 0);
        }
      }
    }
    if (more) ATT_STORE(cur ^ 1);
    __syncthreads();
  }
#undef ATT_LOAD
#undef ATT_STORE
  if (MODE == 2) {
#pragma unroll
    for (int rb = 0; rb < 2; ++rb) {
      float sum = 0.f;
#pragma unroll
      for (int nb = 0; nb < NB; ++nb)
#pragma unroll
        for (int j = 0; j < 4; ++j) sum += o[nb][rb][j];
      sum += __shfl_xor(sum, 16); sum += __shfl_xor(sum, 32);
      const float mean = sum * (1.0f / (float)DV);
      float var = 0.f;
#pragma unroll
      for (int nb = 0; nb < NB; ++nb)
#pragma unroll
        for (int j = 0; j < 4; ++j) { const float d = o[nb][rb][j] - mean; var += d * d; }
      var += __shfl_xor(var, 16); var += __shfl_xor(var, 32);
      const float rstd = rsqrtf(var * (1.0f / (float)DV) + 1e-5f);
      const size_t tok = (size_t)(a.tok0 + w * 32 + rb * 16 + lr);
#pragma unroll
      for (int nb = 0; nb < NB; ++nb) {
        const int e0 = nb * 16 + lq * 4;
        const uint2 gv = *(const uint2*)(a.gr + tok * 1024 + a.h * DV + e0);
        const float4 gn = *(const float4*)(a.gn + a.h * DV + e0);
        const float g0 = bf2f((unsigned short)(gv.x & 0xffffu)), g1 = bf2f((unsigned short)(gv.x >> 16));
        const float g2 = bf2f((unsigned short)(gv.y & 0xffffu)), g3 = bf2f((unsigned short)(gv.y >> 16));
        uint2 ov;
        ov.x = pack2((o[nb][rb][0] - mean) * rstd * gn.x * silu_f(g0), (o[nb][rb][1] - mean) * rstd * gn.y * silu_f(g1));
        ov.y = pack2((o[nb][rb][2] - mean) * rstd * gn.z * silu_f(g2), (o[nb][rb][3] - mean) * rstd * gn.w * silu_f(g3));
        *(uint2*)(a.out + tok * a.ldo + a.h * DV + e0) = ov;
      }
    }
  } else {
#pragma unroll
    for (int rb = 0; rb < 2; ++rb) {
      float lt = lrow[rb]; lt += __shfl_xor(lt, 16); lt += __shfl_xor(lt, 32);
      const float inv = 1.0f / lt;
      bf16* op = a.out + (size_t)(w * 32 + rb * 16 + lr) * a.ldo + lq * 4;
#pragma unroll
      for (int nb = 0; nb < NB; ++nb) {
        uint2 ov; ov.x = pack2(o[nb][rb][0] * inv, o[nb][rb][1] * inv); ov.y = pack2(o[nb][rb][2] * inv, o[nb][rb][3] * inv);
        *(uint2*)(op + nb * 16) = ov;
      }
    }
  }
}

DEV void even_attn_args(const Params& p, AttnArgs& a, int i2, bool lat, int& b, int& h, int& seq0, int& tok0) {
  int qt;
  if (lat) { b = i2 >> 6; h = (i2 >> 3) & 7; qt = i2 & 7; }
  else { b = i2 >> 4; h = (i2 >> 1) & 7; qt = i2 & 1; }
  seq0 = lat ? 8192 + b * 1024 : b * 256;
  tok0 = seq0 + qt * 128;
  a.n1 = 0; a.n2 = 0; a.k1 = nullptr; a.vt1 = nullptr; a.vt2 = nullptr; a.ldk1 = 0; a.ldvt1 = 0; a.ldvt2 = 0;
  a.r0 = 0; a.lo = 0; a.scale = 0.125f * LOG2E; a.qpos0 = qt * 128; a.seqN = lat ? 1024 : 256; a.lgf = 0.f; a.lgb = 0.f;
  a.gr = nullptr; a.gn = nullptr; a.tok0 = tok0; a.h = h;
}

DEV void even_mixer_phase(const Params& p, unsigned char* smem) {
  unsigned char* ws = p.ws;
  bf16* MO = (bf16*)(ws + OFF_R1);
  for (int item = blockIdx.x; item < 1024; item += gridDim.x) {
    const float* lg2 = (const float*)(ws + OFF_LG2);
    const bool lat = item < 512; int b, h, seq0, tok0; AttnArgs a;
    even_attn_args(p, a, item & 511, lat, b, h, seq0, tok0);
    a.q = (const bf16*)(ws + B_QR) + (size_t)tok0 * 512 + h * 64; a.ldq = 512;
    a.k0 = (const bf16*)(ws + B_KR) + (size_t)seq0 * 512 + h * 64; a.ldk0 = 512;
    if (lat) { a.vt0 = (const bf16*)(ws + B_VRT) + (size_t)8192 * 1024 + ((size_t)(b * 8 + h) * 128) * 1024; a.ldvt0 = 1024; a.n0 = 16;
      a.n1 = 1; a.vt1 = (const bf16*)(ws + S0T_F) + (size_t)(b * 8 + h) * 128 * 64; a.ldvt1 = 64;
      a.n2 = 1; a.vt2 = (const bf16*)(ws + S0T_B) + (size_t)(b * 8 + h) * 128 * 64; a.ldvt2 = 64; }
    else { a.vt0 = (const bf16*)(ws + B_VRT) + ((size_t)(b * 8 + h) * 128) * 256; a.ldvt0 = 256; a.n0 = 4; }
    a.lgf = lg2[h]; a.lgb = lg2[8 + h];
    a.gr = (const bf16*)(ws + B_GR); a.gn = p.ret_gn; a.out = MO; a.ldo = 1536;
    attn_item<128, 2>(a, smem, nullptr);
  }
  for (int item = blockIdx.x; item < 1024; item += gridDim.x) {
    const bool lat = item < 512; int b, h, seq0, tok0; AttnArgs a;
    even_attn_args(p, a, item & 511, lat, b, h, seq0, tok0);
    const int kvh = h >> 2;
    a.q = (const bf16*)(ws + B_QA) + (size_t)tok0 * 512 + h * 64; a.ldq = 512;
    a.k0 = (const bf16*)(ws + B_KA) + (size_t)seq0 * 128 + kvh * 64; a.ldk0 = 128;
    if (lat) { a.vt0 = (const bf16*)(ws + B_VAT) + (size_t)32 * 2 * 64 * 256 + ((size_t)(b * 2 + kvh) * 64) * 1024; a.ldvt0 = 1024; a.n0 = 16;
      a.n1 = 4; a.k1 = (const bf16*)(ws + CK_GQA) + (size_t)(b * 2 + kvh) * 256 * 64; a.ldk1 = 64;
      a.vt1 = (const bf16*)(ws + CVT_GQA) + (size_t)(b * 2 + kvh) * 64 * 256; a.ldvt1 = 256; }
    else { a.vt0 = (const bf16*)(ws + B_VAT) + ((size_t)(b * 2 + kvh) * 64) * 256; a.ldvt0 = 256; a.n0 = 4; }
    a.out = MO + (size_t)tok0 * 1536 + 1024 + h * 64; a.ldo = 1536;
    attn_item<64, 0>(a, smem, nullptr);
  }
  for (int item = blockIdx.x; item < 256; item += gridDim.x) {
    const int b = item >> 3, h = item & 7;
    gemm_core((const bf16*)(ws + B_KTFB) + (size_t)(b * 8 + h) * 2 * 64 * 256, 256, (const bf16*)(ws + B_VRT) + (size_t)(b * 8 + h) * 128 * 256, 256, 256, smem);
    epi_state(p, b, h, (const float*)smem);
  }
}

DEV void odd_mixer_phase(const Params& p, unsigned char* smem) {
  unsigned char* ws = p.ws;
  bf16* MO = (bf16*)(ws + OFF_R1);
  float* rpbs = (float*)(smem + 65536);
  for (int item = blockIdx.x; item < 2048; item += gridDim.x) {
    AttnArgs a;
    a.n1 = 0; a.n2 = 0; a.k1 = nullptr; a.vt1 = nullptr; a.vt2 = nullptr; a.ldk1 = 0; a.ldvt1 = 0; a.ldvt2 = 0;
    a.r0 = 0; a.lo = 0; a.scale = 0.125f * LOG2E; a.qpos0 = 0; a.seqN = 0; a.lgf = 0.f; a.lgb = 0.f;
    a.gr = nullptr; a.gn = nullptr; a.tok0 = 0; a.h = 0;
    if (item < 1024) {
      const int b = item >> 7, h = (item >> 3) & 15, rp = item & 7; const int r0 = rp * 2;
      int lo = r0 - 4; lo = lo < 0 ? 0 : (lo > 8 ? 8 : lo);
      int hi = r0 + 1 - 4; hi = hi < 0 ? 0 : (hi > 8 ? 8 : hi); hi += 8;
      const int seq0 = 8192 + b * 1024; const int tok0 = seq0 + r0 * 64;
      for (int idx = threadIdx.x; idx < 465; idx += 256) rpbs[idx] = p.na_rpb[h * 465 + idx] * LOG2E;
      a.q = (const bf16*)(ws + B_Q) + (size_t)tok0 * 1024 + h * 64; a.ldq = 1024;
      a.k0 = (const bf16*)(ws + B_K) + (size_t)(seq0 + lo * 64) * 1024 + h * 64; a.ldk0 = 1024;
      a.vt0 = (const bf16*)(ws + B_VT) + (size_t)8192 * 1024 + ((size_t)(b * 16 + h) * 64) * 1024 + lo * 64; a.ldvt0 = 1024; a.n0 = hi - lo;
      a.n1 = 4; a.k1 = (const bf16*)(ws + CK_NA) + (size_t)(b * 16 + h) * 256 * 64; a.ldk1 = 64;
      a.vt1 = (const bf16*)(ws + CVT_NA) + (size_t)(b * 16 + h) * 64 * 256; a.ldvt1 = 256;
      a.r0 = r0; a.lo = lo;
      a.out = MO + (size_t)tok0 * 1024 + h * 64; a.ldo = 1024;
      attn_item<64, 1>(a, smem, rpbs);
    } else {
      const int i2 = item - 1024; const int b = i2 >> 5, h = (i2 >> 1) & 15, qt = i2 & 1;
      const int seq0 = b * 256; const int tok0 = seq0 + qt * 128;
      a.q = (const bf16*)(ws + B_Q) + (size_t)tok0 * 1024 + h * 64; a.ldq = 1024;
      a.k0 = (const bf16*)(ws + B_K) + (size_t)seq0 * 1024 + h * 64; a.ldk0 = 1024;
      a.vt0 = (const bf16*)(ws + B_VT) + ((size_t)(b * 16 + h) * 64) * 256; a.ldvt0 = 256; a.n0 = 4;
      a.out = MO + (size_t)tok0 * 1024 + h * 64; a.ldo = 1024;
      attn_item<64, 0>(a, smem, nullptr);
    }
  }
}

__global__ void __launch_bounds__(256, 2) mega_kernel(Params p) {
  __shared__ __attribute__((aligned(16))) unsigned char smem[SMEM_BYTES];
  __shared__ uint4 xb_words;
  if (threadIdx.x == 0) xb_words = make_uint4(0u, 0u, 0u, 0u);
  __syncthreads();
  XcdBarrier bar = xcd_barrier_post((unsigned*)(p.ws + OFF_BAR), (volatile LAS unsigned*)&xb_words);
  unsigned char* ws = p.ws;
  float* xo_c = p.out; float* xo_s = p.out + (size_t)8192 * 1024;

  for (int item = blockIdx.x; item < 8097; item += gridDim.x) p0_item(p, item, smem);
  xcd_barrier(bar);

  {
    float* mod = (float*)(ws + OFF_MOD); const float* mp = (const float*)(ws + OFF_MODP);
    for (int idx = blockIdx.x * 256 + threadIdx.x; idx < 2 * 9 * 6144; idx += gridDim.x * 256) {
      const int l = idx / 55296, n = idx % 6144;
      float s = p.ada_b[l * 6144 + n];
#pragma unroll
      for (int kq = 0; kq < 8; ++kq) s += mp[(size_t)kq * 110592 + idx];
      mod[idx] = s;
    }
  }
  norm_phase(p, 0, 0, 1, p.norm_mix, p.x_prompt, p.x_sample, true, smem);
  xcd_barrier(bar);

  gemm_phase<0>(p, (const bf16*)(ws + OFF_R1), 1024, (const bf16*)(ws + WT_EIN), 1024, 1024, 30, 0, 0, nullptr, nullptr, smem);
  xcd_barrier(bar);
  even_mixer_phase(p, smem);
  xcd_barrier(bar);
  gemm_phase<2>(p, (const bf16*)(ws + OFF_R1), 1536, (const bf16*)(ws + WT_EOUT), 1536, 1536, 8, 0, 2, p.x_prompt, p.x_sample, smem);
  xcd_barrier(bar);
  norm_phase(p, 0, 3, 4, p.norm_ffn, xo_c, xo_s, false, smem);
  xcd_barrier(bar);
  gemm_phase<3>(p, (const bf16*)(ws + OFF_R1), 1024, (const bf16*)(ws + WT_UP), 1024, 1024, 44, 0, 0, nullptr, nullptr, smem);
  xcd_barrier(bar);
  ffn_fixup_phase(p, 0);
  xcd_barrier(bar);
  gemm_phase<2>(p, (const bf16*)(ws + B_ACT), 2816, (const bf16*)(ws + WT_DN), 2816, 2816, 8, 0, 5, xo_c, xo_s, smem);
  xcd_barrier(bar);

  norm_phase(p, 1, 0, 1, p.norm_mix + 1024, xo_c, xo_s, false, smem);
  xcd_barrier(bar);
  gemm_phase<1>(p, (const bf16*)(ws + OFF_R1), 1024, (const bf16*)(ws + WT_OIN), 1024, 1024, 24, 1, 0, nullptr, nullptr, smem);
  xcd_barrier(bar);
  odd_mixer_phase(p, smem);
  xcd_barrier(bar);
  gemm_phase<2>(p, (const bf16*)(ws + OFF_R1), 1024, (const bf16*)(ws + WT_OOUT), 1024, 1024, 8, 1, 2, xo_c, xo_s, smem);
  xcd_barrier(bar);
  norm_phase(p, 1, 3, 4, p.norm_ffn + 1024, xo_c, xo_s, false, smem);
  xcd_barrier(bar);
  gemm_phase<3>(p, (const bf16*)(ws + OFF_R1), 1024, (const bf16*)(ws + WT_UP) + (size_t)5632 * 1024, 1024, 1024, 44, 1, 0, nullptr, nullptr, smem);
  xcd_barrier(bar);
  ffn_fixup_phase(p, 1);
  xcd_barrier(bar);
  gemm_phase<2>(p, (const bf16*)(ws + B_ACT), 2816, (const bf16*)(ws + WT_DN) + (size_t)1024 * 2816, 2816, 2816, 8, 1, 5, xo_c, xo_s, smem);
  xcd_barrier(bar);

  final_norm_phase(p);
}

extern "C" void kernel_launch(void* const* d_in, const int* in_sizes, int n_in, void* d_out, int out_size, void* d_ws, size_t ws_size,
                              hipStream_t stream) {
  static int grid_blocks = 0;
  if (!grid_blocks) {
    int dev = 0, cus = 0, per_cu = 0;
    hipGetDevice(&dev);
    hipDeviceGetAttribute(&cus, hipDeviceAttributeMultiprocessorCount, dev);
    hipOccupancyMaxActiveBlocksPerMultiprocessor(&per_cu, mega_kernel, 256, 0);
    if (per_cu > 2) per_cu = 2;
    if (per_cu < 1) per_cu = 1;
    grid_blocks = cus * per_cu;
    if (grid_blocks % 8) grid_blocks -= grid_blocks % 8;
  }
  if (ws_size < (size_t)WS_NEEDED) fprintf(stderr, "workspace too small: %zu < %llu\n", ws_size, (unsigned long long)WS_NEEDED);
  Params p{};
  const float** pp = (const float**)&p;
  for (int i = 0; i < 29; ++i) pp[i] = (const float*)d_in[i];
  p.out = (float*)d_out;
  p.ws = (unsigned char*)d_ws;
  hipMemsetAsync(d_ws, 0, XCD_BAR_WORDS * 4, stream);
  void* args[] = {&p};
  hipError_t e = hipLaunchCooperativeKernel((void*)mega_kernel, dim3(grid_blocks), dim3(256), args, 0, stream);
  if (e != hipSuccess) fprintf(stderr, "cooperative launch failed: %s (grid %d)\n", hipGetErrorString(e), grid_blocks);
}
```

```cpp
#include <hip/hip_runtime.h>
#include <stdint.h>
#include <stdio.h>

typedef unsigned short bf16;
typedef __attribute__((ext_vector_type(8))) short bf16x8;
typedef __attribute__((ext_vector_type(4))) float f32x4;
typedef __attribute__((ext_vector_type(4))) unsigned u32x4;

#define DEV __device__ __forceinline__
#define LOG2E 1.4426950408889634f

#define OFF_BAR    0ull
#define OFF_ROPE   16384ull
#define OFF_LG2    (16384ull + 8192ull)
#define OFF_MOD    32768ull
#define OFF_MODP   491520ull
#define OFF_WT     4194304ull
#define WT_EIN     (OFF_WT)
#define WT_EOUT    (WT_EIN + 7864320ull)
#define WT_OIN     (WT_EOUT + 3145728ull)
#define WT_OOUT    (WT_OIN + 6291456ull)
#define WT_UP      (WT_OOUT + 2097152ull)
#define WT_DN      (WT_UP + 2ull * 11534336ull)
#define OFF_CACHE  (WT_DN + 2ull * 5767168ull)
#define CK_GQA     (OFF_CACHE)
#define CVT_GQA    (CK_GQA + 524288ull)
#define CK_NA      (CVT_GQA + 524288ull)
#define CVT_NA     (CK_NA + 4194304ull)
#define S0T_F      (CVT_NA + 4194304ull)
#define S0T_B      (S0T_F + 1048576ull)
#define OFF_R1     (S0T_B + 1048576ull)
#define OFF_R2     (OFF_R1 + 50331648ull)
#define B_QR       (OFF_R2)
#define B_KR       (B_QR + 16777216ull)
#define B_VRT      (B_KR + 16777216ull)
#define B_GR       (B_VRT + 33554432ull)
#define B_QA       (B_GR + 33554432ull)
#define B_KA       (B_QA + 16777216ull)
#define B_VAT      (B_KA + 4194304ull)
#define B_KTFB     (B_VAT + 4194304ull)
#define R2_END     (B_KTFB + 16777216ull)
#define B_Q        (OFF_R2)
#define B_K        (B_Q + 33554432ull)
#define B_VT       (B_K + 33554432ull)
#define B_ACT      (OFF_R2)
#define B_HALO     (B_ACT + 92274688ull)
#define B_XB       (OFF_R2 + 103809024ull)
#define WS_NEEDED  (R2_END)

#define O_YP 0ull
#define O_SF 16777216ull
#define O_SB 18874368ull
#define O_GK 20971520ull
#define O_GV 22020096ull
#define O_NK 23068672ull
#define O_NV 31457280ull

#define SMEM_BYTES 135168
#define NTHR 512
#define LDS_TOTAL (SMEM_BYTES + 16)

struct Params {
  const float *x_prompt, *x_sample, *state_f, *state_b, *cgk, *cgv, *cnk, *cnv, *c, *c_ctx, *ada_w, *ada_b,
      *norm_mix, *norm_ffn, *norm_final, *even_w_in, *even_w_out, *decay_f, *decay_b, *ret_gn, *q_norm, *k_norm,
      *odd_w_in, *odd_w_out, *na_rpb, *w_up, *conv_w, *conv_b, *w_down;
  float* out;
  unsigned char* ws;
};

DEV unsigned short f2bf(float f) { unsigned u = __float_as_uint(f); u += 0x7fffu + ((u >> 16) & 1u); return (unsigned short)(u >> 16); }
DEV float bf2f(unsigned short h) { return __uint_as_float(((unsigned)h) << 16); }
DEV unsigned pack2(float a, float b) { unsigned r; asm("v_cvt_pk_bf16_f32 %0, %1, %2" : "=v"(r) : "v"(a), "v"(b)); return r; }
DEV uint4 pack8(const float* v) { uint4 o; o.x = pack2(v[0], v[1]); o.y = pack2(v[2], v[3]); o.z = pack2(v[4], v[5]); o.w = pack2(v[6], v[7]); return o; }
DEV float fexp2(float x) { return __builtin_amdgcn_exp2f(x); }
DEV u32x4 gload16(const void* p) { u32x4 r; asm volatile("global_load_dwordx4 %0, %1, off" : "=v"(r) : "v"(p) : "memory"); return r; }
#define VMWAIT4(a, b, c, d) asm volatile("s_waitcnt vmcnt(0)" : "+v"(a), "+v"(b), "+v"(c), "+v"(d) : : "memory")
#define VMWAIT2(a, b) asm volatile("s_waitcnt vmcnt(0)" : "+v"(a), "+v"(b) : : "memory")
DEV float silu_f(float x) { return x * __builtin_amdgcn_rcpf(1.0f + __expf(-x)); }

#define XB_TMO      128
#define XB_XCNT(j)  (256  + 64 * (j))
#define XB_XSUB(j)  (1280 + 64 * (j))
#define XB_XGEN(j)  (2304 + 64 * (j))
#define XB_TOP      3328
#define XB_TOPGEN   3392
#define XCD_BAR_WORDS 3456
#define XB_SPIN_CAP (1u << 22)
#define LAS __attribute__((address_space(3)))

DEV unsigned xb_ld(unsigned* p) { return __hip_atomic_load(p, __ATOMIC_RELAXED, __HIP_MEMORY_SCOPE_AGENT); }
DEV unsigned xb_add(unsigned* p, unsigned v) { return __hip_atomic_fetch_add(p, v, __ATOMIC_RELAXED, __HIP_MEMORY_SCOPE_AGENT); }
DEV unsigned xb_xcc_id() { return (unsigned)__builtin_amdgcn_s_getreg((3 << 11) | 20) & 0xFu; }
#define XB_SPIN(cond, bar) do { unsigned _sp = 0; while (cond) { __builtin_amdgcn_s_sleep(1); \
    if ((++_sp & 255u) == 0u) { if (xb_ld(&(bar)[XB_TMO])) break; if (_sp > XB_SPIN_CAP) { atomicAdd(&(bar)[XB_TMO], 1u); break; } } } } while (0)

struct XcdBarrier { unsigned* bar; unsigned x; volatile LAS unsigned* st; };

DEV XcdBarrier xcd_barrier_post(unsigned* bar, volatile LAS unsigned* st) {
  XcdBarrier b; b.bar = bar; b.x = xb_xcc_id(); b.st = st;
  if (threadIdx.x == 0) (void)xb_add(&bar[XB_XCNT(b.x)], 1u);
  return b;
}
DEV void xcd_barrier_complete(unsigned* bar, unsigned x, unsigned& nloc, unsigned& nx) {
  const unsigned G = gridDim.x * gridDim.y * gridDim.z;
  unsigned sum, cnt, mine, sp = 0u;
  for (;;) {
    sum = 0u; cnt = 0u; mine = 0u;
#pragma unroll
    for (unsigned j = 0; j < 16; ++j) { const unsigned c = xb_ld(&bar[XB_XCNT(j)]); sum += c; cnt += (c > 0u) ? 1u : 0u; mine = (j == x) ? c : mine; }
    if (sum == G) break;
    __builtin_amdgcn_s_sleep(1);
    if ((++sp & 255u) == 0u) { if (xb_ld(&bar[XB_TMO])) break; if (sp > XB_SPIN_CAP) { atomicAdd(&bar[XB_TMO], 1u); break; } }
  }
  nloc = mine > 0u ? mine : 1u; nx = cnt > 0u ? cnt : 1u;
}
DEV void xcd_barrier(const XcdBarrier& b) {
  asm volatile("s_waitcnt vmcnt(0)" ::: "memory");
  __syncthreads();
  if (threadIdx.x == 0) {
    unsigned* bar = b.bar;
    __builtin_amdgcn_s_waitcnt(0);
    unsigned nloc = b.st[0], nx = b.st[1];
    if (nloc == 0u) { xcd_barrier_complete(bar, b.x, nloc, nx); b.st[0] = nloc; b.st[1] = nx; }
    const unsigned old = xb_add(&bar[XB_XSUB(b.x)], 1u);
    const unsigned gen = old / nloc;
    if (old + 1u == (gen + 1u) * nloc) {
      __builtin_amdgcn_fence(__ATOMIC_RELEASE, "agent");
      asm volatile("s_waitcnt vmcnt(0)" ::: "memory");
      const unsigned og = xb_add(&bar[XB_TOP], 1u);
      const unsigned tg = og / nx;
      if (og + 1u == (tg + 1u) * nx) xb_add(&bar[XB_TOPGEN], 1u);
      else XB_SPIN(xb_ld(&bar[XB_TOPGEN]) == tg, bar);
      __builtin_amdgcn_fence(__ATOMIC_ACQUIRE, "agent");
      xb_add(&bar[XB_XGEN(b.x)], 1u);
      asm volatile("s_waitcnt vmcnt(0)" ::: "memory");
    } else {
      XB_SPIN(xb_ld(&bar[XB_XGEN(b.x)]) == gen, bar);
      __builtin_amdgcn_fence(__ATOMIC_ACQUIRE, "agent");
      asm volatile("s_waitcnt vmcnt(0)" ::: "memory");
    }
  }
  __syncthreads();
}

DEV void p0_transpose(const float* __restrict__ src, int ld, bf16* __restrict__ dst, int ldd, float* sm) {
  int tid = threadIdx.x; asm volatile("" : "+v"(tid));
#pragma unroll
  for (int i = 0; i < 2; ++i) {
    int idx = tid + 512 * i; int r = idx >> 4, c4 = idx & 15;
    float4 v = *(const float4*)(src + (size_t)r * ld + c4 * 4);
    float* d = sm + r * 65 + c4 * 4; d[0] = v.x; d[1] = v.y; d[2] = v.z; d[3] = v.w;
  }
  __syncthreads();
  {
    int idx = tid; int c = idx >> 3, rc = idx & 7; float v[8];
#pragma unroll
    for (int e = 0; e < 8; ++e) v[e] = sm[(rc * 8 + e) * 65 + c];
    *(uint4*)(dst + (size_t)c * ldd + rc * 8) = pack8(v);
  }
  __syncthreads();
}

DEV void p0_transpose4(const float* __restrict__ src, int ld, bf16* __restrict__ d0, bf16* __restrict__ d1, bf16* __restrict__ d2, bf16* __restrict__ d3, int ldd, float scale, float* sm) {
  int tid = threadIdx.x; asm volatile("" : "+v"(tid));
  float4 v[8];
#pragma unroll
  for (int i = 0; i < 8; ++i) { const int idx = tid + 512 * i; const int r = idx >> 6, c4 = idx & 63; v[i] = *(const float4*)(src + (size_t)r * ld + c4 * 4); }
#pragma unroll
  for (int i = 0; i < 8; ++i) { const int idx = tid + 512 * i; const int r = idx >> 6, c4 = idx & 63; float* d = sm + r * 257 + c4 * 4; d[0] = v[i].x; d[1] = v[i].y; d[2] = v[i].z; d[3] = v[i].w; }
  __syncthreads();
#pragma unroll
  for (int i = 0; i < 4; ++i) {
    const int idx = tid + 512 * i; const int c = idx >> 3, rc = idx & 7; float o[8];
#pragma unroll
    for (int e = 0; e < 8; ++e) o[e] = sm[(rc * 8 + e) * 257 + c] * scale;
    bf16* db = (i == 0) ? d0 : (i == 1) ? d1 : (i == 2) ? d2 : d3;
    *(uint4*)(db + (size_t)(c & 63) * ldd + rc * 8) = pack8(o);
  }
  __syncthreads();
}

DEV void p0_weight(const Params& p, int item, unsigned char* smem) {
  unsigned char* ws = p.ws;
  const float* src; bf16* dst; int R, C, remap = 0; int t = item;
  if (t < 240) { src = p.even_w_in; R = 1024; C = 3840; dst = (bf16*)(ws + WT_EIN); }
  else if ((t -= 240) < 96) { src = p.even_w_out; R = 1536; C = 1024; dst = (bf16*)(ws + WT_EOUT); }
  else if ((t -= 96) < 192) { src = p.odd_w_in; R = 1024; C = 3072; dst = (bf16*)(ws + WT_OIN); }
  else if ((t -= 192) < 64) { src = p.odd_w_out; R = 1024; C = 1024; dst = (bf16*)(ws + WT_OOUT); }
  else if ((t -= 64) < 704) { int l = t / 352; t %= 352; src = p.w_up + (size_t)l * 1024 * 5632; R = 1024; C = 5632; dst = (bf16*)(ws + WT_UP) + (size_t)l * 5632 * 1024; remap = 1; }
  else { t -= 704; int l = t / 176; t %= 176; src = p.w_down + (size_t)l * 2816 * 1024; R = 2816; C = 1024; dst = (bf16*)(ws + WT_DN) + (size_t)l * 1024 * 2816; }
  const int tcn = C >> 8; const int rt = t / tcn, c4 = t % tcn;
  bf16* d[4];
#pragma unroll
  for (int j = 0; j < 4; ++j) { const int ct = c4 * 4 + j; const int drow = remap ? ((ct % 44) * 128 + (ct / 44) * 64) : ct * 64; d[j] = dst + (size_t)drow * R + rt * 64; }
  const float wscale = (item < 240 && (c4 == 2 || c4 == 3)) ? 0.125f : 1.0f;
  p0_transpose4(src + (size_t)rt * 64 * C + c4 * 256, C, d[0], d[1], d[2], d[3], R, wscale, (float*)smem);
}
DEV void p0_item(const Params& p, int item, unsigned char* smem);
DEV void p0_weight_tail(const Params& p, int group, int total_units, unsigned char* smem) {
  const int G = (int)gridDim.x, c = (int)blockIdx.x;
  const int nfull = total_units % G;
  const int first = nfull ? nfull : 0, nw = nfull ? (G - nfull) : G;
  if (c < first) return;
  const int n = group ? 784 + 960 : 624;
  for (int i = c - first; i < n; i += nw) {
    if (i >= 784) {
      const int j = i - 784;
      p0_item(p, j < 192 ? 192 + j : (j < 704 ? 624 + 64 + (j - 192) : 1456 + 32 + (j - 704)), smem);
      continue;
    }
    int t;
    if (group == 0) t = i < 96 ? 240 + i : (i < 448 ? 592 + (i - 96) : 1296 + (i - 448));
    else t = i < 192 ? 336 + i : (i < 256 ? 528 + (i - 192) : (i < 608 ? 944 + (i - 256) : 1472 + (i - 608)));
    p0_weight(p, t, smem);
  }
}

DEV void p0_item(const Params& p, int item, unsigned char* smem) {
  int tid = threadIdx.x; asm volatile("" : "+v"(tid)); const int lane = tid & 63, w = tid >> 6;
  unsigned char* ws = p.ws;
  if (item < 384) {
    const int l = item / 192, rem = item % 192, cb = rem >> 3, kq = rem & 7;
    float* sc = (float*)smem;
    float* red = sc + 9 * 128;
    for (int idx = tid; idx < 9 * 128; idx += 512) {
      int crow = idx >> 7, kk = idx & 127, k = kq * 128 + kk;
      float v = crow < 8 ? p.c[crow * 1024 + k] : p.c_ctx[k];
      sc[idx] = silu_f(v);
    }
    __syncthreads();
    float acc[9][4];
#pragma unroll
    for (int r = 0; r < 9; ++r) { acc[r][0] = 0.f; acc[r][1] = 0.f; acc[r][2] = 0.f; acc[r][3] = 0.f; }
    const float* wp = p.ada_w + ((size_t)(l * 1024 + kq * 128 + w * 16)) * 6144 + cb * 256 + lane * 4;
#pragma unroll 8
    for (int kk = 0; kk < 16; ++kk) {
      float4 wv = *(const float4*)(wp + (size_t)kk * 6144);
#pragma unroll
      for (int r = 0; r < 9; ++r) {
        float s = sc[r * 128 + w * 16 + kk];
        acc[r][0] += s * wv.x; acc[r][1] += s * wv.y; acc[r][2] += s * wv.z; acc[r][3] += s * wv.w;
      }
    }
#pragma unroll
    for (int r = 0; r < 9; ++r) {
      float* d = red + (w * 9 + r) * 256 + lane * 4;
      d[0] = acc[r][0]; d[1] = acc[r][1]; d[2] = acc[r][2]; d[3] = acc[r][3];
    }
    __syncthreads();
    float* modp = (float*)(ws + OFF_MODP);
    for (int idx = tid; idx < 9 * 256; idx += 512) {
      int r = idx >> 8, cc = idx & 255;
      float s = 0.f;
#pragma unroll
      for (int ww = 0; ww < 8; ++ww) s += red[(ww * 9 + r) * 256 + cc];
      modp[((size_t)(kq * 2 + l) * 9 + r) * 6144 + cb * 256 + cc] = s;
    }
    __syncthreads();
    return;
  }
  item -= 384;
  if (item < 240) { p0_weight(p, item, smem); return; }
  item -= 240;
  if (item < 832) {
    const float* src; bf16* dst; int R, C, tiled = 0; int t = item;
    if (t < 64) { int mat = t >> 2; t &= 3; src = p.cgv + (size_t)mat * 256 * 64; R = 256; C = 64; dst = (bf16*)(ws + CVT_GQA) + (size_t)mat * 64 * 256; tiled = 1; }
    else if ((t -= 64) < 512) { int mat = t >> 2; t &= 3; src = p.cnv + (size_t)mat * 256 * 64; R = 256; C = 64; dst = (bf16*)(ws + CVT_NA) + (size_t)mat * 64 * 256; tiled = 1; }
    else { t -= 512; int which = t >> 7; t &= 127; int mat = t >> 1; t &= 1; src = (which ? p.state_b : p.state_f) + (size_t)mat * 64 * 128; R = 64; C = 128; dst = (bf16*)(ws + (which ? S0T_B : S0T_F)) + (size_t)mat * 128 * 64; }
    const int tcn = C >> 6; const int rt = t / tcn, ct = t % tcn;
    if (tiled) p0_transpose(src + (size_t)rt * 64 * C, C, dst + (size_t)rt * 4096, 64, (float*)smem);
    else p0_transpose(src + (size_t)rt * 64 * C + ct * 64, C, dst + (size_t)(ct * 64) * R + rt * 64, R, (float*)smem);
    return;
  }
  item -= 832;
  if (item < 288) {
    const float* src; bf16* dst; size_t base;
    if (item < 32) { src = p.cgk; dst = (bf16*)(ws + CK_GQA); base = (size_t)item * 8192; }
    else { src = p.cnk; dst = (bf16*)(ws + CK_NA); base = (size_t)(item - 32) * 8192; }
#pragma unroll
    for (int i = 0; i < 2; ++i) {
      size_t o = base + (size_t)(i * 512 + tid) * 8;
      float4 a = *(const float4*)(src + o), b = *(const float4*)(src + o + 4);
      float v[8] = {a.x, a.y, a.z, a.w, b.x, b.y, b.z, b.w};
      *(uint4*)(dst + o) = pack8(v);
    }
    return;
  }
  {
    float2* rope = (float2*)(ws + OFF_ROPE);
    for (int idx = tid; idx < 1024; idx += 512) {
      int pos = idx >> 4, fi = idx & 15;
      float inv = exp2f(-(float)fi * 0.8304820237218406f);
      float ang = (float)pos * inv;
      float k = rintf(ang * 0.15915494309189535f);
      float r = fmaf(-k, 6.2831854820251465f, ang);
      r = fmaf(-k, -1.7484556e-7f, r);
      rope[idx] = make_float2(__cosf(r), __sinf(r));
    }
    if (tid < 16) {
      int fb = tid >> 3, h = tid & 7;
      float x = (fb ? p.decay_b : p.decay_f)[h];
      float lg = -log1pf(expf(-x)) * LOG2E;
      ((float*)(ws + OFF_LG2))[tid] = lg;
    }
  }
}

DEV float modval(const Params& p, int l, int crow, int n, bool partial) {
  if (!partial) return ((const float*)(p.ws + OFF_MOD))[(size_t)(l * 9 + crow) * 6144 + n];
  const float* mp = (const float*)(p.ws + OFF_MODP);
  float s = p.ada_b[l * 6144 + n];
#pragma unroll
  for (int kq = 0; kq < 8; ++kq) s += mp[((size_t)(kq * 2 + l) * 9 + crow) * 6144 + n];
  return s;
}

DEV void norm_phase(const Params& p, int l, int si, int sci, const float* g, const float* xc, const float* xs, bool partial, unsigned char* smem) {
  int tid = threadIdx.x; asm volatile("" : "+v"(tid)); const int lane = tid & 63, w = tid >> 6;
  float* ssh = (float*)smem; float* ssc = ssh + 1024;
  bf16* H = (bf16*)(p.ws + OFF_R1);
  for (int chunk = blockIdx.x; chunk < 512; chunk += gridDim.x) {
    const int row0 = chunk * 32; const int crow = row0 < 8192 ? 8 : ((row0 - 8192) >> 10);
    float4 v[4][4];
#pragma unroll
    for (int rr = 0; rr < 4; ++rr) {
      const int row = row0 + w * 4 + rr;
      if (xc) {
        const float* xp = row < 8192 ? xc + (size_t)row * 1024 : xs + (size_t)(row - 8192) * 1024;
#pragma unroll
        for (int i = 0; i < 4; ++i) v[rr][i] = *(const float4*)(xp + lane * 4 + 256 * i);
      } else {
        const bf16* xp = (const bf16*)(p.ws + B_XB) + (size_t)row * 1024;
#pragma unroll
        for (int i = 0; i < 4; ++i) { const uint2 q = *(const uint2*)(xp + lane * 4 + 256 * i);
          v[rr][i] = make_float4(__uint_as_float(q.x << 16), __uint_as_float(q.x & 0xffff0000u), __uint_as_float(q.y << 16), __uint_as_float(q.y & 0xffff0000u)); }
      }
    }
    for (int idx = tid; idx < 1024; idx += 512) {
      ssh[idx] = modval(p, l, crow, si * 1024 + idx, partial);
      ssc[idx] = (1.0f + modval(p, l, crow, sci * 1024 + idx, partial)) * g[idx];
    }
    float ss[4];
#pragma unroll
    for (int rr = 0; rr < 4; ++rr) {
      ss[rr] = 0.f;
#pragma unroll
      for (int i = 0; i < 4; ++i) ss[rr] += v[rr][i].x * v[rr][i].x + v[rr][i].y * v[rr][i].y + v[rr][i].z * v[rr][i].z + v[rr][i].w * v[rr][i].w;
    }
#pragma unroll
    for (int o = 1; o < 64; o <<= 1) {
#pragma unroll
      for (int rr = 0; rr < 4; ++rr) ss[rr] += __shfl_xor(ss[rr], o);
    }
    __syncthreads();
#pragma unroll
    for (int rr = 0; rr < 4; ++rr) {
      const int row = row0 + w * 4 + rr;
      const float rstd = rsqrtf(ss[rr] * (1.0f / 1024.0f) + 1e-6f);
#pragma unroll
      for (int i = 0; i < 4; ++i) {
        const int col = lane * 4 + 256 * i;
        float4 sc = *(const float4*)(ssc + col), sh = *(const float4*)(ssh + col);
        uint2 o; o.x = pack2(v[rr][i].x * rstd * sc.x + sh.x, v[rr][i].y * rstd * sc.y + sh.y);
        o.y = pack2(v[rr][i].z * rstd * sc.z + sh.z, v[rr][i].w * rstd * sc.w + sh.w);
        *(uint2*)(H + (size_t)row * 1024 + col) = o;
      }
    }
    __syncthreads();
  }
}

DEV void final_norm_phase(const Params& p) {
  int tid = threadIdx.x; asm volatile("" : "+v"(tid)); const int lane = tid & 63, w = tid >> 6;
  for (int row = blockIdx.x * 8 + w; row < 16384; row += gridDim.x * 8) {
    const bf16* xp = (const bf16*)(p.ws + B_XB) + (size_t)row * 1024;
    float* yp = p.out + (size_t)row * 1024;
    float4 v[4]; float ss = 0.f;
#pragma unroll
    for (int i = 0; i < 4; ++i) { const uint2 q = *(const uint2*)(xp + lane * 4 + 256 * i);
      v[i] = make_float4(__uint_as_float(q.x << 16), __uint_as_float(q.x & 0xffff0000u), __uint_as_float(q.y << 16), __uint_as_float(q.y & 0xffff0000u));
      ss += v[i].x * v[i].x + v[i].y * v[i].y + v[i].z * v[i].z + v[i].w * v[i].w; }
#pragma unroll
    for (int o = 1; o < 64; o <<= 1) ss += __shfl_xor(ss, o);
    const float rstd = rsqrtf(ss * (1.0f / 1024.0f) + 1e-6f);
#pragma unroll
    for (int i = 0; i < 4; ++i) {
      const int col = lane * 4 + 256 * i;
      float4 g = *(const float4*)(p.norm_final + col);
      *(float4*)(yp + col) = make_float4(v[i].x * rstd * g.x, v[i].y * rstd * g.y, v[i].z * rstd * g.z, v[i].w * rstd * g.w);
    }
  }
}

#define CT_LD 132
DEV void gemm_core(const bf16* __restrict__ A, int lda, const bf16* __restrict__ B, int ldb, int kstepB, int K, unsigned char* smem) {
  int tid = threadIdx.x; asm volatile("" : "+v"(tid)); const int lane = tid & 63, w = tid >> 6;
  const int wr = w >> 2, wc = w & 3, lr = lane & 15, lq = lane >> 4;
  bf16* As = (bf16*)smem;
  bf16* Bs = As + 2 * 128 * 72;
  const int ldr = tid >> 3, ldc = (tid & 7) * 8;
  const bf16* Ap = A + (size_t)ldr * lda + ldc;
  const bf16* Bp = B + (size_t)ldr * ldb + ldc;
  {
    uint4 a0 = *(const uint4*)(Ap), a1 = *(const uint4*)(Ap + (size_t)64 * lda), b0 = *(const uint4*)(Bp), b1 = *(const uint4*)(Bp + (size_t)64 * ldb);
    *(uint4*)(As + ldr * 72 + ldc) = a0; *(uint4*)(As + (ldr + 64) * 72 + ldc) = a1;
    *(uint4*)(Bs + ldr * 72 + ldc) = b0; *(uint4*)(Bs + (ldr + 64) * 72 + ldc) = b1;
  }
  __syncthreads();
  f32x4 acc[4][2];
#pragma unroll
  for (int i = 0; i < 4; ++i) { acc[i][0] = (f32x4){0.f, 0.f, 0.f, 0.f}; acc[i][1] = (f32x4){0.f, 0.f, 0.f, 0.f}; }
  const int nk = K >> 6;
  for (int kt = 0; kt < nk; ++kt) {
    const int cur = kt & 1;
    const int kn = (kt + 1 < nk) ? (kt + 1) : kt;
    const bf16* Apk = Ap + kn * 64; const bf16* Bpk = Bp + (size_t)kn * kstepB;
    u32x4 pa0 = gload16(Apk), pa1 = gload16(Apk + (size_t)64 * lda), pb0 = gload16(Bpk), pb1 = gload16(Bpk + (size_t)64 * ldb);
    __builtin_amdgcn_sched_barrier(0);
    const bf16* as = As + cur * 128 * 72 + (wr * 64 + lr) * 72 + lq * 8;
    const bf16* bs = Bs + cur * 128 * 72 + (wc * 32 + lr) * 72 + lq * 8;
#pragma unroll
    for (int ks = 0; ks < 2; ++ks) {
      bf16x8 a[4], b[2];
#pragma unroll
      for (int i = 0; i < 4; ++i) a[i] = *(const bf16x8*)(as + i * 16 * 72 + ks * 32);
#pragma unroll
      for (int i = 0; i < 2; ++i) b[i] = *(const bf16x8*)(bs + i * 16 * 72 + ks * 32);
#pragma unroll
      for (int mi = 0; mi < 4; ++mi)
#pragma unroll
        for (int ni = 0; ni < 2; ++ni) acc[mi][ni] = __builtin_amdgcn_mfma_f32_16x16x32_bf16(a[mi], b[ni], acc[mi][ni], 0, 0, 0);
    }
    __builtin_amdgcn_sched_barrier(0);
    {
      VMWAIT4(pa0, pa1, pb0, pb1);
      bf16* ad = As + (cur ^ 1) * 128 * 72 + ldr * 72 + ldc; bf16* bd = Bs + (cur ^ 1) * 128 * 72 + ldr * 72 + ldc;
      *(u32x4*)(ad) = pa0; *(u32x4*)(ad + 64 * 72) = pa1; *(u32x4*)(bd) = pb0; *(u32x4*)(bd + 64 * 72) = pb1;
    }
    __syncthreads();
  }
  float* Ct = (float*)smem;
#pragma unroll
  for (int mi = 0; mi < 4; ++mi)
#pragma unroll
    for (int ni = 0; ni < 2; ++ni)
#pragma unroll
      for (int j = 0; j < 4; ++j) Ct[(wr * 64 + mi * 16 + lq * 4 + j) * CT_LD + wc * 32 + ni * 16 + lr] = acc[mi][ni][j];
  __syncthreads();
}

#define CT16_LD 264
DEV void ld8h(const bf16* Ct, int r, int c, float* v) {
  const uint4 q = *(const uint4*)(Ct + r * CT16_LD + c);
  v[0] = __uint_as_float(q.x << 16); v[1] = __uint_as_float(q.x & 0xffff0000u); v[2] = __uint_as_float(q.y << 16); v[3] = __uint_as_float(q.y & 0xffff0000u);
  v[4] = __uint_as_float(q.z << 16); v[5] = __uint_as_float(q.z & 0xffff0000u); v[6] = __uint_as_float(q.w << 16); v[7] = __uint_as_float(q.w & 0xffff0000u);
}
DEV float ldh(const bf16* Ct, int r, int c) { return bf2f(Ct[r * CT16_LD + c]); }
DEV void ld8(const float* Ct, int r, int c, float* v) {
  float4 a = *(const float4*)(Ct + r * CT_LD + c), b = *(const float4*)(Ct + r * CT_LD + c + 4);
  v[0] = a.x; v[1] = a.y; v[2] = a.z; v[3] = a.w; v[4] = b.x; v[5] = b.y; v[6] = b.z; v[7] = b.w;
}

template <class F>
DEV void epi_transposed(const bf16* Ct, F dstrow, int tstride) {
  int tid = threadIdx.x; asm volatile("" : "+v"(tid));
#pragma unroll
  for (int i = 0; i < 4; ++i) {
    int idx = tid + 512 * i; int tcl = idx & 3, c = (idx >> 2) & 127, tch = idx >> 9; int tc = tch * 4 + tcl;
    unsigned hv[8];
#pragma unroll
    for (int e = 0; e < 8; ++e) hv[e] = Ct[(tc * 8 + e) * CT16_LD + c];
    uint4 ov; ov.x = hv[0] | (hv[1] << 16); ov.y = hv[2] | (hv[3] << 16); ov.z = hv[4] | (hv[5] << 16); ov.w = hv[6] | (hv[7] << 16);
    *(uint4*)(dstrow(c) + (size_t)(tc >> 3) * tstride + (tc & 7) * 8) = ov;
  }
}

DEV void epi_even(const Params& p, int mt, int nt, const bf16* Ct) {
  int tid = threadIdx.x; asm volatile("" : "+v"(tid));
  const int cg = tid & 15, rg = tid >> 4;
  unsigned char* ws = p.ws;
  const int m0 = mt * 128; const bool lat = m0 >= 8192;
  const int bseq = lat ? ((m0 - 8192) >> 10) : (m0 >> 8);
  const int t0 = lat ? ((m0 - 8192) & 1023) : (m0 & 255);
  int type; int cb;
  if (nt < 4) { type = 0; cb = nt * 128; } else if (nt < 8) { type = 1; cb = (nt - 4) * 128; } else if (nt < 16) { type = 2; cb = (nt - 8) * 128; }
  else if (nt < 24) { type = 3; cb = (nt - 16) * 128; } else if (nt < 28) { type = 4; cb = (nt - 24) * 128; } else if (nt == 28) { type = 5; cb = 0; } else { type = 6; cb = 0; }
  if (type == 2) {
    const int h = nt - 8;
    bf16* base = (bf16*)(ws + B_VRT) + (lat ? (size_t)8192 * 1024 + ((size_t)(bseq * 8 + h) * 16 + (t0 >> 6)) * 8192 : ((size_t)(bseq * 8 + h) * 4 + (t0 >> 6)) * 8192);
    epi_transposed(Ct, [&](int c) { return base + (size_t)c * 64; }, 8192);
  } else if (type == 6) {
    bf16* base = (bf16*)(ws + B_VAT) + (lat ? (size_t)32 * 2 * 64 * 256 : (size_t)0);
    const int ntk = lat ? 16 : 4;
    epi_transposed(Ct, [&](int c) { return base + ((size_t)(bseq * 2 + (c >> 6)) * ntk + (t0 >> 6)) * 4096 + (size_t)(c & 63) * 64; }, 4096);
    if (!lat) {
#pragma unroll
      for (int i = 0; i < 4; ++i) {
        const int r = rg + 32 * i; float v[8]; ld8h(Ct, r, cg * 8, v);
        const int kvh = cg >> 3, d0 = (cg & 7) * 8;
        float* o = p.out + O_GV + ((size_t)(bseq * 2 + kvh) * 256 + t0 + r) * 64 + d0;
        *(float4*)o = make_float4(v[0], v[1], v[2], v[3]); *(float4*)(o + 4) = make_float4(v[4], v[5], v[6], v[7]);
      }
    }
  } else {
    const int j0 = (cg * 8) & 63;
    if (type == 3 || ((type == 0 || type == 1) && !lat)) {
      bf16* dstc; size_t off; int rstride;
      if (type == 3) { dstc = (bf16*)(ws + B_GR); off = (size_t)m0 * 1024 + cb + cg * 8; rstride = 1024; }
      else { dstc = (bf16*)(ws + (type == 0 ? B_QR : B_KR)); off = ((size_t)(bseq * 8 + ((cb + cg * 8) >> 6)) * 256 + t0) * 64 + j0; rstride = 64; }
#pragma unroll
      for (int i = 0; i < 4; ++i) { const int r = rg + 32 * i; *(uint4*)(dstc + off + (size_t)r * rstride) = *(const uint4*)(Ct + r * CT16_LD + cg * 8); }
    } else {
    const float2* rope = (const float2*)(ws + OFF_ROPE);
    const bool dorope = lat && (type == 0 || type == 1 || type == 4 || type == 5);
    float gain[8], pgain[8];
#pragma unroll
    for (int e = 0; e < 8; ++e) { gain[e] = 1.f; pgain[e] = 1.f; }
    if (type == 4 || type == 5) {
      const float* gp = (type == 4) ? p.q_norm : p.k_norm;
#pragma unroll
      for (int e = 0; e < 8; ++e) { gain[e] = gp[j0 + e]; pgain[e] = gp[(j0 ^ 16) + e]; }
    }
    bf16* dst; int nh;
    if (type == 0) { dst = (bf16*)(ws + B_QR); nh = 8; } else if (type == 1) { dst = (bf16*)(ws + B_KR); nh = 8; }
    else if (type == 3) { dst = (bf16*)(ws + B_GR); nh = 0; } else if (type == 4) { dst = (bf16*)(ws + B_QA); nh = 8; } else { dst = (bf16*)(ws + B_KA); nh = 2; }
    const int hh = (cb + cg * 8) >> 6;
    const size_t hbase = lat ? (size_t)8192 * 64 * nh + ((size_t)(bseq * nh + hh) * 1024 + t0) * 64 : ((size_t)(bseq * nh + hh) * 256 + t0) * 64;
#pragma unroll
    for (int i = 0; i < 4; ++i) {
      const int r = rg + 32 * i; const int row = m0 + r;
      float v[8]; ld8h(Ct, r, cg * 8, v);
      float mul = 1.0f;
      if (type == 4 || type == 5) {
        float ss = 0.f;
#pragma unroll
        for (int e = 0; e < 8; ++e) ss += v[e] * v[e];
        ss += __shfl_xor(ss, 1); ss += __shfl_xor(ss, 2); ss += __shfl_xor(ss, 4);
        mul = rsqrtf(ss * (1.0f / 64.0f) + 1e-6f);
      }
#pragma unroll
      for (int e = 0; e < 8; ++e) v[e] *= mul * gain[e];
      if (type == 5 && !lat) {
        const int kvh = cg >> 3;
        float* o = p.out + O_GK + ((size_t)(bseq * 2 + kvh) * 256 + t0 + r) * 64 + j0;
        *(float4*)o = make_float4(v[0], v[1], v[2], v[3]); *(float4*)(o + 4) = make_float4(v[4], v[5], v[6], v[7]);
      }
      if (dorope) {
        float pv[8]; ld8h(Ct, r, (cg * 8) ^ 16, pv);
        const int t = t0 + r; const int pos = (j0 & 32) ? (t & 63) : (t >> 6); const int f0 = j0 & 15;
        const float sgn = (j0 & 16) ? 1.0f : -1.0f;
#pragma unroll
        for (int e = 0; e < 8; ++e) {
          float2 cs = rope[pos * 16 + f0 + e];
          float pe = pv[e] * mul * pgain[e];
          v[e] = v[e] * cs.x + sgn * pe * cs.y;
        }
      }
      if (nh) *(uint4*)(dst + hbase + (size_t)r * 64 + j0) = pack8(v);
      else *(uint4*)(dst + (size_t)row * 1024 + cb + cg * 8) = pack8(v);
    }
    }
    if (type == 1 && !lat) {
      const float* lg2 = (const float*)(ws + OFF_LG2);
      bf16* base = (bf16*)(ws + B_KTFB);
#pragma unroll
      for (int i = 0; i < 4; ++i) {
        int idx = tid + 512 * i; int tcl = idx & 3, c = (idx >> 2) & 127, tch = idx >> 9; int tc = tch * 4 + tcl;
        const int h = (nt - 4) * 2 + (c >> 6), d = c & 63;
        const float lgf = lg2[h], lgb = lg2[8 + h];
        float f[8], g[8];
#pragma unroll
        for (int e = 0; e < 8; ++e) {
          const int tt = t0 + tc * 8 + e; const float val = ldh(Ct, tc * 8 + e, c);
          f[e] = val * fexp2(lgf * (float)(255 - tt)); g[e] = val * fexp2(lgb * (float)tt);
        }
        bf16* o = base + (((size_t)(bseq * 8 + h) * 2) * 64 + d) * 256 + t0 + tc * 8;
        *(uint4*)o = pack8(f); *(uint4*)(o + 64 * 256) = pack8(g);
      }
    }
  }
}

DEV void epi_odd(const Params& p, int mt, int nt, const bf16* Ct) {
  int tid = threadIdx.x; asm volatile("" : "+v"(tid));
  const int cg = tid & 15, rg = tid >> 4;
  unsigned char* ws = p.ws;
  const int m0 = mt * 128; const bool lat = m0 >= 8192;
  const int bseq = lat ? ((m0 - 8192) >> 10) : (m0 >> 8);
  const int t0 = lat ? ((m0 - 8192) & 1023) : (m0 & 255);
  if (nt < 16) {
    bf16* dst = (bf16*)(ws + (nt < 8 ? B_Q : B_K));
    const int hh = (nt & 7) * 2 + (cg >> 3), dd0 = (cg & 7) * 8;
    const size_t hbase = lat ? (size_t)8192 * 1024 + ((size_t)(bseq * 16 + hh) * 1024 + t0) * 64 : ((size_t)(bseq * 16 + hh) * 256 + t0) * 64;
#pragma unroll
    for (int i = 0; i < 4; ++i) {
      const int r = rg + 32 * i;
      *(uint4*)(dst + hbase + (size_t)r * 64 + dd0) = *(const uint4*)(Ct + r * CT16_LD + cg * 8);
      if (nt >= 8 && !lat) {
        float v[8]; ld8h(Ct, r, cg * 8, v);
        const int h = (nt - 8) * 2 + (cg >> 3), d0 = (cg & 7) * 8;
        float* o = p.out + O_NK + ((size_t)(bseq * 16 + h) * 256 + t0 + r) * 64 + d0;
        *(float4*)o = make_float4(v[0], v[1], v[2], v[3]); *(float4*)(o + 4) = make_float4(v[4], v[5], v[6], v[7]);
      }
    }
  } else {
    const int h0 = (nt - 16) * 2;
    bf16* base = (bf16*)(ws + B_VT) + (lat ? (size_t)8192 * 1024 : (size_t)0);
    const int ntk = lat ? 16 : 4;
    epi_transposed(Ct, [&](int c) { return base + ((size_t)(bseq * 16 + h0 + (c >> 6)) * ntk + (t0 >> 6)) * 4096 + (size_t)(c & 63) * 64; }, 4096);
    if (!lat) {
#pragma unroll
      for (int i = 0; i < 4; ++i) {
        const int r = rg + 32 * i; float v[8]; ld8h(Ct, r, cg * 8, v);
        const int h = h0 + (cg >> 3), d0 = (cg & 7) * 8;
        float* o = p.out + O_NV + ((size_t)(bseq * 16 + h) * 256 + t0 + r) * 64 + d0;
        *(float4*)o = make_float4(v[0], v[1], v[2], v[3]); *(float4*)(o + 4) = make_float4(v[4], v[5], v[6], v[7]);
      }
    }
  }
}

DEV void epi_resid(const Params& p, int mt, int nt, const bf16* Ct, int l, int gi_, const float* xc, const float* xs) {
  int tid = threadIdx.x; asm volatile("" : "+v"(tid));
  const int cg = tid & 15, rg = tid >> 4;
  const bool ob = (gi_ & 16) != 0; const int gi = gi_ & 15;
  const int m0 = mt * 128; const int col = nt * 128 + cg * 8;
  const int crow = m0 < 8192 ? 8 : ((m0 - 8192) >> 10);
  const float* gp = (const float*)(p.ws + OFF_MOD) + (size_t)(l * 9 + crow) * 6144 + gi * 1024 + col;
  const float4 g0 = *(const float4*)gp, g1 = *(const float4*)(gp + 4);
  bf16* xb = (bf16*)(p.ws + B_XB);
#pragma unroll
  for (int i = 0; i < 4; ++i) {
    const int r = rg + 32 * i; const int row = m0 + r; float v[8]; ld8h(Ct, r, cg * 8, v);
    float x[8];
    if (xc) {
      const float* xp = (row < 8192 ? xc + (size_t)row * 1024 : xs + (size_t)(row - 8192) * 1024) + col;
      const float4 a = *(const float4*)xp, b = *(const float4*)(xp + 4);
      x[0] = a.x; x[1] = a.y; x[2] = a.z; x[3] = a.w; x[4] = b.x; x[5] = b.y; x[6] = b.z; x[7] = b.w;
    } else {
      const uint4 q = *(const uint4*)(xb + (size_t)row * 1024 + col);
      x[0] = __uint_as_float(q.x << 16); x[1] = __uint_as_float(q.x & 0xffff0000u); x[2] = __uint_as_float(q.y << 16); x[3] = __uint_as_float(q.y & 0xffff0000u);
      x[4] = __uint_as_float(q.z << 16); x[5] = __uint_as_float(q.z & 0xffff0000u); x[6] = __uint_as_float(q.w << 16); x[7] = __uint_as_float(q.w & 0xffff0000u);
    }
    x[0] += g0.x * v[0]; x[1] += g0.y * v[1]; x[2] += g0.z * v[2]; x[3] += g0.w * v[3];
    x[4] += g1.x * v[4]; x[5] += g1.y * v[5]; x[6] += g1.z * v[6]; x[7] += g1.w * v[7];
    if (ob) *(uint4*)(xb + (size_t)row * 1024 + col) = pack8(x);
    else {
      float* o = p.out + (size_t)row * 1024 + col;
      *(float4*)o = make_float4(x[0], x[1], x[2], x[3]);
      *(float4*)(o + 4) = make_float4(x[4], x[5], x[6], x[7]);
    }
  }
}

DEV void epi_ffn_up_unit(const Params& p, int pm, int pn, const bf16* Ct, int l) {
  int tid = threadIdx.x; asm volatile("" : "+v"(tid));
  const int cgp = tid & 15, rgp = tid >> 4;
  const int bj = cgp >> 3, j0 = (cgp & 7) * 8;
  const int ca = bj * 128 + j0;
  const int oc = (2 * pn + bj) * 64 + j0;
  const bool lat = pm >= 32;
  const bool firstu = !lat || ((pm & 3) == 0), lastu = !lat || ((pm & 3) == 3);
  const float* cw = p.conv_w + (size_t)l * 3 * 5632; const float* cbp = p.conv_b + (size_t)l * 5632;
  float wa0[8], wa1[8], wa2[8], wab[8], wg0[8], wg1[8], wg2[8], wgb[8];
#pragma unroll
  for (int e = 0; e < 8; ++e) {
    wa0[e] = cw[oc + e]; wa1[e] = cw[5632 + oc + e]; wa2[e] = cw[2 * 5632 + oc + e]; wab[e] = cbp[oc + e];
    wg0[e] = cw[2816 + oc + e]; wg1[e] = cw[5632 + 2816 + oc + e]; wg2[e] = cw[2 * 5632 + 2816 + oc + e]; wgb[e] = cbp[2816 + oc + e];
  }
  bf16* act = (bf16*)(p.ws + B_ACT);
  const int r0 = rgp * 8;
  float ap[8], ac[8], an[8], gp[8], gc[8], gn[8];
  if (r0 > 0) { ld8h(Ct, r0 - 1, ca, ap); ld8h(Ct, r0 - 1, ca + 64, gp); }
  else {
#pragma unroll
    for (int e = 0; e < 8; ++e) { ap[e] = 0.f; gp[e] = 0.f; }
  }
  ld8h(Ct, r0, ca, ac); ld8h(Ct, r0, ca + 64, gc);
#pragma unroll
  for (int i = 0; i < 8; ++i) {
    const int r = r0 + i;
    if (r < 255) { ld8h(Ct, r + 1, ca, an); ld8h(Ct, r + 1, ca + 64, gn); }
    else {
#pragma unroll
      for (int e = 0; e < 8; ++e) { an[e] = 0.f; gn[e] = 0.f; }
    }
    const bool skip = (r == 0 && !firstu) || (r == 255 && !lastu);
    if (!skip) {
      float res[8];
#pragma unroll
      for (int e = 0; e < 8; ++e) {
        const float a = wab[e] + wa0[e] * ap[e] + wa1[e] * ac[e] + wa2[e] * an[e];
        const float g = wgb[e] + wg0[e] * gp[e] + wg1[e] * gc[e] + wg2[e] * gn[e];
        res[e] = silu_f(a) * g;
      }
      *(uint4*)(act + (size_t)(pm * 256 + r) * 2816 + oc) = pack8(res);
    }
#pragma unroll
    for (int e = 0; e < 8; ++e) { ap[e] = ac[e]; ac[e] = an[e]; gp[e] = gc[e]; gc[e] = gn[e]; }
  }
  if (lat) {
    float* halo = (float*)(p.ws + B_HALO);
    for (int idx = tid; idx < 1024; idx += 512) {
      const int hr = idx >> 8, c = idx & 255; const int r = (hr < 2) ? hr : 252 + hr;
      halo[((size_t)(pm * 4 + hr)) * 5632 + pn * 256 + c] = ldh(Ct, r, c);
    }
  }
}

DEV void ffn_seam_rows(const Params& p, int l, int pm) {
  if (pm < 32) return;
  int tid = threadIdx.x; asm volatile("" : "+v"(tid));
  const float* cw = p.conv_w + (size_t)l * 3 * 5632; const float* cbp = p.conv_b + (size_t)l * 5632;
  const float* halo = (const float*)(p.ws + B_HALO);
  bf16* act = (bf16*)(p.ws + B_ACT);
#pragma unroll 1
  for (int which = 0; which < 2; ++which) {
    if (which == 0 ? ((pm & 3) == 0) : ((pm & 3) == 3)) continue;
    const float *up, *uc, *un; int row;
    if (which == 0) { up = halo + (size_t)((pm - 1) * 4 + 3) * 5632; uc = halo + (size_t)(pm * 4 + 0) * 5632; un = halo + (size_t)(pm * 4 + 1) * 5632; row = pm * 256; }
    else { up = halo + (size_t)(pm * 4 + 2) * 5632; uc = halo + (size_t)(pm * 4 + 3) * 5632; un = halo + (size_t)((pm + 1) * 4 + 0) * 5632; row = pm * 256 + 255; }
    for (int j = tid; j < 2816; j += 512) {
      const int ca = (j >> 6) * 128 + (j & 63), cgi = ca + 64;
      const float a = cbp[j] + cw[j] * up[ca] + cw[5632 + j] * uc[ca] + cw[2 * 5632 + j] * un[ca];
      const float g = cbp[2816 + j] + cw[2816 + j] * up[cgi] + cw[5632 + 2816 + j] * uc[cgi] + cw[2 * 5632 + 2816 + j] * un[cgi];
      act[(size_t)row * 2816 + j] = f2bf(silu_f(a) * g);
    }
  }
  asm volatile("s_waitcnt vmcnt(0)" ::: "memory");
  __syncthreads();
}

DEV void epi_state(const Params& p, int b, int h, const float* Ct) {
  int tid = threadIdx.x; asm volatile("" : "+v"(tid)); const int cg = tid & 15, rg = tid >> 4;
#pragma unroll 1
  for (int i = 0; i < 4; ++i) {
    const int r = rg + 32 * i; float v[8]; ld8(Ct, r, cg * 8, v);
    float* o = p.out + (r < 64 ? O_SF : O_SB) + ((size_t)(b * 8 + h) * 64 + (r & 63)) * 128 + cg * 8;
    *(float4*)o = make_float4(v[0], v[1], v[2], v[3]); *(float4*)(o + 4) = make_float4(v[4], v[5], v[6], v[7]);
  }
  __syncthreads();
}

namespace pg8 {
#define PG8_LAS __attribute__((address_space(3)))
typedef unsigned short bf16_t;
typedef short bf16x8 __attribute__((ext_vector_type(8)));
typedef float f32x4 __attribute__((ext_vector_type(4)));
typedef unsigned u32x4 __attribute__((ext_vector_type(4)));
constexpr int BM = 256, BK = 64, HALF = 128, HTB = HALF * BK * 2  , STAGE_BYTES = 8 * HTB, NXCD = 8, WGM = 8;

__host__ __device__ __forceinline__ int lds_byte(int r, int c) { const int st = (r >> 4) * 2 + (c >> 5), rr = r & 15, cc = c & 31, ob = rr * 64 + cc * 2; return st * 1024 + (ob ^ (((ob >> 9) & 1) << 5)); }
__host__ __device__ __forceinline__ void stage_rc(int b, int& R, int& C) { const int st = b / 1024, sb = b % 1024, swz = sb ^ (((sb >> 9) & 1) << 5); R = (st >> 1) * 16 + swz / 64; C = (st & 1) * 32 + (swz % 64) / 2; }
__host__ __device__ __forceinline__ int perm32(int rho) { const int n = rho >> 4, i = rho & 15; return 8 * (i >> 2) + 4 * n + (i & 3); }

struct Unit { int pm, pn; };
struct Gemm { const bf16_t* A; const bf16_t* Bt; int M, N, K; };

struct StaticOrder {
    int nM, nN, nwg, G, c;
    __host__ __device__ void init(int M, int N, int G_, int c_) { nM = M / BM; nN = N / BM; nwg = nM * nN; G = G_; c = c_; }
    __host__ __device__ bool next(int i, Unit& u) const {
        const long L = (long)i * G + c; if (L >= nwg) return false;
        int wgid = (int)L; { const int q = nwg / NXCD, r = nwg % NXCD, xcd = wgid % NXCD, off = wgid / NXCD; wgid = (xcd < r ? xcd * (q + 1) : r * (q + 1) + (xcd - r) * q) + off; }
        const int nig = WGM * nN, gid = wgid / nig, fm = gid * WGM, gsz = (nM - fm) < WGM ? (nM - fm) : WGM;
        u.pm = fm + ((wgid % nig) % gsz); u.pn = (wgid % nig) / gsz; return true;
    }
    __device__ __forceinline__ void a_ready(const Unit&) const {}
    __device__ __forceinline__ void done(const Unit&) const {}
};
template <class Epi, class Sched, bool STAMP = false>
__device__ __forceinline__ void gemm_phase(PG8_LAS unsigned char* lds, const Gemm g, const Sched& S, const Epi& E, unsigned long long* stamps) {
    int tid = threadIdx.x; asm volatile("" : "+v"(tid)); const int wid = __builtin_amdgcn_readfirstlane(tid >> 6), lane = tid & 63, wr = wid >> 2, wc = wid & 3, fr = lane & 15, fq = lane >> 4;
    const int K = g.K, nt = K / BK;
    int ts_lo = 0, ts_hi = 0, nts = 0; const unsigned long long rt_entry = STAMP ? (unsigned long long)wall_clock64() : 0ull;
#define PG8_STAMP() do { if (STAMP && wid == 0 && nts < 64) { const unsigned long long _c = (unsigned long long)clock64(); \
        ts_lo = (lane == nts) ? (int)(unsigned)_c : ts_lo; ts_hi = (lane == nts) ? (int)(unsigned)(_c >> 32) : ts_hi; ++nts; } } while (0)
    PG8_STAMP();
    unsigned voffA[2], voffB[2];
#pragma unroll
    for (int i = 0; i < 2; ++i) { int R, C; stage_rc(tid * 16 + i * 8192, R, C); const int Rb = Epi::PERM ? ((R & ~31) + perm32(R & 31)) : R;
        voffA[i] = (unsigned)(R * K + C) * 2u; voffB[i] = (unsigned)(Rb * K + C) * 2u; }
    const size_t kstep = (size_t)(BK * 2);
    const size_t hstep = (size_t)HALF * K * 2;
    const size_t tstep = 2 * hstep;
    const unsigned ldsw = (unsigned)wid * 1024u;
    const int aoff = lds_byte(wr * 64 + fr, fq * 8), boff = lds_byte(wc * 32 + fr, fq * 8);
#define PG8_SA(b, h) (((b) * 2 + (h)) * HTB)
#define PG8_SB(b, h) ((4 + (b) * 2 + (h)) * HTB)
#define PG8_STAGE(bufoff, gbase, voff) do { _Pragma("unroll") for (int _i = 0; _i < 2; ++_i) \
        __builtin_amdgcn_global_load_lds((const unsigned*)((const char*)(gbase) + (voff)[_i]), (PG8_LAS unsigned*)(lds + (bufoff) + ldsw + _i * 8192), 16, 0, 0); } while (0)
#define PG8_LDA(dst, b, h) do { _Pragma("unroll") for (int m = 0; m < 4; ++m) _Pragma("unroll") for (int k = 0; k < 2; ++k) dst[m][k] = *(const PG8_LAS bf16x8*)(lds + PG8_SA(b, h) + aoff + m * 2048 + k * 1024); } while (0)
#define PG8_LDB(dst, b, h) do { _Pragma("unroll") for (int n = 0; n < 2; ++n) _Pragma("unroll") for (int k = 0; k < 2; ++k) dst[n][k] = *(const PG8_LAS bf16x8*)(lds + PG8_SB(b, h) + boff + n * 2048 + k * 1024); } while (0)
#define PG8_MMA(ai, bj, At, Bt) do { __builtin_amdgcn_s_setprio(1); _Pragma("unroll") for (int m = 0; m < 4; ++m) _Pragma("unroll") for (int n = 0; n < 2; ++n) _Pragma("unroll") for (int k = 0; k < 2; ++k) \
        acc[ai][bj][m][n] = __builtin_amdgcn_mfma_f32_16x16x32_bf16(Bt[n][k], At[m][k], acc[ai][bj][m][n], 0, 0, 0); __builtin_amdgcn_s_setprio(0); } while (0)
#define PG8_WAIT_V(n) asm volatile("s_waitcnt vmcnt(" #n ")" ::: "memory")
#define PG8_WAIT_L(n) asm volatile("s_waitcnt lgkmcnt(" #n ")" ::: "memory")
#define PG8_BAR __builtin_amdgcn_s_barrier()
#define PG8_SCHED __builtin_amdgcn_sched_barrier(0)
    Unit cur, nxt; int ui = 0;
    if (!S.next(0, cur)) return;
    f32x4 acc[2][2][4][2];
#pragma unroll
    for (int a = 0; a < 2; ++a)
#pragma unroll
        for (int b = 0; b < 2; ++b)
#pragma unroll
            for (int m = 0; m < 4; ++m)
#pragma unroll
                for (int n = 0; n < 2; ++n) acc[a][b][m][n] = (f32x4){0.f, 0.f, 0.f, 0.f};
    bf16x8 At[4][2], B0[2][2], B1[2][2];
    const char* cA = (const char*)g.A + (size_t)cur.pm * tstep; const char* cB = (const char*)g.Bt + (size_t)cur.pn * tstep;
    S.a_ready(cur);
    PG8_STAGE(PG8_SB(0, 0), cB, voffB); PG8_STAGE(PG8_SA(0, 0), cA, voffA); PG8_STAGE(PG8_SB(0, 1), cB + hstep, voffB); PG8_STAGE(PG8_SA(0, 1), cA + hstep, voffA);
    if (wr == 1) PG8_BAR;
    PG8_WAIT_V(4); PG8_BAR;
    PG8_STAGE(PG8_SB(1, 0), cB + kstep, voffB); PG8_STAGE(PG8_SA(1, 0), cA + kstep, voffA); PG8_STAGE(PG8_SB(1, 1), cB + hstep + kstep, voffB);
    PG8_WAIT_V(6); PG8_BAR;
    PG8_STAMP();
    for (;;) {
        const bool has_next = S.next(ui + 1, nxt);
        const char* nA = has_next ? (const char*)g.A + (size_t)nxt.pm * tstep : cA; const char* nB = has_next ? (const char*)g.Bt + (size_t)nxt.pn * tstep : cB;
        for (int t = 0; t < nt; t += 2) {
            const bool last = (t == nt - 2);
            const char* a1 = cA + (size_t)(t + 1) * kstep;
            const char* a2 = last ? nA : cA + (size_t)(t + 2) * kstep; const char* b2 = last ? nB : cB + (size_t)(t + 2) * kstep;
            const char* a3 = a2 + kstep; const char* b3 = b2 + kstep;
            if (last && has_next) S.a_ready(nxt);
            PG8_LDB(B0, 0, 0); PG8_SCHED; PG8_LDA(At, 0, 0); PG8_STAGE(PG8_SA(1, 1), a1 + hstep, voffA);
            PG8_WAIT_L(8); PG8_BAR; PG8_WAIT_L(0); PG8_MMA(0, 0, At, B0); PG8_BAR; PG8_SCHED;
            PG8_LDB(B1, 0, 1); PG8_STAGE(PG8_SB(0, 0), b2, voffB);
            PG8_BAR; PG8_WAIT_L(0); PG8_MMA(0, 1, At, B1); PG8_BAR;
            PG8_LDA(At, 0, 1); PG8_STAGE(PG8_SA(0, 0), a2, voffA);
            PG8_BAR; PG8_WAIT_L(0); PG8_MMA(1, 0, At, B0); PG8_BAR; PG8_SCHED;
            PG8_STAGE(PG8_SB(0, 1), b2 + hstep, voffB);
            PG8_WAIT_V(6); PG8_BAR; PG8_MMA(1, 1, At, B1); PG8_BAR;
            PG8_LDB(B0, 1, 0); PG8_SCHED; PG8_LDA(At, 1, 0); PG8_STAGE(PG8_SA(0, 1), a2 + hstep, voffA);
            PG8_WAIT_L(8); PG8_BAR; PG8_WAIT_L(0); PG8_MMA(0, 0, At, B0); PG8_BAR; PG8_SCHED;
            PG8_LDB(B1, 1, 1); PG8_STAGE(PG8_SB(1, 0), b3, voffB);
            PG8_BAR; PG8_WAIT_L(0); PG8_MMA(0, 1, At, B1); PG8_BAR;
            PG8_LDA(At, 1, 1); PG8_STAGE(PG8_SA(1, 0), a3, voffA);
            PG8_BAR; PG8_WAIT_L(0); PG8_MMA(1, 0, At, B0); PG8_BAR; PG8_SCHED;
            PG8_STAGE(PG8_SB(1, 1), b3 + hstep, voffB);
            PG8_WAIT_V(6); PG8_BAR; PG8_MMA(1, 1, At, B1); PG8_BAR;
        }
        PG8_STAMP();
        if constexpr (!Epi::AFTER_DRAIN) { E(acc, cur, wr, wc, fr, fq); S.done(cur); }
        PG8_STAMP();
        if (!has_next) break;
#pragma unroll
        for (int a = 0; a < 2; ++a)
#pragma unroll
            for (int b = 0; b < 2; ++b)
#pragma unroll
                for (int m = 0; m < 4; ++m)
#pragma unroll
                    for (int n = 0; n < 2; ++n) acc[a][b][m][n] = (f32x4){0.f, 0.f, 0.f, 0.f};
        cur = nxt; cA = nA; cB = nB; ++ui;
    }
    PG8_WAIT_V(0);
    if (wr == 0) PG8_BAR;
    PG8_BAR;
    if constexpr (Epi::AFTER_DRAIN) { E.fused(acc, cur, wr, wc, fr, fq, lds, wid, lane); S.done(cur); }
    PG8_STAMP();
    if (STAMP && wid == 0) { stamps[lane] = lane < nts ? (((unsigned long long)(unsigned)ts_hi << 32) | (unsigned)ts_lo) : 0ull;
        if (lane == 62) stamps[62] = rt_entry; if (lane == 63) stamps[63] = (unsigned long long)wall_clock64(); }
#undef PG8_STAMP
#undef PG8_SA
#undef PG8_SB
#undef PG8_STAGE
#undef PG8_LDA
#undef PG8_LDB
#undef PG8_MMA
#undef PG8_WAIT_V
#undef PG8_WAIT_L
#undef PG8_BAR
#undef PG8_SCHED
}
}

struct OneUnit {
  pg8::Unit u;
  DEV bool next(int i, pg8::Unit& o) const { if (i != 0) return false; o = u; return true; }
  DEV void a_ready(const pg8::Unit&) const {}
  DEV void done(const pg8::Unit&) const {}
};
template <int EPI>
struct EpiStage {
  static constexpr bool PERM = false, AFTER_DRAIN = true;
  const Params* p; unsigned char* smem; int l, gi; const float* xc; const float* xs;
  const bf16* A; const bf16* B; int K, npm, npn;
  DEV void fused(pg8::f32x4 (&acc)[2][2][4][2], const pg8::Unit& u, int wr, int wc, int fr, int fq, PG8_LAS unsigned char* lds, int wid, int lane) const {
    unsigned pf0 = 0u, pf1 = 0u;
    if (npm >= 0) {
      const int t_ = threadIdx.x;
      const bf16* pa = A + ((size_t)(npm * 256 + (t_ >> 1)) * K + (t_ & 1) * 64);
      const bf16* pb = B + ((size_t)(npn * 256 + (t_ >> 1)) * K + (t_ & 1) * 64);
      asm volatile("global_load_dword %0, %1, off" : "=v"(pf0) : "v"(pa) : "memory");
      asm volatile("global_load_dword %0, %1, off" : "=v"(pf1) : "v"(pb) : "memory");
    }
    bf16* Ct = (bf16*)smem;
    int ctoff = (wr * 64 + fr) * CT16_LD + wc * 32 + fq * 4; asm volatile("" : "+v"(ctoff));
#pragma unroll
    for (int ai = 0; ai < 2; ++ai)
#pragma unroll
      for (int bj = 0; bj < 2; ++bj)
#pragma unroll
        for (int m = 0; m < 4; ++m)
#pragma unroll
          for (int n = 0; n < 2; ++n) {
            uint2 pk; pk.x = pack2(acc[ai][bj][m][n][0], acc[ai][bj][m][n][1]); pk.y = pack2(acc[ai][bj][m][n][2], acc[ai][bj][m][n][3]);
            *(uint2*)(Ct + ctoff + (ai * 128 + m * 16) * CT16_LD + bj * 128 + n * 16) = pk;
          }
    __syncthreads();
    if (EPI == 3) epi_ffn_up_unit(*p, u.pm, u.pn, Ct, l);
    else
#pragma unroll 1
    for (int q = 0; q < 4; ++q) {
      const int ai = q >> 1, bj = q & 1;
      const int mt = 2 * u.pm + ai, nt = 2 * u.pn + bj;
      const bf16* Cq = Ct + ai * 128 * CT16_LD + bj * 128;
      if (EPI == 0) epi_even(*p, mt, nt, Cq);
      else if (EPI == 1) epi_odd(*p, mt, nt, Cq);
      else epi_resid(*p, mt, nt, Cq, l, gi, xc, xs);
    }
    asm volatile("s_waitcnt vmcnt(0)" : "+v"(pf0), "+v"(pf1) : : "memory");
    __syncthreads();
  }
};

template <int EPI>
DEV void gemm_phase(const Params& p, const bf16* A, const bf16* B, int K, int N, int l, int gi, const float* xc, const float* xs, unsigned char* smem) {
  pg8::StaticOrder so; so.init(16384, N, (int)gridDim.x, (int)blockIdx.x);
  pg8::Gemm g; g.A = A; g.Bt = B; g.M = 16384; g.N = N; g.K = K;
  EpiStage<EPI> E; E.p = &p; E.smem = smem; E.l = l; E.gi = gi; E.xc = xc; E.xs = xs; E.A = A; E.B = B; E.K = K;
  for (int it = 0;; ++it) {
    OneUnit S;
    if (!so.next(it, S.u)) break;
    if (EPI == 2 && K == 2816) ffn_seam_rows(p, l, S.u.pm);
    { pg8::Unit nu; if (so.next(it + 1, nu)) { E.npm = nu.pm; E.npn = nu.pn; } else { E.npm = -1; E.npn = -1; } }
    pg8::gemm_phase<EpiStage<EPI>, OneUnit, false>((PG8_LAS unsigned char*)smem, g, S, E, nullptr);
  }
  if (EPI == 0) p0_weight_tail(p, 0, 64 * (N / 256), smem);
  if (EPI == 3 && l == 0) p0_weight_tail(p, 1, 64 * (N / 256), smem);
}

struct AttnArgs {
  const bf16* q; int ldq;
  const bf16* k0; const bf16* vt0; int ldk0, ldvt0, n0;
  const bf16* k1; const bf16* vt1; int ldk1, ldvt1, n1;
  const bf16* vt2; int ldvt2, n2;
  float scale;
  int qpos0, seqN; float lgf, lgb;
  int r0, lo;
  bf16* out; int ldo;
  const bf16* gr; const float* gn; int tok0; int h;
};


struct AttRegs { u32x4 k0, v0, v1; int ident; };
template <int NV>
DEV void att_load(const AttnArgs& a, int ti, int tid8, AttRegs& R) {
  const bf16* kp; const bf16* vp;
  if (ti < a.n0) { kp = a.k0 + (size_t)ti * 4096; vp = a.vt0 + (size_t)ti * (NV * 4096); }
  else if (ti < a.n0 + a.n1) { const int j = ti - a.n0; kp = a.k1 ? a.k1 + (size_t)j * 4096 : (const bf16*)0; vp = a.vt1 + (size_t)j * (NV * 4096); }
  else { const int j = ti - a.n0 - a.n1; kp = (const bf16*)0; vp = a.vt2 + (size_t)j * (NV * 4096); }
  R.ident = (kp == (const bf16*)0) ? 1 : 0;
  const bf16* ksrc = kp ? kp + tid8 : vp + tid8;
  R.k0 = gload16(ksrc);
  R.v0 = gload16(vp + tid8);
  if (NV > 1) R.v1 = gload16(vp + tid8 + 4096);
}
template <int DV, int NV, int WAITN>
DEV void att_store(bf16* Ks, bf16* Vs, int buf, int krow, int kch, AttRegs& R) {
  if (NV > 1) asm volatile("s_waitcnt vmcnt(%3)" : "+v"(R.k0), "+v"(R.v0), "+v"(R.v1) : "n"(WAITN) : "memory");
  else asm volatile("s_waitcnt vmcnt(%2)" : "+v"(R.k0), "+v"(R.v0) : "n"(WAITN) : "memory");
  u32x4 kv = R.k0;
  if (R.ident) {
    const int d = krow - kch * 8; const unsigned one = (d & 1) ? 0x3F800000u : 0x00003F80u; const bool in = (d >= 0 && d < 8);
    kv.x = (in && (d >> 1) == 0) ? one : 0u; kv.y = (in && (d >> 1) == 1) ? one : 0u; kv.z = (in && (d >> 1) == 2) ? one : 0u; kv.w = (in && (d >> 1) == 3) ? one : 0u;
  }
  *(u32x4*)(Ks + buf * 64 * 72 + krow * 72 + kch * 8) = kv;
  bf16* vd = Vs + buf * DV * 72 + krow * 72 + kch * 8;
  *(u32x4*)(vd) = R.v0;
  if (NV > 1) *(u32x4*)(vd + 64 * 72) = R.v1;
}

template <int V> struct IntTag { static constexpr int value = V; };
DEV void store_pair16(bf16* rowp  , int lq, uint2 ve, uint2 vo) {
  const bool odd = (lq & 1) != 0;
  uint2 snd = odd ? ve : vo, rcv;
  rcv.x = (unsigned)__shfl_xor((int)snd.x, 16); rcv.y = (unsigned)__shfl_xor((int)snd.y, 16);
  uint4 q;
  if (!odd) { q.x = ve.x; q.y = ve.y; q.z = rcv.x; q.w = rcv.y; }
  else { q.x = rcv.x; q.y = rcv.y; q.z = vo.x; q.w = vo.y; }
  *(uint4*)(rowp + (odd ? 16 : 0) + (lq & ~1) * 4) = q;
}
template <int DV, int MODE>
DEV void attn_item(const AttnArgs& a, unsigned char* smem, const float* rpbs) {
  constexpr int NB = DV / 16, NV = DV / 64;
  int tid = threadIdx.x; asm volatile("" : "+v"(tid)); const int lane = tid & 63, w = __builtin_amdgcn_readfirstlane(tid >> 6), lr = lane & 15, lq = lane >> 4;
  bf16* Ks = (bf16*)smem;
  bf16* Vs = Ks + 2 * 64 * 72;
  const int ntiles = a.n0 + a.n1 + a.n2;
  bf16x8 qf[2][2];
#pragma unroll
  for (int rb = 0; rb < 2; ++rb)
#pragma unroll
    for (int ds = 0; ds < 2; ++ds) qf[rb][ds] = *(const bf16x8*)(a.q + (size_t)(w * 32 + rb * 16 + lr) * a.ldq + ds * 32 + lq * 8);
  f32x4 o[NB][2];
#pragma unroll
  for (int nb = 0; nb < NB; ++nb) { o[nb][0] = (f32x4){0.f, 0.f, 0.f, 0.f}; o[nb][1] = (f32x4){0.f, 0.f, 0.f, 0.f}; }
  float mrow[2] = {-1e30f, -1e30f}, lrow[2] = {0.f, 0.f};
  float cff[4][4], cfb[4][4];
  if (MODE == 2) {
#pragma unroll
    for (int kb = 0; kb < 4; ++kb)
#pragma unroll
      for (int j = 0; j < 4; ++j) { const float mm = (float)(kb * 16 + lq * 4 + j); cff[kb][j] = fexp2(-a.lgf * mm); cfb[kb][j] = fexp2(a.lgb * mm); }
  }
  AttRegs R0, R1;
  R0.v1 = (u32x4){0u, 0u, 0u, 0u}; R1.v1 = R0.v1;
  const int krow = tid >> 3, kch = tid & 7;
  constexpr int NL = 1 + NV;

  att_load<NV>(a, 0, tid * 8, R0);
  att_store<DV, NV, 0>(Ks, Vs, 0, krow, kch, R0);
  att_load<NV>(a, (1 < ntiles) ? 1 : 0, tid * 8, R0);
  __syncthreads();
  auto step = [&](const int ti, const int cur, AttRegs& Rl, AttRegs& Rs) {
    att_load<NV>(a, (ti + 2 < ntiles) ? (ti + 2) : (ntiles - 1), tid * 8, Rl);
    __builtin_amdgcn_sched_barrier(0);
    bool active = true;
    const int myrow = a.r0 + (w >> 1);
    int rs_ = myrow - 4; rs_ = rs_ < 0 ? 0 : (rs_ > 8 ? 8 : rs_);
    const int kr = a.lo + ti;
    if (MODE == 1 && ti < a.n0) active = (kr >= rs_ && kr < rs_ + 8);
    if (active) {
      const bf16* ks = Ks + cur * 64 * 72 + lr * 72 + lq * 8;
      f32x4 s[4][2];
      {
        bf16x8 kf[2][4];
#pragma unroll
        for (int ds = 0; ds < 2; ++ds)
#pragma unroll
          for (int kb = 0; kb < 4; ++kb) kf[ds][kb] = *(const bf16x8*)(ks + kb * 16 * 72 + ds * 32);
        __builtin_amdgcn_sched_barrier(0);
        __builtin_amdgcn_s_setprio(1);
#pragma unroll
        for (int kb = 0; kb < 4; ++kb) {
          s[kb][0] = __builtin_amdgcn_mfma_f32_16x16x32_bf16(kf[0][kb], qf[0][0], (f32x4){0.f, 0.f, 0.f, 0.f}, 0, 0, 0);
          s[kb][1] = __builtin_amdgcn_mfma_f32_16x16x32_bf16(kf[0][kb], qf[1][0], (f32x4){0.f, 0.f, 0.f, 0.f}, 0, 0, 0);
        }
#pragma unroll
        for (int kb = 0; kb < 4; ++kb) {
          s[kb][0] = __builtin_amdgcn_mfma_f32_16x16x32_bf16(kf[1][kb], qf[0][1], s[kb][0], 0, 0, 0);
          s[kb][1] = __builtin_amdgcn_mfma_f32_16x16x32_bf16(kf[1][kb], qf[1][1], s[kb][1], 0, 0, 0);
        }
        __builtin_amdgcn_s_setprio(0);
      }
      if (MODE == 2) {
        const int nq0 = a.qpos0 + w * 32, t0 = ti * 64;
        if (ti >= a.n0) {
#pragma unroll
          for (int rb = 0; rb < 2; ++rb) {
            const int n = nq0 + rb * 16 + lr;
            const float fac = (ti < a.n0 + a.n1) ? fexp2(a.lgf * (float)(n + 1)) : fexp2(a.lgb * (float)(a.seqN - n));
#pragma unroll
            for (int kb = 0; kb < 4; ++kb)
#pragma unroll
              for (int j = 0; j < 4; ++j) s[kb][rb][j] *= fac;
          }
        } else if (t0 + 63 < nq0) {
#pragma unroll
          for (int rb = 0; rb < 2; ++rb) {
            const float rf = fexp2(a.lgf * (float)(nq0 + rb * 16 + lr - t0));
#pragma unroll
            for (int kb = 0; kb < 4; ++kb)
#pragma unroll
              for (int j = 0; j < 4; ++j) s[kb][rb][j] *= rf * cff[kb][j];
          }
        } else if (t0 > nq0 + 31) {
#pragma unroll
          for (int rb = 0; rb < 2; ++rb) {
            const float rf = fexp2(a.lgb * (float)(t0 - (nq0 + rb * 16 + lr)));
#pragma unroll
            for (int kb = 0; kb < 4; ++kb)
#pragma unroll
              for (int j = 0; j < 4; ++j) s[kb][rb][j] *= rf * cfb[kb][j];
          }
        } else {
#pragma unroll
          for (int rb = 0; rb < 2; ++rb) {
            const int n = nq0 + rb * 16 + lr;
#pragma unroll
            for (int kb = 0; kb < 4; ++kb)
#pragma unroll
              for (int j = 0; j < 4; ++j) {
                const int m = t0 + kb * 16 + lq * 4 + j; const int d = n - m;
                const float fac = d > 0 ? fexp2(a.lgf * (float)d) : (d < 0 ? fexp2(a.lgb * (float)(-d)) : 2.0f);
                s[kb][rb][j] *= fac;
              }
          }
        }
      } else {
        auto softmax_tile = [&](auto wv_tag) {
          constexpr int WV = decltype(wv_tag)::value;
#define KB_USED(kb_, rb_) (WV == 0 || (WV == 1 ? ((kb_) <= 1 + (rb_)) : ((kb_) >= 1 + (rb_))))
          if (WV != 0) {
#pragma unroll
            for (int rb = 0; rb < 2; ++rb) {
              const int c = (w & 1) * 32 + rb * 16 + lr;
              int cs = c - 8; cs = cs < 0 ? 0 : (cs > 48 ? 48 : cs);
              const float* bp = rpbs + (kr - myrow + 7) * 31 + (15 - c);
#pragma unroll
              for (int kb = 0; kb < 4; ++kb) {
                if (!KB_USED(kb, rb)) continue;
#pragma unroll
                for (int j = 0; j < 4; ++j) {
                  const int kc = kb * 16 + lq * 4 + j;
                  const bool valid = (kc >= cs) && (kc < cs + 16);
                  const float bias = valid ? bp[kc] : 0.f;
                  s[kb][rb][j] = valid ? (s[kb][rb][j] * a.scale + bias) : -1e30f;
                }
              }
            }
          }
          const float sc = (WV != 0) ? 1.0f : a.scale;
          float mxl[2];
#pragma unroll
          for (int rb = 0; rb < 2; ++rb) {
            float mx = -1e30f;
#pragma unroll
            for (int kb = 0; kb < 4; ++kb) {
              if (!KB_USED(kb, rb)) continue;
#pragma unroll
              for (int j = 0; j < 4; ++j) mx = fmaxf(mx, s[kb][rb][j]);
            }
            mxl[rb] = mx * sc;
          }
          const bool need = (mxl[0] > mrow[0] + 16.0f) || (mxl[1] > mrow[1] + 16.0f);
          if (__builtin_amdgcn_ballot_w64(need) != 0ull) {
#pragma unroll
            for (int rb = 0; rb < 2; ++rb) {
              float mx = mxl[rb];
              mx = fmaxf(mx, __shfl_xor(mx, 16)); mx = fmaxf(mx, __shfl_xor(mx, 32));
              const float mn = fmaxf(mrow[rb], mx); const float alpha = fexp2(mrow[rb] - mn); mrow[rb] = mn;
              lrow[rb] *= alpha;
#pragma unroll
              for (int nb = 0; nb < NB; ++nb) o[nb][rb] *= alpha;
            }
          }
#pragma unroll
          for (int rb = 0; rb < 2; ++rb) {
            const float mn = mrow[rb];
            float rs = 0.f;
#pragma unroll
            for (int kb = 0; kb < 4; ++kb) {
              if (!KB_USED(kb, rb)) { s[kb][rb] = (f32x4){0.f, 0.f, 0.f, 0.f}; continue; }
#pragma unroll
              for (int j = 0; j < 4; ++j) { const float pv = fexp2(fmaf(s[kb][rb][j], sc, -mn)); s[kb][rb][j] = pv; rs += pv; }
            }
            lrow[rb] += rs;
          }
#undef KB_USED
        };
        if (MODE == 1 && ti < a.n0) { if (w & 1) softmax_tile(IntTag<2>{}); else softmax_tile(IntTag<1>{}); }
        else softmax_tile(IntTag<0>{});
      }
      const bf16* vs = Vs + cur * DV * 72 + lr * 72 + lq * 4;
      bf16x8 pf[2][2];
#pragma unroll
      for (int pp = 0; pp < 2; ++pp)
#pragma unroll
        for (int rb = 0; rb < 2; ++rb) {
          u32x4 t; t.x = pack2(s[2 * pp][rb][0], s[2 * pp][rb][1]); t.y = pack2(s[2 * pp][rb][2], s[2 * pp][rb][3]);
          t.z = pack2(s[2 * pp + 1][rb][0], s[2 * pp + 1][rb][1]); t.w = pack2(s[2 * pp + 1][rb][2], s[2 * pp + 1][rb][3]);
          pf[pp][rb] = __builtin_bit_cast(bf16x8, t);
        }
      constexpr int NG = NB / 4, TOT = 2 * NG;
      bf16x8 vbuf[2][4];
#define ATT_LDV(gi_, dst_) do { const int pp_ = (gi_) / NG, nb0_ = ((gi_) % NG) * 4; \
        _Pragma("unroll") for (int q_ = 0; q_ < 4; ++q_) { \
          const uint2 vlo_ = *(const uint2*)(vs + (nb0_ + q_) * 16 * 72 + (2 * pp_) * 16); \
          const uint2 vhi_ = *(const uint2*)(vs + (nb0_ + q_) * 16 * 72 + (2 * pp_ + 1) * 16); \
          u32x4 t_; t_.x = vlo_.x; t_.y = vlo_.y; t_.z = vhi_.x; t_.w = vhi_.y; dst_[q_] = __builtin_bit_cast(bf16x8, t_); } } while (0)
      ATT_LDV(0, vbuf[0]);
#pragma unroll
      for (int gi = 0; gi < TOT; ++gi) {
        if (gi + 1 < TOT) ATT_LDV(gi + 1, vbuf[(gi + 1) & 1]);
        __builtin_amdgcn_sched_barrier(0);
        const int pp = gi / NG, nb0 = (gi % NG) * 4;
        __builtin_amdgcn_s_setprio(1);
#pragma unroll
        for (int q = 0; q < 4; ++q) {
          o[nb0 + q][0] = __builtin_amdgcn_mfma_f32_16x16x32_bf16(vbuf[gi & 1][q], pf[pp][0], o[nb0 + q][0], 0, 0, 0);
          o[nb0 + q][1] = __builtin_amdgcn_mfma_f32_16x16x32_bf16(vbuf[gi & 1][q], pf[pp][1], o[nb0 + q][1], 0, 0, 0);
        }
        __builtin_amdgcn_s_setprio(0);
        __builtin_amdgcn_sched_barrier(0);
      }
#undef ATT_LDV
    }
    __builtin_amdgcn_sched_barrier(0);
    att_store<DV, NV, NL>(Ks, Vs, cur ^ 1, krow, kch, Rs);
    __syncthreads();
  };
  for (int ti = 0; ti < ntiles; ti += 2) {
    step(ti, 0, R1, R0);
    if (ti + 1 < ntiles) step(ti + 1, 1, R0, R1);
  }
  asm volatile("s_waitcnt vmcnt(0)" : "+v"(R0.k0), "+v"(R0.v0), "+v"(R0.v1), "+v"(R1.k0), "+v"(R1.v0), "+v"(R1.v1) : : "memory");
  if (MODE == 2) {
#pragma unroll
    for (int rb = 0; rb < 2; ++rb) {
      float sum = 0.f;
#pragma unroll
      for (int nb = 0; nb < NB; ++nb)
#pragma unroll
        for (int j = 0; j < 4; ++j) sum += o[nb][rb][j];
      sum += __shfl_xor(sum, 16); sum += __shfl_xor(sum, 32);
      const float mean = sum * (1.0f / (float)DV);
      float var = 0.f;
#pragma unroll
      for (int nb = 0; nb < NB; ++nb)
#pragma unroll
        for (int j = 0; j < 4; ++j) { const float d = o[nb][rb][j] - mean; var += d * d; }
      var += __shfl_xor(var, 16); var += __shfl_xor(var, 32);
      const float rstd = rsqrtf(var * (1.0f / (float)DV) + 1e-5f);
      const size_t tok = (size_t)(a.tok0 + w * 32 + rb * 16 + lr);
      uint2 ovs[NB];
#pragma unroll
      for (int nb = 0; nb < NB; ++nb) {
        const int e0 = nb * 16 + lq * 4;
        const uint2 gv = *(const uint2*)(a.gr + tok * 1024 + a.h * DV + e0);
        const float4 gn = *(const float4*)(a.gn + a.h * DV + e0);
        const float g0 = bf2f((unsigned short)(gv.x & 0xffffu)), g1 = bf2f((unsigned short)(gv.x >> 16));
        const float g2 = bf2f((unsigned short)(gv.y & 0xffffu)), g3 = bf2f((unsigned short)(gv.y >> 16));
        uint2 ov;
        ov.x = pack2((o[nb][rb][0] - mean) * rstd * gn.x * silu_f(g0), (o[nb][rb][1] - mean) * rstd * gn.y * silu_f(g1));
        ov.y = pack2((o[nb][rb][2] - mean) * rstd * gn.z * silu_f(g2), (o[nb][rb][3] - mean) * rstd * gn.w * silu_f(g3));
        ovs[nb] = ov;
      }
#pragma unroll
      for (int k = 0; k < NB / 2; ++k) store_pair16(a.out + tok * a.ldo + a.h * DV + 32 * k, lq, ovs[2 * k], ovs[2 * k + 1]);
    }
  } else {
#pragma unroll
    for (int rb = 0; rb < 2; ++rb) {
      float lt = lrow[rb]; lt += __shfl_xor(lt, 16); lt += __shfl_xor(lt, 32);
      const float inv = __builtin_amdgcn_rcpf(lt);
      bf16* op = a.out + (size_t)(w * 32 + rb * 16 + lr) * a.ldo;
      uint2 ovs[NB];
#pragma unroll
      for (int nb = 0; nb < NB; ++nb) { ovs[nb].x = pack2(o[nb][rb][0] * inv, o[nb][rb][1] * inv); ovs[nb].y = pack2(o[nb][rb][2] * inv, o[nb][rb][3] * inv); }
#pragma unroll
      for (int k = 0; k < NB / 2; ++k) store_pair16(op + 32 * k, lq, ovs[2 * k], ovs[2 * k + 1]);
    }
  }
}

DEV int xcd_item(int item, int per) {
  const int g = item / per, i = item - g * per;
  const int sub = per >> 3;
  return g * per + (i & 7) * sub + (i >> 3);
}

DEV void even_attn_args(const Params& p, AttnArgs& a, int item, int& b, int& h, int& seq0, int& tok0, bool& lat) {
  int qt;
  lat = item < 256;
  if (lat) { b = item >> 5; h = (item >> 2) & 7; qt = item & 3; }
  else { const int i2 = item - 256; b = i2 >> 3; h = i2 & 7; qt = 0; }
  seq0 = lat ? 8192 + b * 1024 : b * 256;
  tok0 = seq0 + qt * 256;
  a.n1 = 0; a.n2 = 0; a.k1 = nullptr; a.vt1 = nullptr; a.vt2 = nullptr; a.ldk1 = 0; a.ldvt1 = 0; a.ldvt2 = 0;
  a.r0 = 0; a.lo = 0; a.scale = 0.125f * LOG2E; a.qpos0 = qt * 256; a.seqN = lat ? 1024 : 256; a.lgf = 0.f; a.lgb = 0.f;
  a.gr = nullptr; a.gn = nullptr; a.tok0 = tok0; a.h = h;
}

DEV void even_mixer_phase(const Params& p, unsigned char* smem) {
  unsigned char* ws = p.ws;
  bf16* MO = (bf16*)(ws + OFF_R1);
  for (int item = blockIdx.x; item < 512; item += gridDim.x) {
    const float* lg2 = (const float*)(ws + OFF_LG2);
    bool lat; int b, h, seq0, tok0; AttnArgs a;
    even_attn_args(p, a, xcd_item(item, 256), b, h, seq0, tok0, lat);
    const size_t hb = lat ? (size_t)8192 * 512 + (size_t)(b * 8 + h) * 1024 * 64 : (size_t)(b * 8 + h) * 256 * 64;
    a.q = (const bf16*)(ws + B_QR) + hb + (size_t)a.qpos0 * 64; a.ldq = 64;
    a.k0 = (const bf16*)(ws + B_KR) + hb; a.ldk0 = 64;
    if (lat) { a.vt0 = (const bf16*)(ws + B_VRT) + (size_t)8192 * 1024 + (size_t)(b * 8 + h) * 16 * 8192; a.ldvt0 = 64; a.n0 = 16;
      a.n1 = 1; a.vt1 = (const bf16*)(ws + S0T_F) + (size_t)(b * 8 + h) * 128 * 64; a.ldvt1 = 64;
      a.n2 = 1; a.vt2 = (const bf16*)(ws + S0T_B) + (size_t)(b * 8 + h) * 128 * 64; a.ldvt2 = 64; }
    else { a.vt0 = (const bf16*)(ws + B_VRT) + (size_t)(b * 8 + h) * 4 * 8192; a.ldvt0 = 64; a.n0 = 4; }
    a.lgf = lg2[h]; a.lgb = lg2[8 + h];
    a.gr = (const bf16*)(ws + B_GR); a.gn = p.ret_gn; a.out = MO; a.ldo = 1536;
    attn_item<128, 2>(a, smem, nullptr);
  }
  for (int item = blockIdx.x; item < 512; item += gridDim.x) {
    bool lat; int b, h, seq0, tok0; AttnArgs a;
    even_attn_args(p, a, xcd_item(item, 256), b, h, seq0, tok0, lat);
    const int kvh = h >> 2;
    const size_t hb = lat ? (size_t)8192 * 512 + (size_t)(b * 8 + h) * 1024 * 64 : (size_t)(b * 8 + h) * 256 * 64;
    a.q = (const bf16*)(ws + B_QA) + hb + (size_t)a.qpos0 * 64; a.ldq = 64;
    a.k0 = (const bf16*)(ws + B_KA) + (lat ? (size_t)8192 * 128 + (size_t)(b * 2 + kvh) * 1024 * 64 : (size_t)(b * 2 + kvh) * 256 * 64); a.ldk0 = 64;
    if (lat) { a.vt0 = (const bf16*)(ws + B_VAT) + (size_t)32 * 2 * 64 * 256 + (size_t)(b * 2 + kvh) * 16 * 4096; a.ldvt0 = 64; a.n0 = 16;
      a.n1 = 4; a.k1 = (const bf16*)(ws + CK_GQA) + (size_t)(b * 2 + kvh) * 256 * 64; a.ldk1 = 64;
      a.vt1 = (const bf16*)(ws + CVT_GQA) + (size_t)(b * 2 + kvh) * 64 * 256; a.ldvt1 = 256; }
    else { a.vt0 = (const bf16*)(ws + B_VAT) + (size_t)(b * 2 + kvh) * 4 * 4096; a.ldvt0 = 64; a.n0 = 4; }
    a.out = MO + (size_t)tok0 * 1536 + 1024 + h * 64; a.ldo = 1536;
    attn_item<64, 0>(a, smem, nullptr);
  }
  for (int item = blockIdx.x; item < 256; item += gridDim.x) {
    const int b = item >> 3, h = item & 7;
    gemm_core((const bf16*)(ws + B_KTFB) + (size_t)(b * 8 + h) * 2 * 64 * 256, 256, (const bf16*)(ws + B_VRT) + (size_t)(b * 8 + h) * 4 * 8192, 64, 8192, 256, smem);
    epi_state(p, b, h, (const float*)smem);
  }
}

DEV void odd_mixer_phase(const Params& p, unsigned char* smem) {
  unsigned char* ws = p.ws;
  bf16* MO = (bf16*)(ws + OFF_R1);
  float* rpbs = (float*)(smem + 65536);
  for (int item = blockIdx.x; item < 1024; item += gridDim.x) {
    AttnArgs a;
    a.n1 = 0; a.n2 = 0; a.k1 = nullptr; a.vt1 = nullptr; a.vt2 = nullptr; a.ldk1 = 0; a.ldvt1 = 0; a.ldvt2 = 0;
    a.r0 = 0; a.lo = 0; a.scale = 0.125f * LOG2E; a.qpos0 = 0; a.seqN = 0; a.lgf = 0.f; a.lgb = 0.f;
    a.gr = nullptr; a.gn = nullptr; a.tok0 = 0; a.h = 0;
    if (item < 512) {
      const int it2 = xcd_item(item, 512);
      const int b = it2 >> 6, h = (it2 >> 2) & 15, rq = (it2 & 3) ^ ((item >> 8) & 1); const int r0 = rq * 4;
      int lo = r0 - 4; lo = lo < 0 ? 0 : (lo > 8 ? 8 : lo);
      int hi = r0 + 3 - 4; hi = hi < 0 ? 0 : (hi > 8 ? 8 : hi); hi += 8;
      const int seq0 = 8192 + b * 1024; const int tok0 = seq0 + r0 * 64;
      for (int idx = threadIdx.x; idx < 465; idx += 512) rpbs[idx] = p.na_rpb[h * 465 + idx] * LOG2E;
      const size_t hb = (size_t)8192 * 1024 + (size_t)(b * 16 + h) * 1024 * 64;
      a.q = (const bf16*)(ws + B_Q) + hb + (size_t)r0 * 64 * 64; a.ldq = 64;
      a.k0 = (const bf16*)(ws + B_K) + hb + (size_t)lo * 64 * 64; a.ldk0 = 64;
      a.vt0 = (const bf16*)(ws + B_VT) + (size_t)8192 * 1024 + ((size_t)(b * 16 + h) * 16 + lo) * 4096; a.ldvt0 = 64; a.n0 = hi - lo;
      a.n1 = 4; a.k1 = (const bf16*)(ws + CK_NA) + (size_t)(b * 16 + h) * 256 * 64; a.ldk1 = 64;
      a.vt1 = (const bf16*)(ws + CVT_NA) + (size_t)(b * 16 + h) * 64 * 256; a.ldvt1 = 256;
      a.r0 = r0; a.lo = lo;
      a.out = MO + (size_t)tok0 * 1024 + h * 64; a.ldo = 1024;
      attn_item<64, 1>(a, smem, rpbs);
    } else {
      const int i2 = item - 512; const int b = i2 >> 4, h = i2 & 15;
      const int seq0 = b * 256; const int tok0 = seq0;
      const size_t hb = (size_t)(b * 16 + h) * 256 * 64;
      a.q = (const bf16*)(ws + B_Q) + hb; a.ldq = 64;
      a.k0 = (const bf16*)(ws + B_K) + hb; a.ldk0 = 64;
      a.vt0 = (const bf16*)(ws + B_VT) + (size_t)(b * 16 + h) * 4 * 4096; a.ldvt0 = 64; a.n0 = 4;
      a.out = MO + (size_t)tok0 * 1024 + h * 64; a.ldo = 1024;
      attn_item<64, 0>(a, smem, nullptr);
    }
  }
}

__global__ void __launch_bounds__(512, 2) mega_kernel(Params p) {
  extern __shared__ __attribute__((aligned(16))) unsigned char smem[];
  if (threadIdx.x == 0) *(uint4*)(smem + SMEM_BYTES) = make_uint4(0u, 0u, 0u, 0u);
  __syncthreads();
  XcdBarrier bar = xcd_barrier_post((unsigned*)(p.ws + OFF_BAR), (volatile LAS unsigned*)(smem + SMEM_BYTES));
  unsigned char* ws = p.ws;

  for (int i = blockIdx.x; i < 785; i += gridDim.x) {
    const int old = i < 192 ? i : (i < 432 ? 384 + (i - 192) : (i < 496 ? 624 + (i - 432) : (i < 752 ? 624 + 576 + (i - 496) : (i < 784 ? 1456 + (i - 752) : 1744))));
    p0_item(p, old, smem);
  }
  xcd_barrier(bar);

  {
    float* mod = (float*)(ws + OFF_MOD); const float* mp = (const float*)(ws + OFF_MODP);
    for (int idx = blockIdx.x * 512 + threadIdx.x; idx < 9 * 6144; idx += gridDim.x * 512) {
      const int l = 0, n = idx % 6144;
      float s = p.ada_b[l * 6144 + n];
#pragma unroll
      for (int kq = 0; kq < 8; ++kq) s += mp[(size_t)kq * 110592 + idx];
      mod[idx] = s;
    }
  }
  norm_phase(p, 0, 0, 1, p.norm_mix, p.x_prompt, p.x_sample, true, smem);
  xcd_barrier(bar);

  gemm_phase<0>(p, (const bf16*)(ws + OFF_R1), (const bf16*)(ws + WT_EIN), 1024, 3840, 0, 0, nullptr, nullptr, smem);
  xcd_barrier(bar);
  even_mixer_phase(p, smem);
  xcd_barrier(bar);
  gemm_phase<2>(p, (const bf16*)(ws + OFF_R1), (const bf16*)(ws + WT_EOUT), 1536, 1024, 0, 2 | 16, p.x_prompt, p.x_sample, smem);
  xcd_barrier(bar);
  norm_phase(p, 0, 3, 4, p.norm_ffn, nullptr, nullptr, false, smem);
  xcd_barrier(bar);
  gemm_phase<3>(p, (const bf16*)(ws + OFF_R1), (const bf16*)(ws + WT_UP), 1024, 5632, 0, 0, nullptr, nullptr, smem);
  xcd_barrier(bar);
  {
    float* mod = (float*)(ws + OFF_MOD); const float* mp = (const float*)(ws + OFF_MODP);
    for (int idx = 55296 + blockIdx.x * 512 + threadIdx.x; idx < 2 * 55296; idx += gridDim.x * 512) {
      float sacc = p.ada_b[6144 + idx % 6144];
#pragma unroll
      for (int kq = 0; kq < 8; ++kq) sacc += mp[(size_t)kq * 110592 + idx];
      mod[idx] = sacc;
    }
  }
  gemm_phase<2>(p, (const bf16*)(ws + B_ACT), (const bf16*)(ws + WT_DN), 2816, 1024, 0, 5 | 16, nullptr, nullptr, smem);
  xcd_barrier(bar);

  norm_phase(p, 1, 0, 1, p.norm_mix + 1024, nullptr, nullptr, false, smem);
  xcd_barrier(bar);
  gemm_phase<1>(p, (const bf16*)(ws + OFF_R1), (const bf16*)(ws + WT_OIN), 1024, 3072, 1, 0, nullptr, nullptr, smem);
  xcd_barrier(bar);
  odd_mixer_phase(p, smem);
  xcd_barrier(bar);
  gemm_phase<2>(p, (const bf16*)(ws + OFF_R1), (const bf16*)(ws + WT_OOUT), 1024, 1024, 1, 2 | 16, nullptr, nullptr, smem);
  xcd_barrier(bar);
  norm_phase(p, 1, 3, 4, p.norm_ffn + 1024, nullptr, nullptr, false, smem);
  xcd_barrier(bar);
  gemm_phase<3>(p, (const bf16*)(ws + OFF_R1), (const bf16*)(ws + WT_UP) + (size_t)5632 * 1024, 1024, 5632, 1, 0, nullptr, nullptr, smem);
  xcd_barrier(bar);
  gemm_phase<2>(p, (const bf16*)(ws + B_ACT), (const bf16*)(ws + WT_DN) + (size_t)1024 * 2816, 2816, 1024, 1, 5 | 16, nullptr, nullptr, smem);
  xcd_barrier(bar);

  final_norm_phase(p);
}

extern "C" void kernel_launch(void* const* d_in, const int* in_sizes, int n_in, void* d_out, int out_size, void* d_ws, size_t ws_size,
                              hipStream_t stream) {
  static int grid_blocks = 0;
  if (!grid_blocks) {
    int dev = 0, cus = 0, per_cu = 0;
    hipGetDevice(&dev);
    hipDeviceGetAttribute(&cus, hipDeviceAttributeMultiprocessorCount, dev);
    if (hipFuncSetAttribute((const void*)mega_kernel, hipFuncAttributeMaxDynamicSharedMemorySize, LDS_TOTAL) != hipSuccess) fprintf(stderr, "hipFuncSetAttribute failed\n");
    hipOccupancyMaxActiveBlocksPerMultiprocessor(&per_cu, mega_kernel, 512, LDS_TOTAL);
    (void)hipGetLastError();
    if (per_cu > 1) per_cu = 1;
    if (per_cu < 1) per_cu = 1;
    grid_blocks = cus * per_cu;
    if (grid_blocks % 8) grid_blocks -= grid_blocks % 8;
  }
  if (ws_size < (size_t)WS_NEEDED) fprintf(stderr, "workspace too small: %zu < %llu\n", ws_size, (unsigned long long)WS_NEEDED);
  Params p{};
  const float** pp = (const float**)&p;
  for (int i = 0; i < 29; ++i) pp[i] = (const float*)d_in[i];
  p.out = (float*)d_out;
  p.ws = (unsigned char*)d_ws;
  hipMemsetAsync(d_ws, 0, XCD_BAR_WORDS * 4, stream);
  void* args[] = {&p};
  hipError_t e = hipLaunchCooperativeKernel((void*)mega_kernel, dim3(grid_blocks), dim3(512), args, LDS_TOTAL, stream);
  if (e != hipSuccess) fprintf(stderr, "cooperative launch failed: %s (grid %d)\n", hipGetErrorString(e), grid_blocks);
}
```

```cpp
#include <hip/hip_runtime.h>
#include <stdint.h>
#include <stdio.h>

typedef unsigned short bf16;
typedef __attribute__((ext_vector_type(8))) short bf16x8;
typedef __attribute__((ext_vector_type(4))) float f32x4;
typedef __attribute__((ext_vector_type(4))) unsigned u32x4;

#define DEV __device__ __forceinline__
#define LOG2E 1.4426950408889634f

#define OFF_BAR    0ull
#define OFF_ROPE   16384ull
#define OFF_LG2    (16384ull + 8192ull)
#define OFF_MOD    32768ull
#define OFF_MODP   491520ull
#define OFF_WT     4194304ull
#define WT_EIN     (OFF_WT)
#define WT_EOUT    (WT_EIN + 7864320ull)
#define WT_OIN     (WT_EOUT + 3145728ull)
#define WT_OOUT    (WT_OIN + 6291456ull)
#define WT_UP      (WT_OOUT + 2097152ull)
#define WT_DN      (WT_UP + 2ull * 11534336ull)
#define OFF_CACHE  (WT_DN + 2ull * 5767168ull)
#define CK_GQA     (OFF_CACHE)
#define CVT_GQA    (CK_GQA + 524288ull)
#define CK_NA      (CVT_GQA + 524288ull)
#define CVT_NA     (CK_NA + 4194304ull)
#define S0T_F      (CVT_NA + 4194304ull)
#define S0T_B      (S0T_F + 1048576ull)
#define OFF_R1     (S0T_B + 1048576ull)
#define OFF_R2     (OFF_R1 + 50331648ull)
#define B_QR       (OFF_R2)
#define B_KR       (B_QR + 16777216ull)
#define B_VRT      (B_KR + 16777216ull)
#define B_GR       (B_VRT + 33554432ull)
#define B_QA       (B_GR + 33554432ull)
#define B_KA       (B_QA + 16777216ull)
#define B_VAT      (B_KA + 4194304ull)
#define B_KTFB     (B_VAT + 4194304ull)
#define R2_END     (B_KTFB + 16777216ull)
#define B_Q        (OFF_R2)
#define B_K        (B_Q + 33554432ull)
#define B_VT       (B_K + 33554432ull)
#define B_ACT      (OFF_R2)
#define B_HALO     (B_ACT + 92274688ull)
#define B_XB       (OFF_R2 + 103809024ull)
#define WS_NEEDED  (R2_END)

#define O_YP 0ull
#define O_SF 16777216ull
#define O_SB 18874368ull
#define O_GK 20971520ull
#define O_GV 22020096ull
#define O_NK 23068672ull
#define O_NV 31457280ull

#define SMEM_BYTES 135168
#define NTHR 512
#define LDS_TOTAL (SMEM_BYTES + 16)

struct Params {
  const float *x_prompt, *x_sample, *state_f, *state_b, *cgk, *cgv, *cnk, *cnv, *c, *c_ctx, *ada_w, *ada_b,
      *norm_mix, *norm_ffn, *norm_final, *even_w_in, *even_w_out, *decay_f, *decay_b, *ret_gn, *q_norm, *k_norm,
      *odd_w_in, *odd_w_out, *na_rpb, *w_up, *conv_w, *conv_b, *w_down;
  float* out;
  unsigned char* ws;
};

DEV unsigned short f2bf(float f) { unsigned u = __float_as_uint(f); u += 0x7fffu + ((u >> 16) & 1u); return (unsigned short)(u >> 16); }
DEV float bf2f(unsigned short h) { return __uint_as_float(((unsigned)h) << 16); }
DEV unsigned pack2(float a, float b) { unsigned r; asm("v_cvt_pk_bf16_f32 %0, %1, %2" : "=v"(r) : "v"(a), "v"(b)); return r; }
DEV uint4 pack8(const float* v) { uint4 o; o.x = pack2(v[0], v[1]); o.y = pack2(v[2], v[3]); o.z = pack2(v[4], v[5]); o.w = pack2(v[6], v[7]); return o; }
DEV float fexp2(float x) { return __builtin_amdgcn_exp2f(x); }
DEV u32x4 gload16(const void* p) { u32x4 r; asm volatile("global_load_dwordx4 %0, %1, off" : "=v"(r) : "v"(p) : "memory"); return r; }
#define VMWAIT4(a, b, c, d) asm volatile("s_waitcnt vmcnt(0)" : "+v"(a), "+v"(b), "+v"(c), "+v"(d) : : "memory")
#define VMWAIT2(a, b) asm volatile("s_waitcnt vmcnt(0)" : "+v"(a), "+v"(b) : : "memory")
DEV float silu_f(float x) { return x * __builtin_amdgcn_rcpf(1.0f + __expf(-x)); }

#define XB_TMO      128
#define XB_XCNT(j)  (256  + 64 * (j))
#define XB_XSUB(j)  (1280 + 64 * (j))
#define XB_XGEN(j)  (2304 + 64 * (j))
#define XB_TOP      3328
#define XB_TOPGEN   3392
#define XCD_BAR_WORDS 3456
#define XB_SPIN_CAP (1u << 22)
#define LAS __attribute__((address_space(3)))

DEV unsigned xb_ld(unsigned* p) { return __hip_atomic_load(p, __ATOMIC_RELAXED, __HIP_MEMORY_SCOPE_AGENT); }
DEV unsigned xb_add(unsigned* p, unsigned v) { return __hip_atomic_fetch_add(p, v, __ATOMIC_RELAXED, __HIP_MEMORY_SCOPE_AGENT); }
DEV unsigned xb_xcc_id() { return (unsigned)__builtin_amdgcn_s_getreg((3 << 11) | 20) & 0xFu; }
#define XB_SPIN(cond, bar) do { unsigned _sp = 0; while (cond) { __builtin_amdgcn_s_sleep(1); \
    if ((++_sp & 255u) == 0u) { if (xb_ld(&(bar)[XB_TMO])) break; if (_sp > XB_SPIN_CAP) { atomicAdd(&(bar)[XB_TMO], 1u); break; } } } } while (0)

struct XcdBarrier { unsigned* bar; unsigned x; volatile LAS unsigned* st; };

DEV XcdBarrier xcd_barrier_post(unsigned* bar, volatile LAS unsigned* st) {
  XcdBarrier b; b.bar = bar; b.x = xb_xcc_id(); b.st = st;
  if (threadIdx.x == 0) (void)xb_add(&bar[XB_XCNT(b.x)], 1u);
  return b;
}
DEV void xcd_barrier_complete(unsigned* bar, unsigned x, unsigned& nloc, unsigned& nx) {
  const unsigned G = gridDim.x * gridDim.y * gridDim.z;
  unsigned sum, cnt, mine, sp = 0u;
  for (;;) {
    sum = 0u; cnt = 0u; mine = 0u;
#pragma unroll
    for (unsigned j = 0; j < 16; ++j) { const unsigned c = xb_ld(&bar[XB_XCNT(j)]); sum += c; cnt += (c > 0u) ? 1u : 0u; mine = (j == x) ? c : mine; }
    if (sum == G) break;
    __builtin_amdgcn_s_sleep(1);
    if ((++sp & 255u) == 0u) { if (xb_ld(&bar[XB_TMO])) break; if (sp > XB_SPIN_CAP) { atomicAdd(&bar[XB_TMO], 1u); break; } }
  }
  nloc = mine > 0u ? mine : 1u; nx = cnt > 0u ? cnt : 1u;
}
DEV void xcd_barrier(const XcdBarrier& b) {
  asm volatile("s_waitcnt vmcnt(0)" ::: "memory");
  __syncthreads();
  if (threadIdx.x == 0) {
    unsigned* bar = b.bar;
    __builtin_amdgcn_s_waitcnt(0);
    unsigned nloc = b.st[0], nx = b.st[1];
    if (nloc == 0u) { xcd_barrier_complete(bar, b.x, nloc, nx); b.st[0] = nloc; b.st[1] = nx; }
    const unsigned old = xb_add(&bar[XB_XSUB(b.x)], 1u);
    const unsigned gen = old / nloc;
    if (old + 1u == (gen + 1u) * nloc) {
      __builtin_amdgcn_fence(__ATOMIC_RELEASE, "agent");
      asm volatile("s_waitcnt vmcnt(0)" ::: "memory");
      const unsigned og = xb_add(&bar[XB_TOP], 1u);
      const unsigned tg = og / nx;
      if (og + 1u == (tg + 1u) * nx) xb_add(&bar[XB_TOPGEN], 1u);
      else XB_SPIN(xb_ld(&bar[XB_TOPGEN]) == tg, bar);
      __builtin_amdgcn_fence(__ATOMIC_ACQUIRE, "agent");
      xb_add(&bar[XB_XGEN(b.x)], 1u);
      asm volatile("s_waitcnt vmcnt(0)" ::: "memory");
    } else {
      XB_SPIN(xb_ld(&bar[XB_XGEN(b.x)]) == gen, bar);
      __builtin_amdgcn_fence(__ATOMIC_ACQUIRE, "agent");
      asm volatile("s_waitcnt vmcnt(0)" ::: "memory");
    }
  }
  __syncthreads();
}

DEV void p0_transpose(const float* __restrict__ src, int ld, bf16* __restrict__ dst, int ldd, float* sm) {
  int tid = threadIdx.x; asm volatile("" : "+v"(tid));
#pragma unroll
  for (int i = 0; i < 2; ++i) {
    int idx = tid + 512 * i; int r = idx >> 4, c4 = idx & 15;
    float4 v = *(const float4*)(src + (size_t)r * ld + c4 * 4);
    float* d = sm + r * 65 + c4 * 4; d[0] = v.x; d[1] = v.y; d[2] = v.z; d[3] = v.w;
  }
  __syncthreads();
  {
    int idx = tid; int c = idx >> 3, rc = idx & 7; float v[8];
#pragma unroll
    for (int e = 0; e < 8; ++e) v[e] = sm[(rc * 8 + e) * 65 + c];
    *(uint4*)(dst + (size_t)c * ldd + rc * 8) = pack8(v);
  }
  __syncthreads();
}

DEV void p0_transpose4(const float* __restrict__ src, int ld, bf16* __restrict__ d0, bf16* __restrict__ d1, bf16* __restrict__ d2, bf16* __restrict__ d3, int ldd, float scale, float* sm) {
  int tid = threadIdx.x; asm volatile("" : "+v"(tid));
  float4 v[8];
#pragma unroll
  for (int i = 0; i < 8; ++i) { const int idx = tid + 512 * i; const int r = idx >> 6, c4 = idx & 63; v[i] = *(const float4*)(src + (size_t)r * ld + c4 * 4); }
#pragma unroll
  for (int i = 0; i < 8; ++i) { const int idx = tid + 512 * i; const int r = idx >> 6, c4 = idx & 63; float* d = sm + r * 257 + c4 * 4; d[0] = v[i].x; d[1] = v[i].y; d[2] = v[i].z; d[3] = v[i].w; }
  __syncthreads();
#pragma unroll
  for (int i = 0; i < 4; ++i) {
    const int idx = tid + 512 * i; const int c = idx >> 3, rc = idx & 7; float o[8];
#pragma unroll
    for (int e = 0; e < 8; ++e) o[e] = sm[(rc * 8 + e) * 257 + c] * scale;
    bf16* db = (i == 0) ? d0 : (i == 1) ? d1 : (i == 2) ? d2 : d3;
    *(uint4*)(db + (size_t)(c & 63) * ldd + rc * 8) = pack8(o);
  }
  __syncthreads();
}

DEV void p0_weight(const Params& p, int item, unsigned char* smem) {
  unsigned char* ws = p.ws;
  const float* src; bf16* dst; int R, C, remap = 0; int t = item;
  if (t < 240) { src = p.even_w_in; R = 1024; C = 3840; dst = (bf16*)(ws + WT_EIN); }
  else if ((t -= 240) < 96) { src = p.even_w_out; R = 1536; C = 1024; dst = (bf16*)(ws + WT_EOUT); }
  else if ((t -= 96) < 192) { src = p.odd_w_in; R = 1024; C = 3072; dst = (bf16*)(ws + WT_OIN); }
  else if ((t -= 192) < 64) { src = p.odd_w_out; R = 1024; C = 1024; dst = (bf16*)(ws + WT_OOUT); }
  else if ((t -= 64) < 704) { int l = t / 352; t %= 352; src = p.w_up + (size_t)l * 1024 * 5632; R = 1024; C = 5632; dst = (bf16*)(ws + WT_UP) + (size_t)l * 5632 * 1024; remap = 1; }
  else { t -= 704; int l = t / 176; t %= 176; src = p.w_down + (size_t)l * 2816 * 1024; R = 2816; C = 1024; dst = (bf16*)(ws + WT_DN) + (size_t)l * 1024 * 2816; }
  const int tcn = C >> 8; const int rt = t / tcn, c4 = t % tcn;
  bf16* d[4];
#pragma unroll
  for (int j = 0; j < 4; ++j) { const int ct = c4 * 4 + j; const int drow = remap ? ((ct % 44) * 128 + (ct / 44) * 64) : ct * 64; d[j] = dst + (size_t)drow * R + rt * 64; }
  const float wscale = (item < 240 && (c4 == 2 || c4 == 3)) ? 0.125f : 1.0f;
  p0_transpose4(src + (size_t)rt * 64 * C + c4 * 256, C, d[0], d[1], d[2], d[3], R, wscale, (float*)smem);
}
DEV void p0_item(const Params& p, int item, unsigned char* smem);
DEV void p0_weight_tail(const Params& p, int group, int total_units, unsigned char* smem) {
  const int G = (int)gridDim.x, c = (int)blockIdx.x;
  const int nfull = total_units % G;
  const int first = nfull ? nfull : 0, nw = nfull ? (G - nfull) : G;
  if (c < first) return;
  const int n = group ? 784 + 960 : 624;
  for (int i = c - first; i < n; i += nw) {
    if (i >= 784) {
      const int j = i - 784;
      p0_item(p, j < 192 ? 192 + j : (j < 704 ? 624 + 64 + (j - 192) : 1456 + 32 + (j - 704)), smem);
      continue;
    }
    int t;
    if (group == 0) t = i < 96 ? 240 + i : (i < 448 ? 592 + (i - 96) : 1296 + (i - 448));
    else t = i < 192 ? 336 + i : (i < 256 ? 528 + (i - 192) : (i < 608 ? 944 + (i - 256) : 1472 + (i - 608)));
    p0_weight(p, t, smem);
  }
}

DEV void p0_item(const Params& p, int item, unsigned char* smem) {
  int tid = threadIdx.x; asm volatile("" : "+v"(tid)); const int lane = tid & 63, w = tid >> 6;
  unsigned char* ws = p.ws;
  if (item < 384) {
    const int l = item / 192, rem = item % 192, cb = rem >> 3, kq = rem & 7;
    float* sc = (float*)smem;
    float* red = sc + 9 * 128;
    for (int idx = tid; idx < 9 * 128; idx += 512) {
      int crow = idx >> 7, kk = idx & 127, k = kq * 128 + kk;
      float v = crow < 8 ? p.c[crow * 1024 + k] : p.c_ctx[k];
      sc[idx] = silu_f(v);
    }
    __syncthreads();
    float acc[9][4];
#pragma unroll
    for (int r = 0; r < 9; ++r) { acc[r][0] = 0.f; acc[r][1] = 0.f; acc[r][2] = 0.f; acc[r][3] = 0.f; }
    const float* wp = p.ada_w + ((size_t)(l * 1024 + kq * 128 + w * 16)) * 6144 + cb * 256 + lane * 4;
#pragma unroll 8
    for (int kk = 0; kk < 16; ++kk) {
      float4 wv = *(const float4*)(wp + (size_t)kk * 6144);
#pragma unroll
      for (int r = 0; r < 9; ++r) {
        float s = sc[r * 128 + w * 16 + kk];
        acc[r][0] += s * wv.x; acc[r][1] += s * wv.y; acc[r][2] += s * wv.z; acc[r][3] += s * wv.w;
      }
    }
#pragma unroll
    for (int r = 0; r < 9; ++r) {
      float* d = red + (w * 9 + r) * 256 + lane * 4;
      d[0] = acc[r][0]; d[1] = acc[r][1]; d[2] = acc[r][2]; d[3] = acc[r][3];
    }
    __syncthreads();
    float* modp = (float*)(ws + OFF_MODP);
    for (int idx = tid; idx < 9 * 256; idx += 512) {
      int r = idx >> 8, cc = idx & 255;
      float s = 0.f;
#pragma unroll
      for (int ww = 0; ww < 8; ++ww) s += red[(ww * 9 + r) * 256 + cc];
      modp[((size_t)(kq * 2 + l) * 9 + r) * 6144 + cb * 256 + cc] = s;
    }
    __syncthreads();
    return;
  }
  item -= 384;
  if (item < 240) { p0_weight(p, item, smem); return; }
  item -= 240;
  if (item < 832) {
    const float* src; bf16* dst; int R, C, tiled = 0; int t = item;
    if (t < 64) { int mat = t >> 2; t &= 3; src = p.cgv + (size_t)mat * 256 * 64; R = 256; C = 64; dst = (bf16*)(ws + CVT_GQA) + (size_t)mat * 64 * 256; tiled = 1; }
    else if ((t -= 64) < 512) { int mat = t >> 2; t &= 3; src = p.cnv + (size_t)mat * 256 * 64; R = 256; C = 64; dst = (bf16*)(ws + CVT_NA) + (size_t)mat * 64 * 256; tiled = 1; }
    else { t -= 512; int which = t >> 7; t &= 127; int mat = t >> 1; t &= 1; src = (which ? p.state_b : p.state_f) + (size_t)mat * 64 * 128; R = 64; C = 128; dst = (bf16*)(ws + (which ? S0T_B : S0T_F)) + (size_t)mat * 128 * 64; }
    const int tcn = C >> 6; const int rt = t / tcn, ct = t % tcn;
    if (tiled) p0_transpose(src + (size_t)rt * 64 * C, C, dst + (size_t)rt * 4096, 64, (float*)smem);
    else p0_transpose(src + (size_t)rt * 64 * C + ct * 64, C, dst + (size_t)(ct * 64) * R + rt * 64, R, (float*)smem);
    return;
  }
  item -= 832;
  if (item < 288) {
    const float* src; bf16* dst; size_t base;
    if (item < 32) { src = p.cgk; dst = (bf16*)(ws + CK_GQA); base = (size_t)item * 8192; }
    else { src = p.cnk; dst = (bf16*)(ws + CK_NA); base = (size_t)(item - 32) * 8192; }
#pragma unroll
    for (int i = 0; i < 2; ++i) {
      size_t o = base + (size_t)(i * 512 + tid) * 8;
      float4 a = *(const float4*)(src + o), b = *(const float4*)(src + o + 4);
      float v[8] = {a.x, a.y, a.z, a.w, b.x, b.y, b.z, b.w};
      *(uint4*)(dst + o) = pack8(v);
    }
    return;
  }
  {
    float2* rope = (float2*)(ws + OFF_ROPE);
    for (int idx = tid; idx < 1024; idx += 512) {
      int pos = idx >> 4, fi = idx & 15;
      float inv = exp2f(-(float)fi * 0.8304820237218406f);
      float ang = (float)pos * inv;
      float k = rintf(ang * 0.15915494309189535f);
      float r = fmaf(-k, 6.2831854820251465f, ang);
      r = fmaf(-k, -1.7484556e-7f, r);
      rope[idx] = make_float2(__cosf(r), __sinf(r));
    }
    if (tid < 16) {
      int fb = tid >> 3, h = tid & 7;
      float x = (fb ? p.decay_b : p.decay_f)[h];
      float lg = -log1pf(expf(-x)) * LOG2E;
      ((float*)(ws + OFF_LG2))[tid] = lg;
    }
  }
}

DEV float modval(const Params& p, int l, int crow, int n, bool partial) {
  if (!partial) return ((const float*)(p.ws + OFF_MOD))[(size_t)(l * 9 + crow) * 6144 + n];
  const float* mp = (const float*)(p.ws + OFF_MODP);
  float s = p.ada_b[l * 6144 + n];
#pragma unroll
  for (int kq = 0; kq < 8; ++kq) s += mp[((size_t)(kq * 2 + l) * 9 + crow) * 6144 + n];
  return s;
}

DEV void norm_phase(const Params& p, int l, int si, int sci, const float* g, const float* xc, const float* xs, bool partial, unsigned char* smem) {
  int tid = threadIdx.x; asm volatile("" : "+v"(tid)); const int lane = tid & 63, w = tid >> 6;
  float* ssh = (float*)smem; float* ssc = ssh + 1024;
  bf16* H = (bf16*)(p.ws + OFF_R1);
  for (int chunk = blockIdx.x; chunk < 512; chunk += gridDim.x) {
    const int row0 = chunk * 32; const int crow = row0 < 8192 ? 8 : ((row0 - 8192) >> 10);
    for (int idx = tid; idx < 1024; idx += 512) {
      ssh[idx] = modval(p, l, crow, si * 1024 + idx, partial);
      ssc[idx] = (1.0f + modval(p, l, crow, sci * 1024 + idx, partial)) * g[idx];
    }
    __syncthreads();
    for (int rr = 0; rr < 4; ++rr) {
      const int row = row0 + w * 4 + rr;
      float4 v[4]; float ss = 0.f;
      if (xc) {
        const float* xp = row < 8192 ? xc + (size_t)row * 1024 : xs + (size_t)(row - 8192) * 1024;
#pragma unroll
        for (int i = 0; i < 4; ++i) v[i] = *(const float4*)(xp + lane * 4 + 256 * i);
      } else {
        const bf16* xp = (const bf16*)(p.ws + B_XB) + (size_t)row * 1024;
#pragma unroll
        for (int i = 0; i < 4; ++i) { const uint2 q = *(const uint2*)(xp + lane * 4 + 256 * i);
          v[i] = make_float4(__uint_as_float(q.x << 16), __uint_as_float(q.x & 0xffff0000u), __uint_as_float(q.y << 16), __uint_as_float(q.y & 0xffff0000u)); }
      }
#pragma unroll
      for (int i = 0; i < 4; ++i) ss += v[i].x * v[i].x + v[i].y * v[i].y + v[i].z * v[i].z + v[i].w * v[i].w;
#pragma unroll
      for (int o = 1; o < 64; o <<= 1) ss += __shfl_xor(ss, o);
      const float rstd = rsqrtf(ss * (1.0f / 1024.0f) + 1e-6f);
#pragma unroll
      for (int i = 0; i < 4; ++i) {
        const int col = lane * 4 + 256 * i;
        float4 sc = *(const float4*)(ssc + col), sh = *(const float4*)(ssh + col);
        uint2 o; o.x = pack2(v[i].x * rstd * sc.x + sh.x, v[i].y * rstd * sc.y + sh.y);
        o.y = pack2(v[i].z * rstd * sc.z + sh.z, v[i].w * rstd * sc.w + sh.w);
        *(uint2*)(H + (size_t)row * 1024 + col) = o;
      }
    }
    __syncthreads();
  }
}

DEV void final_norm_phase(const Params& p) {
  int tid = threadIdx.x; asm volatile("" : "+v"(tid)); const int lane = tid & 63, w = tid >> 6;
  for (int row = blockIdx.x * 8 + w; row < 16384; row += gridDim.x * 8) {
    const bf16* xp = (const bf16*)(p.ws + B_XB) + (size_t)row * 1024;
    float* yp = p.out + (size_t)row * 1024;
    float4 v[4]; float ss = 0.f;
#pragma unroll
    for (int i = 0; i < 4; ++i) { const uint2 q = *(const uint2*)(xp + lane * 4 + 256 * i);
      v[i] = make_float4(__uint_as_float(q.x << 16), __uint_as_float(q.x & 0xffff0000u), __uint_as_float(q.y << 16), __uint_as_float(q.y & 0xffff0000u));
      ss += v[i].x * v[i].x + v[i].y * v[i].y + v[i].z * v[i].z + v[i].w * v[i].w; }
#pragma unroll
    for (int o = 1; o < 64; o <<= 1) ss += __shfl_xor(ss, o);
    const float rstd = rsqrtf(ss * (1.0f / 1024.0f) + 1e-6f);
#pragma unroll
    for (int i = 0; i < 4; ++i) {
      const int col = lane * 4 + 256 * i;
      float4 g = *(const float4*)(p.norm_final + col);
      *(float4*)(yp + col) = make_float4(v[i].x * rstd * g.x, v[i].y * rstd * g.y, v[i].z * rstd * g.z, v[i].w * rstd * g.w);
    }
  }
}

#define CT_LD 132
DEV void gemm_core(const bf16* __restrict__ A, int lda, const bf16* __restrict__ B, int ldb, int kstepB, int K, unsigned char* smem) {
  int tid = threadIdx.x; asm volatile("" : "+v"(tid)); const int lane = tid & 63, w = tid >> 6;
  const int wr = w >> 2, wc = w & 3, lr = lane & 15, lq = lane >> 4;
  bf16* As = (bf16*)smem;
  bf16* Bs = As + 2 * 128 * 72;
  const int ldr = tid >> 3, ldc = (tid & 7) * 8;
  const bf16* Ap = A + (size_t)ldr * lda + ldc;
  const bf16* Bp = B + (size_t)ldr * ldb + ldc;
  {
    uint4 a0 = *(const uint4*)(Ap), a1 = *(const uint4*)(Ap + (size_t)64 * lda), b0 = *(const uint4*)(Bp), b1 = *(const uint4*)(Bp + (size_t)64 * ldb);
    *(uint4*)(As + ldr * 72 + ldc) = a0; *(uint4*)(As + (ldr + 64) * 72 + ldc) = a1;
    *(uint4*)(Bs + ldr * 72 + ldc) = b0; *(uint4*)(Bs + (ldr + 64) * 72 + ldc) = b1;
  }
  __syncthreads();
  f32x4 acc[4][2];
#pragma unroll
  for (int i = 0; i < 4; ++i) { acc[i][0] = (f32x4){0.f, 0.f, 0.f, 0.f}; acc[i][1] = (f32x4){0.f, 0.f, 0.f, 0.f}; }
  const int nk = K >> 6;
  for (int kt = 0; kt < nk; ++kt) {
    const int cur = kt & 1;
    const int kn = (kt + 1 < nk) ? (kt + 1) : kt;
    const bf16* Apk = Ap + kn * 64; const bf16* Bpk = Bp + (size_t)kn * kstepB;
    u32x4 pa0 = gload16(Apk), pa1 = gload16(Apk + (size_t)64 * lda), pb0 = gload16(Bpk), pb1 = gload16(Bpk + (size_t)64 * ldb);
    __builtin_amdgcn_sched_barrier(0);
    const bf16* as = As + cur * 128 * 72 + (wr * 64 + lr) * 72 + lq * 8;
    const bf16* bs = Bs + cur * 128 * 72 + (wc * 32 + lr) * 72 + lq * 8;
#pragma unroll
    for (int ks = 0; ks < 2; ++ks) {
      bf16x8 a[4], b[2];
#pragma unroll
      for (int i = 0; i < 4; ++i) a[i] = *(const bf16x8*)(as + i * 16 * 72 + ks * 32);
#pragma unroll
      for (int i = 0; i < 2; ++i) b[i] = *(const bf16x8*)(bs + i * 16 * 72 + ks * 32);
#pragma unroll
      for (int mi = 0; mi < 4; ++mi)
#pragma unroll
        for (int ni = 0; ni < 2; ++ni) acc[mi][ni] = __builtin_amdgcn_mfma_f32_16x16x32_bf16(a[mi], b[ni], acc[mi][ni], 0, 0, 0);
    }
    __builtin_amdgcn_sched_barrier(0);
    {
      VMWAIT4(pa0, pa1, pb0, pb1);
      bf16* ad = As + (cur ^ 1) * 128 * 72 + ldr * 72 + ldc; bf16* bd = Bs + (cur ^ 1) * 128 * 72 + ldr * 72 + ldc;
      *(u32x4*)(ad) = pa0; *(u32x4*)(ad + 64 * 72) = pa1; *(u32x4*)(bd) = pb0; *(u32x4*)(bd + 64 * 72) = pb1;
    }
    __syncthreads();
  }
  float* Ct = (float*)smem;
#pragma unroll
  for (int mi = 0; mi < 4; ++mi)
#pragma unroll
    for (int ni = 0; ni < 2; ++ni)
#pragma unroll
      for (int j = 0; j < 4; ++j) Ct[(wr * 64 + mi * 16 + lq * 4 + j) * CT_LD + wc * 32 + ni * 16 + lr] = acc[mi][ni][j];
  __syncthreads();
}

#define CT16_LD 264
DEV void ld8h(const bf16* Ct, int r, int c, float* v) {
  const uint4 q = *(const uint4*)(Ct + r * CT16_LD + c);
  v[0] = __uint_as_float(q.x << 16); v[1] = __uint_as_float(q.x & 0xffff0000u); v[2] = __uint_as_float(q.y << 16); v[3] = __uint_as_float(q.y & 0xffff0000u);
  v[4] = __uint_as_float(q.z << 16); v[5] = __uint_as_float(q.z & 0xffff0000u); v[6] = __uint_as_float(q.w << 16); v[7] = __uint_as_float(q.w & 0xffff0000u);
}
DEV float ldh(const bf16* Ct, int r, int c) { return bf2f(Ct[r * CT16_LD + c]); }
DEV void ld8(const float* Ct, int r, int c, float* v) {
  float4 a = *(const float4*)(Ct + r * CT_LD + c), b = *(const float4*)(Ct + r * CT_LD + c + 4);
  v[0] = a.x; v[1] = a.y; v[2] = a.z; v[3] = a.w; v[4] = b.x; v[5] = b.y; v[6] = b.z; v[7] = b.w;
}

template <class F>
DEV void epi_transposed(const bf16* Ct, F dstrow, int tstride) {
  int tid = threadIdx.x; asm volatile("" : "+v"(tid));
#pragma unroll
  for (int i = 0; i < 4; ++i) {
    int idx = tid + 512 * i; int tcl = idx & 3, c = (idx >> 2) & 127, tch = idx >> 9; int tc = tch * 4 + tcl;
    unsigned hv[8];
#pragma unroll
    for (int e = 0; e < 8; ++e) hv[e] = Ct[(tc * 8 + e) * CT16_LD + c];
    uint4 ov; ov.x = hv[0] | (hv[1] << 16); ov.y = hv[2] | (hv[3] << 16); ov.z = hv[4] | (hv[5] << 16); ov.w = hv[6] | (hv[7] << 16);
    *(uint4*)(dstrow(c) + (size_t)(tc >> 3) * tstride + (tc & 7) * 8) = ov;
  }
}

DEV void epi_even(const Params& p, int mt, int nt, const bf16* Ct) {
  int tid = threadIdx.x; asm volatile("" : "+v"(tid));
  const int cg = tid & 15, rg = tid >> 4;
  unsigned char* ws = p.ws;
  const int m0 = mt * 128; const bool lat = m0 >= 8192;
  const int bseq = lat ? ((m0 - 8192) >> 10) : (m0 >> 8);
  const int t0 = lat ? ((m0 - 8192) & 1023) : (m0 & 255);
  int type; int cb;
  if (nt < 4) { type = 0; cb = nt * 128; } else if (nt < 8) { type = 1; cb = (nt - 4) * 128; } else if (nt < 16) { type = 2; cb = (nt - 8) * 128; }
  else if (nt < 24) { type = 3; cb = (nt - 16) * 128; } else if (nt < 28) { type = 4; cb = (nt - 24) * 128; } else if (nt == 28) { type = 5; cb = 0; } else { type = 6; cb = 0; }
  if (type == 2) {
    const int h = nt - 8;
    bf16* base = (bf16*)(ws + B_VRT) + (lat ? (size_t)8192 * 1024 + ((size_t)(bseq * 8 + h) * 16 + (t0 >> 6)) * 8192 : ((size_t)(bseq * 8 + h) * 4 + (t0 >> 6)) * 8192);
    epi_transposed(Ct, [&](int c) { return base + (size_t)c * 64; }, 8192);
  } else if (type == 6) {
    bf16* base = (bf16*)(ws + B_VAT) + (lat ? (size_t)32 * 2 * 64 * 256 : (size_t)0);
    const int ntk = lat ? 16 : 4;
    epi_transposed(Ct, [&](int c) { return base + ((size_t)(bseq * 2 + (c >> 6)) * ntk + (t0 >> 6)) * 4096 + (size_t)(c & 63) * 64; }, 4096);
    if (!lat) {
#pragma unroll
      for (int i = 0; i < 4; ++i) {
        const int r = rg + 32 * i; float v[8]; ld8h(Ct, r, cg * 8, v);
        const int kvh = cg >> 3, d0 = (cg & 7) * 8;
        float* o = p.out + O_GV + ((size_t)(bseq * 2 + kvh) * 256 + t0 + r) * 64 + d0;
        *(float4*)o = make_float4(v[0], v[1], v[2], v[3]); *(float4*)(o + 4) = make_float4(v[4], v[5], v[6], v[7]);
      }
    }
  } else {
    const int j0 = (cg * 8) & 63;
    if (type == 3 || ((type == 0 || type == 1) && !lat)) {
      bf16* dstc; size_t off; int rstride;
      if (type == 3) { dstc = (bf16*)(ws + B_GR); off = (size_t)m0 * 1024 + cb + cg * 8; rstride = 1024; }
      else { dstc = (bf16*)(ws + (type == 0 ? B_QR : B_KR)); off = ((size_t)(bseq * 8 + ((cb + cg * 8) >> 6)) * 256 + t0) * 64 + j0; rstride = 64; }
#pragma unroll
      for (int i = 0; i < 4; ++i) { const int r = rg + 32 * i; *(uint4*)(dstc + off + (size_t)r * rstride) = *(const uint4*)(Ct + r * CT16_LD + cg * 8); }
    } else {
    const float2* rope = (const float2*)(ws + OFF_ROPE);
    const bool dorope = lat && (type == 0 || type == 1 || type == 4 || type == 5);
    float gain[8], pgain[8];
#pragma unroll
    for (int e = 0; e < 8; ++e) { gain[e] = 1.f; pgain[e] = 1.f; }
    if (type == 4 || type == 5) {
      const float* gp = (type == 4) ? p.q_norm : p.k_norm;
#pragma unroll
      for (int e = 0; e < 8; ++e) { gain[e] = gp[j0 + e]; pgain[e] = gp[(j0 ^ 16) + e]; }
    }
    bf16* dst; int nh;
    if (type == 0) { dst = (bf16*)(ws + B_QR); nh = 8; } else if (type == 1) { dst = (bf16*)(ws + B_KR); nh = 8; }
    else if (type == 3) { dst = (bf16*)(ws + B_GR); nh = 0; } else if (type == 4) { dst = (bf16*)(ws + B_QA); nh = 8; } else { dst = (bf16*)(ws + B_KA); nh = 2; }
    const int hh = (cb + cg * 8) >> 6;
    const size_t hbase = lat ? (size_t)8192 * 64 * nh + ((size_t)(bseq * nh + hh) * 1024 + t0) * 64 : ((size_t)(bseq * nh + hh) * 256 + t0) * 64;
#pragma unroll
    for (int i = 0; i < 4; ++i) {
      const int r = rg + 32 * i; const int row = m0 + r;
      float v[8]; ld8h(Ct, r, cg * 8, v);
      float mul = 1.0f;
      if (type == 4 || type == 5) {
        float ss = 0.f;
#pragma unroll
        for (int e = 0; e < 8; ++e) ss += v[e] * v[e];
        ss += __shfl_xor(ss, 1); ss += __shfl_xor(ss, 2); ss += __shfl_xor(ss, 4);
        mul = rsqrtf(ss * (1.0f / 64.0f) + 1e-6f);
      }
#pragma unroll
      for (int e = 0; e < 8; ++e) v[e] *= mul * gain[e];
      if (type == 5 && !lat) {
        const int kvh = cg >> 3;
        float* o = p.out + O_GK + ((size_t)(bseq * 2 + kvh) * 256 + t0 + r) * 64 + j0;
        *(float4*)o = make_float4(v[0], v[1], v[2], v[3]); *(float4*)(o + 4) = make_float4(v[4], v[5], v[6], v[7]);
      }
      if (dorope) {
        float pv[8]; ld8h(Ct, r, (cg * 8) ^ 16, pv);
        const int t = t0 + r; const int pos = (j0 & 32) ? (t & 63) : (t >> 6); const int f0 = j0 & 15;
        const float sgn = (j0 & 16) ? 1.0f : -1.0f;
#pragma unroll
        for (int e = 0; e < 8; ++e) {
          float2 cs = rope[pos * 16 + f0 + e];
          float pe = pv[e] * mul * pgain[e];
          v[e] = v[e] * cs.x + sgn * pe * cs.y;
        }
      }
      if (nh) *(uint4*)(dst + hbase + (size_t)r * 64 + j0) = pack8(v);
      else *(uint4*)(dst + (size_t)row * 1024 + cb + cg * 8) = pack8(v);
    }
    }
    if (type == 1 && !lat) {
      const float* lg2 = (const float*)(ws + OFF_LG2);
      bf16* base = (bf16*)(ws + B_KTFB);
#pragma unroll
      for (int i = 0; i < 4; ++i) {
        int idx = tid + 512 * i; int tcl = idx & 3, c = (idx >> 2) & 127, tch = idx >> 9; int tc = tch * 4 + tcl;
        const int h = (nt - 4) * 2 + (c >> 6), d = c & 63;
        const float lgf = lg2[h], lgb = lg2[8 + h];
        float f[8], g[8];
#pragma unroll
        for (int e = 0; e < 8; ++e) {
          const int tt = t0 + tc * 8 + e; const float val = ldh(Ct, tc * 8 + e, c);
          f[e] = val * fexp2(lgf * (float)(255 - tt)); g[e] = val * fexp2(lgb * (float)tt);
        }
        bf16* o = base + (((size_t)(bseq * 8 + h) * 2) * 64 + d) * 256 + t0 + tc * 8;
        *(uint4*)o = pack8(f); *(uint4*)(o + 64 * 256) = pack8(g);
      }
    }
  }
}

DEV void epi_odd(const Params& p, int mt, int nt, const bf16* Ct) {
  int tid = threadIdx.x; asm volatile("" : "+v"(tid));
  const int cg = tid & 15, rg = tid >> 4;
  unsigned char* ws = p.ws;
  const int m0 = mt * 128; const bool lat = m0 >= 8192;
  const int bseq = lat ? ((m0 - 8192) >> 10) : (m0 >> 8);
  const int t0 = lat ? ((m0 - 8192) & 1023) : (m0 & 255);
  if (nt < 16) {
    bf16* dst = (bf16*)(ws + (nt < 8 ? B_Q : B_K));
    const int hh = (nt & 7) * 2 + (cg >> 3), dd0 = (cg & 7) * 8;
    const size_t hbase = lat ? (size_t)8192 * 1024 + ((size_t)(bseq * 16 + hh) * 1024 + t0) * 64 : ((size_t)(bseq * 16 + hh) * 256 + t0) * 64;
#pragma unroll
    for (int i = 0; i < 4; ++i) {
      const int r = rg + 32 * i;
      *(uint4*)(dst + hbase + (size_t)r * 64 + dd0) = *(const uint4*)(Ct + r * CT16_LD + cg * 8);
      if (nt >= 8 && !lat) {
        float v[8]; ld8h(Ct, r, cg * 8, v);
        const int h = (nt - 8) * 2 + (cg >> 3), d0 = (cg & 7) * 8;
        float* o = p.out + O_NK + ((size_t)(bseq * 16 + h) * 256 + t0 + r) * 64 + d0;
        *(float4*)o = make_float4(v[0], v[1], v[2], v[3]); *(float4*)(o + 4) = make_float4(v[4], v[5], v[6], v[7]);
      }
    }
  } else {
    const int h0 = (nt - 16) * 2;
    bf16* base = (bf16*)(ws + B_VT) + (lat ? (size_t)8192 * 1024 : (size_t)0);
    const int ntk = lat ? 16 : 4;
    epi_transposed(Ct, [&](int c) { return base + ((size_t)(bseq * 16 + h0 + (c >> 6)) * ntk + (t0 >> 6)) * 4096 + (size_t)(c & 63) * 64; }, 4096);
    if (!lat) {
#pragma unroll
      for (int i = 0; i < 4; ++i) {
        const int r = rg + 32 * i; float v[8]; ld8h(Ct, r, cg * 8, v);
        const int h = h0 + (cg >> 3), d0 = (cg & 7) * 8;
        float* o = p.out + O_NV + ((size_t)(bseq * 16 + h) * 256 + t0 + r) * 64 + d0;
        *(float4*)o = make_float4(v[0], v[1], v[2], v[3]); *(float4*)(o + 4) = make_float4(v[4], v[5], v[6], v[7]);
      }
    }
  }
}

DEV void epi_resid(const Params& p, int mt, int nt, const bf16* Ct, int l, int gi_, const float* xc, const float* xs) {
  int tid = threadIdx.x; asm volatile("" : "+v"(tid));
  const int cg = tid & 15, rg = tid >> 4;
  const bool ob = (gi_ & 16) != 0; const int gi = gi_ & 15;
  const int m0 = mt * 128; const int col = nt * 128 + cg * 8;
  const int crow = m0 < 8192 ? 8 : ((m0 - 8192) >> 10);
  const float* gp = (const float*)(p.ws + OFF_MOD) + (size_t)(l * 9 + crow) * 6144 + gi * 1024 + col;
  const float4 g0 = *(const float4*)gp, g1 = *(const float4*)(gp + 4);
  bf16* xb = (bf16*)(p.ws + B_XB);
#pragma unroll
  for (int i = 0; i < 4; ++i) {
    const int r = rg + 32 * i; const int row = m0 + r; float v[8]; ld8h(Ct, r, cg * 8, v);
    float x[8];
    if (xc) {
      const float* xp = (row < 8192 ? xc + (size_t)row * 1024 : xs + (size_t)(row - 8192) * 1024) + col;
      const float4 a = *(const float4*)xp, b = *(const float4*)(xp + 4);
      x[0] = a.x; x[1] = a.y; x[2] = a.z; x[3] = a.w; x[4] = b.x; x[5] = b.y; x[6] = b.z; x[7] = b.w;
    } else {
      const uint4 q = *(const uint4*)(xb + (size_t)row * 1024 + col);
      x[0] = __uint_as_float(q.x << 16); x[1] = __uint_as_float(q.x & 0xffff0000u); x[2] = __uint_as_float(q.y << 16); x[3] = __uint_as_float(q.y & 0xffff0000u);
      x[4] = __uint_as_float(q.z << 16); x[5] = __uint_as_float(q.z & 0xffff0000u); x[6] = __uint_as_float(q.w << 16); x[7] = __uint_as_float(q.w & 0xffff0000u);
    }
    x[0] += g0.x * v[0]; x[1] += g0.y * v[1]; x[2] += g0.z * v[2]; x[3] += g0.w * v[3];
    x[4] += g1.x * v[4]; x[5] += g1.y * v[5]; x[6] += g1.z * v[6]; x[7] += g1.w * v[7];
    if (ob) *(uint4*)(xb + (size_t)row * 1024 + col) = pack8(x);
    else {
      float* o = p.out + (size_t)row * 1024 + col;
      *(float4*)o = make_float4(x[0], x[1], x[2], x[3]);
      *(float4*)(o + 4) = make_float4(x[4], x[5], x[6], x[7]);
    }
  }
}

DEV void epi_ffn_up_unit(const Params& p, int pm, int pn, const bf16* Ct, int l) {
  int tid = threadIdx.x; asm volatile("" : "+v"(tid));
  const int cgp = tid & 15, rgp = tid >> 4;
  const int bj = cgp >> 3, j0 = (cgp & 7) * 8;
  const int ca = bj * 128 + j0;
  const int oc = (2 * pn + bj) * 64 + j0;
  const bool lat = pm >= 32;
  const bool firstu = !lat || ((pm & 3) == 0), lastu = !lat || ((pm & 3) == 3);
  const float* cw = p.conv_w + (size_t)l * 3 * 5632; const float* cbp = p.conv_b + (size_t)l * 5632;
  float wa0[8], wa1[8], wa2[8], wab[8], wg0[8], wg1[8], wg2[8], wgb[8];
#pragma unroll
  for (int e = 0; e < 8; ++e) {
    wa0[e] = cw[oc + e]; wa1[e] = cw[5632 + oc + e]; wa2[e] = cw[2 * 5632 + oc + e]; wab[e] = cbp[oc + e];
    wg0[e] = cw[2816 + oc + e]; wg1[e] = cw[5632 + 2816 + oc + e]; wg2[e] = cw[2 * 5632 + 2816 + oc + e]; wgb[e] = cbp[2816 + oc + e];
  }
  bf16* act = (bf16*)(p.ws + B_ACT);
  const int r0 = rgp * 8;
  float ap[8], ac[8], an[8], gp[8], gc[8], gn[8];
  if (r0 > 0) { ld8h(Ct, r0 - 1, ca, ap); ld8h(Ct, r0 - 1, ca + 64, gp); }
  else {
#pragma unroll
    for (int e = 0; e < 8; ++e) { ap[e] = 0.f; gp[e] = 0.f; }
  }
  ld8h(Ct, r0, ca, ac); ld8h(Ct, r0, ca + 64, gc);
#pragma unroll
  for (int i = 0; i < 8; ++i) {
    const int r = r0 + i;
    if (r < 255) { ld8h(Ct, r + 1, ca, an); ld8h(Ct, r + 1, ca + 64, gn); }
    else {
#pragma unroll
      for (int e = 0; e < 8; ++e) { an[e] = 0.f; gn[e] = 0.f; }
    }
    const bool skip = (r == 0 && !firstu) || (r == 255 && !lastu);
    if (!skip) {
      float res[8];
#pragma unroll
      for (int e = 0; e < 8; ++e) {
        const float a = wab[e] + wa0[e] * ap[e] + wa1[e] * ac[e] + wa2[e] * an[e];
        const float g = wgb[e] + wg0[e] * gp[e] + wg1[e] * gc[e] + wg2[e] * gn[e];
        res[e] = silu_f(a) * g;
      }
      *(uint4*)(act + (size_t)(pm * 256 + r) * 2816 + oc) = pack8(res);
    }
#pragma unroll
    for (int e = 0; e < 8; ++e) { ap[e] = ac[e]; ac[e] = an[e]; gp[e] = gc[e]; gc[e] = gn[e]; }
  }
  if (lat) {
    float* halo = (float*)(p.ws + B_HALO);
    for (int idx = tid; idx < 1024; idx += 512) {
      const int hr = idx >> 8, c = idx & 255; const int r = (hr < 2) ? hr : 252 + hr;
      halo[((size_t)(pm * 4 + hr)) * 5632 + pn * 256 + c] = ldh(Ct, r, c);
    }
  }
}

DEV void ffn_seam_rows(const Params& p, int l, int pm) {
  if (pm < 32) return;
  int tid = threadIdx.x; asm volatile("" : "+v"(tid));
  const float* cw = p.conv_w + (size_t)l * 3 * 5632; const float* cbp = p.conv_b + (size_t)l * 5632;
  const float* halo = (const float*)(p.ws + B_HALO);
  bf16* act = (bf16*)(p.ws + B_ACT);
#pragma unroll 1
  for (int which = 0; which < 2; ++which) {
    if (which == 0 ? ((pm & 3) == 0) : ((pm & 3) == 3)) continue;
    const float *up, *uc, *un; int row;
    if (which == 0) { up = halo + (size_t)((pm - 1) * 4 + 3) * 5632; uc = halo + (size_t)(pm * 4 + 0) * 5632; un = halo + (size_t)(pm * 4 + 1) * 5632; row = pm * 256; }
    else { up = halo + (size_t)(pm * 4 + 2) * 5632; uc = halo + (size_t)(pm * 4 + 3) * 5632; un = halo + (size_t)((pm + 1) * 4 + 0) * 5632; row = pm * 256 + 255; }
    for (int j = tid; j < 2816; j += 512) {
      const int ca = (j >> 6) * 128 + (j & 63), cgi = ca + 64;
      const float a = cbp[j] + cw[j] * up[ca] + cw[5632 + j] * uc[ca] + cw[2 * 5632 + j] * un[ca];
      const float g = cbp[2816 + j] + cw[2816 + j] * up[cgi] + cw[5632 + 2816 + j] * uc[cgi] + cw[2 * 5632 + 2816 + j] * un[cgi];
      act[(size_t)row * 2816 + j] = f2bf(silu_f(a) * g);
    }
  }
  asm volatile("s_waitcnt vmcnt(0)" ::: "memory");
  __syncthreads();
}

DEV void epi_state(const Params& p, int b, int h, const float* Ct) {
  int tid = threadIdx.x; asm volatile("" : "+v"(tid)); const int cg = tid & 15, rg = tid >> 4;
#pragma unroll 1
  for (int i = 0; i < 4; ++i) {
    const int r = rg + 32 * i; float v[8]; ld8(Ct, r, cg * 8, v);
    float* o = p.out + (r < 64 ? O_SF : O_SB) + ((size_t)(b * 8 + h) * 64 + (r & 63)) * 128 + cg * 8;
    *(float4*)o = make_float4(v[0], v[1], v[2], v[3]); *(float4*)(o + 4) = make_float4(v[4], v[5], v[6], v[7]);
  }
  __syncthreads();
}

namespace pg8 {
#define PG8_LAS __attribute__((address_space(3)))
typedef unsigned short bf16_t;
typedef short bf16x8 __attribute__((ext_vector_type(8)));
typedef float f32x4 __attribute__((ext_vector_type(4)));
typedef unsigned u32x4 __attribute__((ext_vector_type(4)));
constexpr int BM = 256, BK = 64, HALF = 128, HTB = HALF * BK * 2  , STAGE_BYTES = 8 * HTB, NXCD = 8, WGM = 8;

__host__ __device__ __forceinline__ int lds_byte(int r, int c) { const int st = (r >> 4) * 2 + (c >> 5), rr = r & 15, cc = c & 31, ob = rr * 64 + cc * 2; return st * 1024 + (ob ^ (((ob >> 9) & 1) << 5)); }
__host__ __device__ __forceinline__ void stage_rc(int b, int& R, int& C) { const int st = b / 1024, sb = b % 1024, swz = sb ^ (((sb >> 9) & 1) << 5); R = (st >> 1) * 16 + swz / 64; C = (st & 1) * 32 + (swz % 64) / 2; }
__host__ __device__ __forceinline__ int perm32(int rho) { const int n = rho >> 4, i = rho & 15; return 8 * (i >> 2) + 4 * n + (i & 3); }

struct Unit { int pm, pn; };
struct Gemm { const bf16_t* A; const bf16_t* Bt; int M, N, K; };

struct StaticOrder {
    int nM, nN, nwg, G, c;
    __host__ __device__ void init(int M, int N, int G_, int c_) { nM = M / BM; nN = N / BM; nwg = nM * nN; G = G_; c = c_; }
    __host__ __device__ bool next(int i, Unit& u) const {
        const long L = (long)i * G + c; if (L >= nwg) return false;
        int wgid = (int)L; { const int q = nwg / NXCD, r = nwg % NXCD, xcd = wgid % NXCD, off = wgid / NXCD; wgid = (xcd < r ? xcd * (q + 1) : r * (q + 1) + (xcd - r) * q) + off; }
        const int nig = WGM * nN, gid = wgid / nig, fm = gid * WGM, gsz = (nM - fm) < WGM ? (nM - fm) : WGM;
        u.pm = fm + ((wgid % nig) % gsz); u.pn = (wgid % nig) / gsz; return true;
    }
    __device__ __forceinline__ void a_ready(const Unit&) const {}
    __device__ __forceinline__ void done(const Unit&) const {}
};
template <class Epi, class Sched, bool STAMP = false>
__device__ __forceinline__ void gemm_phase(PG8_LAS unsigned char* lds, const Gemm g, const Sched& S, const Epi& E, unsigned long long* stamps) {
    int tid = threadIdx.x; asm volatile("" : "+v"(tid)); const int wid = __builtin_amdgcn_readfirstlane(tid >> 6), lane = tid & 63, wr = wid >> 2, wc = wid & 3, fr = lane & 15, fq = lane >> 4;
    const int K = g.K, nt = K / BK;
    int ts_lo = 0, ts_hi = 0, nts = 0; const unsigned long long rt_entry = STAMP ? (unsigned long long)wall_clock64() : 0ull;
#define PG8_STAMP() do { if (STAMP && wid == 0 && nts < 64) { const unsigned long long _c = (unsigned long long)clock64(); \
        ts_lo = (lane == nts) ? (int)(unsigned)_c : ts_lo; ts_hi = (lane == nts) ? (int)(unsigned)(_c >> 32) : ts_hi; ++nts; } } while (0)
    PG8_STAMP();
    unsigned voffA[2], voffB[2];
#pragma unroll
    for (int i = 0; i < 2; ++i) { int R, C; stage_rc(tid * 16 + i * 8192, R, C); const int Rb = Epi::PERM ? ((R & ~31) + perm32(R & 31)) : R;
        voffA[i] = (unsigned)(R * K + C) * 2u; voffB[i] = (unsigned)(Rb * K + C) * 2u; }
    const size_t kstep = (size_t)(BK * 2);
    const size_t hstep = (size_t)HALF * K * 2;
    const size_t tstep = 2 * hstep;
    const unsigned ldsw = (unsigned)wid * 1024u;
    const int aoff = lds_byte(wr * 64 + fr, fq * 8), boff = lds_byte(wc * 32 + fr, fq * 8);
#define PG8_SA(b, h) (((b) * 2 + (h)) * HTB)
#define PG8_SB(b, h) ((4 + (b) * 2 + (h)) * HTB)
#define PG8_STAGE(bufoff, gbase, voff) do { _Pragma("unroll") for (int _i = 0; _i < 2; ++_i) \
        __builtin_amdgcn_global_load_lds((const unsigned*)((const char*)(gbase) + (voff)[_i]), (PG8_LAS unsigned*)(lds + (bufoff) + ldsw + _i * 8192), 16, 0, 0); } while (0)
#define PG8_LDA(dst, b, h) do { _Pragma("unroll") for (int m = 0; m < 4; ++m) _Pragma("unroll") for (int k = 0; k < 2; ++k) dst[m][k] = *(const PG8_LAS bf16x8*)(lds + PG8_SA(b, h) + aoff + m * 2048 + k * 1024); } while (0)
#define PG8_LDB(dst, b, h) do { _Pragma("unroll") for (int n = 0; n < 2; ++n) _Pragma("unroll") for (int k = 0; k < 2; ++k) dst[n][k] = *(const PG8_LAS bf16x8*)(lds + PG8_SB(b, h) + boff + n * 2048 + k * 1024); } while (0)
#define PG8_MMA(ai, bj, At, Bt) do { __builtin_amdgcn_s_setprio(1); _Pragma("unroll") for (int m = 0; m < 4; ++m) _Pragma("unroll") for (int n = 0; n < 2; ++n) _Pragma("unroll") for (int k = 0; k < 2; ++k) \
        acc[ai][bj][m][n] = __builtin_amdgcn_mfma_f32_16x16x32_bf16(Bt[n][k], At[m][k], acc[ai][bj][m][n], 0, 0, 0); __builtin_amdgcn_s_setprio(0); } while (0)
#define PG8_WAIT_V(n) asm volatile("s_waitcnt vmcnt(" #n ")" ::: "memory")
#define PG8_WAIT_L(n) asm volatile("s_waitcnt lgkmcnt(" #n ")" ::: "memory")
#define PG8_BAR __builtin_amdgcn_s_barrier()
#define PG8_SCHED __builtin_amdgcn_sched_barrier(0)
    Unit cur, nxt; int ui = 0;
    if (!S.next(0, cur)) return;
    f32x4 acc[2][2][4][2];
#pragma unroll
    for (int a = 0; a < 2; ++a)
#pragma unroll
        for (int b = 0; b < 2; ++b)
#pragma unroll
            for (int m = 0; m < 4; ++m)
#pragma unroll
                for (int n = 0; n < 2; ++n) acc[a][b][m][n] = (f32x4){0.f, 0.f, 0.f, 0.f};
    bf16x8 At[4][2], B0[2][2], B1[2][2];
    const char* cA = (const char*)g.A + (size_t)cur.pm * tstep; const char* cB = (const char*)g.Bt + (size_t)cur.pn * tstep;
    S.a_ready(cur);
    PG8_STAGE(PG8_SB(0, 0), cB, voffB); PG8_STAGE(PG8_SA(0, 0), cA, voffA); PG8_STAGE(PG8_SB(0, 1), cB + hstep, voffB); PG8_STAGE(PG8_SA(0, 1), cA + hstep, voffA);
    if (wr == 1) PG8_BAR;
    PG8_WAIT_V(4); PG8_BAR;
    PG8_STAGE(PG8_SB(1, 0), cB + kstep, voffB); PG8_STAGE(PG8_SA(1, 0), cA + kstep, voffA); PG8_STAGE(PG8_SB(1, 1), cB + hstep + kstep, voffB);
    PG8_WAIT_V(6); PG8_BAR;
    PG8_STAMP();
    for (;;) {
        const bool has_next = S.next(ui + 1, nxt);
        const char* nA = has_next ? (const char*)g.A + (size_t)nxt.pm * tstep : cA; const char* nB = has_next ? (const char*)g.Bt + (size_t)nxt.pn * tstep : cB;
        for (int t = 0; t < nt; t += 2) {
            const bool last = (t == nt - 2);
            const char* a1 = cA + (size_t)(t + 1) * kstep;
            const char* a2 = last ? nA : cA + (size_t)(t + 2) * kstep; const char* b2 = last ? nB : cB + (size_t)(t + 2) * kstep;
            const char* a3 = a2 + kstep; const char* b3 = b2 + kstep;
            if (last && has_next) S.a_ready(nxt);
            PG8_LDB(B0, 0, 0); PG8_SCHED; PG8_LDA(At, 0, 0); PG8_STAGE(PG8_SA(1, 1), a1 + hstep, voffA);
            PG8_WAIT_L(8); PG8_BAR; PG8_WAIT_L(0); PG8_MMA(0, 0, At, B0); PG8_BAR; PG8_SCHED;
            PG8_LDB(B1, 0, 1); PG8_STAGE(PG8_SB(0, 0), b2, voffB);
            PG8_BAR; PG8_WAIT_L(0); PG8_MMA(0, 1, At, B1); PG8_BAR;
            PG8_LDA(At, 0, 1); PG8_STAGE(PG8_SA(0, 0), a2, voffA);
            PG8_BAR; PG8_WAIT_L(0); PG8_MMA(1, 0, At, B0); PG8_BAR; PG8_SCHED;
            PG8_STAGE(PG8_SB(0, 1), b2 + hstep, voffB);
            PG8_WAIT_V(6); PG8_BAR; PG8_MMA(1, 1, At, B1); PG8_BAR;
            PG8_LDB(B0, 1, 0); PG8_SCHED; PG8_LDA(At, 1, 0); PG8_STAGE(PG8_SA(0, 1), a2 + hstep, voffA);
            PG8_WAIT_L(8); PG8_BAR; PG8_WAIT_L(0); PG8_MMA(0, 0, At, B0); PG8_BAR; PG8_SCHED;
            PG8_LDB(B1, 1, 1); PG8_STAGE(PG8_SB(1, 0), b3, voffB);
            PG8_BAR; PG8_WAIT_L(0); PG8_MMA(0, 1, At, B1); PG8_BAR;
            PG8_LDA(At, 1, 1); PG8_STAGE(PG8_SA(1, 0), a3, voffA);
            PG8_BAR; PG8_WAIT_L(0); PG8_MMA(1, 0, At, B0); PG8_BAR; PG8_SCHED;
            PG8_STAGE(PG8_SB(1, 1), b3 + hstep, voffB);
            PG8_WAIT_V(6); PG8_BAR; PG8_MMA(1, 1, At, B1); PG8_BAR;
        }
        PG8_STAMP();
        if constexpr (!Epi::AFTER_DRAIN) { E(acc, cur, wr, wc, fr, fq); S.done(cur); }
        PG8_STAMP();
        if (!has_next) break;
#pragma unroll
        for (int a = 0; a < 2; ++a)
#pragma unroll
            for (int b = 0; b < 2; ++b)
#pragma unroll
                for (int m = 0; m < 4; ++m)
#pragma unroll
                    for (int n = 0; n < 2; ++n) acc[a][b][m][n] = (f32x4){0.f, 0.f, 0.f, 0.f};
        cur = nxt; cA = nA; cB = nB; ++ui;
    }
    PG8_WAIT_V(0);
    if (wr == 0) PG8_BAR;
    PG8_BAR;
    if constexpr (Epi::AFTER_DRAIN) { E.fused(acc, cur, wr, wc, fr, fq, lds, wid, lane); S.done(cur); }
    PG8_STAMP();
    if (STAMP && wid == 0) { stamps[lane] = lane < nts ? (((unsigned long long)(unsigned)ts_hi << 32) | (unsigned)ts_lo) : 0ull;
        if (lane == 62) stamps[62] = rt_entry; if (lane == 63) stamps[63] = (unsigned long long)wall_clock64(); }
#undef PG8_STAMP
#undef PG8_SA
#undef PG8_SB
#undef PG8_STAGE
#undef PG8_LDA
#undef PG8_LDB
#undef PG8_MMA
#undef PG8_WAIT_V
#undef PG8_WAIT_L
#undef PG8_BAR
#undef PG8_SCHED
}
}

struct OneUnit {
  pg8::Unit u;
  DEV bool next(int i, pg8::Unit& o) const { if (i != 0) return false; o = u; return true; }
  DEV void a_ready(const pg8::Unit&) const {}
  DEV void done(const pg8::Unit&) const {}
};
template <int EPI>
struct EpiStage {
  static constexpr bool PERM = false, AFTER_DRAIN = true;
  const Params* p; unsigned char* smem; int l, gi; const float* xc; const float* xs;
  const bf16* A; const bf16* B; int K, npm, npn;
  DEV void fused(pg8::f32x4 (&acc)[2][2][4][2], const pg8::Unit& u, int wr, int wc, int fr, int fq, PG8_LAS unsigned char* lds, int wid, int lane) const {
    unsigned pf0 = 0u, pf1 = 0u;
    if (npm >= 0) {
      const int t_ = threadIdx.x;
      const bf16* pa = A + ((size_t)(npm * 256 + (t_ >> 1)) * K + (t_ & 1) * 64);
      const bf16* pb = B + ((size_t)(npn * 256 + (t_ >> 1)) * K + (t_ & 1) * 64);
      asm volatile("global_load_dword %0, %1, off" : "=v"(pf0) : "v"(pa) : "memory");
      asm volatile("global_load_dword %0, %1, off" : "=v"(pf1) : "v"(pb) : "memory");
    }
    bf16* Ct = (bf16*)smem;
    int ctoff = (wr * 64 + fr) * CT16_LD + wc * 32 + fq * 4; asm volatile("" : "+v"(ctoff));
#pragma unroll
    for (int ai = 0; ai < 2; ++ai)
#pragma unroll
      for (int bj = 0; bj < 2; ++bj)
#pragma unroll
        for (int m = 0; m < 4; ++m)
#pragma unroll
          for (int n = 0; n < 2; ++n) {
            uint2 pk; pk.x = pack2(acc[ai][bj][m][n][0], acc[ai][bj][m][n][1]); pk.y = pack2(acc[ai][bj][m][n][2], acc[ai][bj][m][n][3]);
            *(uint2*)(Ct + ctoff + (ai * 128 + m * 16) * CT16_LD + bj * 128 + n * 16) = pk;
          }
    __syncthreads();
    if (EPI == 3) epi_ffn_up_unit(*p, u.pm, u.pn, Ct, l);
    else
#pragma unroll 1
    for (int q = 0; q < 4; ++q) {
      const int ai = q >> 1, bj = q & 1;
      const int mt = 2 * u.pm + ai, nt = 2 * u.pn + bj;
      const bf16* Cq = Ct + ai * 128 * CT16_LD + bj * 128;
      if (EPI == 0) epi_even(*p, mt, nt, Cq);
      else if (EPI == 1) epi_odd(*p, mt, nt, Cq);
      else epi_resid(*p, mt, nt, Cq, l, gi, xc, xs);
    }
    asm volatile("s_waitcnt vmcnt(0)" : "+v"(pf0), "+v"(pf1) : : "memory");
    __syncthreads();
  }
};

template <int EPI>
DEV void gemm_phase(const Params& p, const bf16* A, const bf16* B, int K, int N, int l, int gi, const float* xc, const float* xs, unsigned char* smem) {
  pg8::StaticOrder so; so.init(16384, N, (int)gridDim.x, (int)blockIdx.x);
  pg8::Gemm g; g.A = A; g.Bt = B; g.M = 16384; g.N = N; g.K = K;
  EpiStage<EPI> E; E.p = &p; E.smem = smem; E.l = l; E.gi = gi; E.xc = xc; E.xs = xs; E.A = A; E.B = B; E.K = K;
  for (int it = 0;; ++it) {
    OneUnit S;
    if (!so.next(it, S.u)) break;
    if (EPI == 2 && K == 2816) ffn_seam_rows(p, l, S.u.pm);
    { pg8::Unit nu; if (so.next(it + 1, nu)) { E.npm = nu.pm; E.npn = nu.pn; } else { E.npm = -1; E.npn = -1; } }
    pg8::gemm_phase<EpiStage<EPI>, OneUnit, false>((PG8_LAS unsigned char*)smem, g, S, E, nullptr);
  }
  if (EPI == 0) p0_weight_tail(p, 0, 64 * (N / 256), smem);
  if (EPI == 3 && l == 0) p0_weight_tail(p, 1, 64 * (N / 256), smem);
}

struct AttnArgs {
  const bf16* q; int ldq;
  const bf16* k0; const bf16* vt0; int ldk0, ldvt0, n0;
  const bf16* k1; const bf16* vt1; int ldk1, ldvt1, n1;
  const bf16* vt2; int ldvt2, n2;
  float scale;
  int qpos0, seqN; float lgf, lgb;
  int r0, lo;
  bf16* out; int ldo;
  const bf16* gr; const float* gn; int tok0; int h;
};


#define KLD 80
struct AttRegs { u32x4 k0, v0, v1; int ident; };
template <int NV>
DEV void att_load(const AttnArgs& a, int ti, int tid8, AttRegs& R) {
  const bf16* kp; const bf16* vp;
  if (ti < a.n0) { kp = a.k0 + (size_t)ti * 4096; vp = a.vt0 + (size_t)ti * (NV * 4096); }
  else if (ti < a.n0 + a.n1) { const int j = ti - a.n0; kp = a.k1 ? a.k1 + (size_t)j * 4096 : (const bf16*)0; vp = a.vt1 + (size_t)j * (NV * 4096); }
  else { const int j = ti - a.n0 - a.n1; kp = (const bf16*)0; vp = a.vt2 + (size_t)j * (NV * 4096); }
  R.ident = (kp == (const bf16*)0) ? 1 : 0;
  const bf16* ksrc = kp ? kp + tid8 : vp + tid8;
  R.k0 = gload16(ksrc);
  R.v0 = gload16(vp + tid8);
  if (NV > 1) R.v1 = gload16(vp + tid8 + 4096);
}
template <int DV, int NV, int WAITN>
DEV void att_store(bf16* Ks, bf16* Vs, int buf, int krow, int kch, AttRegs& R) {
  if (NV > 1) asm volatile("s_waitcnt vmcnt(%3)" : "+v"(R.k0), "+v"(R.v0), "+v"(R.v1) : "n"(WAITN) : "memory");
  else asm volatile("s_waitcnt vmcnt(%2)" : "+v"(R.k0), "+v"(R.v0) : "n"(WAITN) : "memory");
  u32x4 kv = R.k0;
  if (R.ident) {
    const int d = krow - kch * 8; const unsigned one = (d & 1) ? 0x3F800000u : 0x00003F80u; const bool in = (d >= 0 && d < 8);
    kv.x = (in && (d >> 1) == 0) ? one : 0u; kv.y = (in && (d >> 1) == 1) ? one : 0u; kv.z = (in && (d >> 1) == 2) ? one : 0u; kv.w = (in && (d >> 1) == 3) ? one : 0u;
  }
  *(u32x4*)(Ks + buf * 64 * KLD + krow * KLD + kch * 8) = kv;
  bf16* vd = Vs + buf * DV * 72 + krow * 72 + kch * 8;
  *(u32x4*)(vd) = R.v0;
  if (NV > 1) *(u32x4*)(vd + 64 * 72) = R.v1;
}

template <int V> struct IntTag { static constexpr int value = V; };
DEV void store_pair16(bf16* rowp  , int lq, uint2 ve, uint2 vo) {
  const bool odd = (lq & 1) != 0;
  uint2 snd = odd ? ve : vo, rcv;
  rcv.x = (unsigned)__shfl_xor((int)snd.x, 16); rcv.y = (unsigned)__shfl_xor((int)snd.y, 16);
  uint4 q;
  if (!odd) { q.x = ve.x; q.y = ve.y; q.z = rcv.x; q.w = rcv.y; }
  else { q.x = rcv.x; q.y = rcv.y; q.z = vo.x; q.w = vo.y; }
  *(uint4*)(rowp + (odd ? 16 : 0) + (lq & ~1) * 4) = q;
}
template <int DV, int MODE>
DEV void attn_item(const AttnArgs& a, unsigned char* smem, const float* rpbs) {
  constexpr int NB = DV / 16, NV = DV / 64;
  int tid = threadIdx.x; asm volatile("" : "+v"(tid)); const int lane = tid & 63, w = __builtin_amdgcn_readfirstlane(tid >> 6), lr = lane & 15, lq = lane >> 4;
  bf16* Ks = (bf16*)smem;
  bf16* Vs = Ks + 2 * 64 * KLD;
  const int ntiles = a.n0 + a.n1 + a.n2;
  bf16x8 qf[2][2];
#pragma unroll
  for (int rb = 0; rb < 2; ++rb)
#pragma unroll
    for (int ds = 0; ds < 2; ++ds) qf[rb][ds] = *(const bf16x8*)(a.q + (size_t)(w * 32 + rb * 16 + lr) * a.ldq + ds * 32 + lq * 8);
  f32x4 o[NB][2];
#pragma unroll
  for (int nb = 0; nb < NB; ++nb) { o[nb][0] = (f32x4){0.f, 0.f, 0.f, 0.f}; o[nb][1] = (f32x4){0.f, 0.f, 0.f, 0.f}; }
  float mrow[2] = {-1e30f, -1e30f}, lrow[2] = {0.f, 0.f};
  float cff[4][4], cfb[4][4];
  if (MODE == 2) {
#pragma unroll
    for (int kb = 0; kb < 4; ++kb)
#pragma unroll
      for (int j = 0; j < 4; ++j) { const float mm = (float)(kb * 16 + lq * 4 + j); cff[kb][j] = fexp2(-a.lgf * mm); cfb[kb][j] = fexp2(a.lgb * mm); }
  }
  AttRegs R0, R1;
  R0.v1 = (u32x4){0u, 0u, 0u, 0u}; R1.v1 = R0.v1;
  const int krow = tid >> 3, kch = tid & 7;
  constexpr int NL = 1 + NV;

  att_load<NV>(a, 0, tid * 8, R0);
  att_store<DV, NV, 0>(Ks, Vs, 0, krow, kch, R0);
  att_load<NV>(a, (1 < ntiles) ? 1 : 0, tid * 8, R0);
  __syncthreads();
  auto step = [&](const int ti, const int cur, AttRegs& Rl, AttRegs& Rs) {
    att_load<NV>(a, (ti + 2 < ntiles) ? (ti + 2) : (ntiles - 1), tid * 8, Rl);
    __builtin_amdgcn_sched_barrier(0);
    bool active = true;
    const int myrow = a.r0 + (w >> 1);
    int rs_ = myrow - 4; rs_ = rs_ < 0 ? 0 : (rs_ > 8 ? 8 : rs_);
    const int kr = a.lo + ti;
    if (MODE == 1 && ti < a.n0) active = (kr >= rs_ && kr < rs_ + 8);
    if (active) {
      const bf16* ks = Ks + cur * 64 * KLD + lr * KLD + lq * 8;
      f32x4 s[4][2];
      {
        bf16x8 kf[2][4];
#pragma unroll
        for (int ds = 0; ds < 2; ++ds)
#pragma unroll
          for (int kb = 0; kb < 4; ++kb) kf[ds][kb] = *(const bf16x8*)(ks + kb * 16 * KLD + ds * 32);
        __builtin_amdgcn_sched_barrier(0);
        __builtin_amdgcn_s_setprio(1);
#pragma unroll
        for (int kb = 0; kb < 4; ++kb) {
          s[kb][0] = __builtin_amdgcn_mfma_f32_16x16x32_bf16(kf[0][kb], qf[0][0], (f32x4){0.f, 0.f, 0.f, 0.f}, 0, 0, 0);
          s[kb][1] = __builtin_amdgcn_mfma_f32_16x16x32_bf16(kf[0][kb], qf[1][0], (f32x4){0.f, 0.f, 0.f, 0.f}, 0, 0, 0);
        }
#pragma unroll
        for (int kb = 0; kb < 4; ++kb) {
          s[kb][0] = __builtin_amdgcn_mfma_f32_16x16x32_bf16(kf[1][kb], qf[0][1], s[kb][0], 0, 0, 0);
          s[kb][1] = __builtin_amdgcn_mfma_f32_16x16x32_bf16(kf[1][kb], qf[1][1], s[kb][1], 0, 0, 0);
        }
        __builtin_amdgcn_s_setprio(0);
      }
      if (MODE == 2) {
        const int nq0 = a.qpos0 + w * 32, t0 = ti * 64;
        if (ti >= a.n0) {
#pragma unroll
          for (int rb = 0; rb < 2; ++rb) {
            const int n = nq0 + rb * 16 + lr;
            const float fac = (ti < a.n0 + a.n1) ? fexp2(a.lgf * (float)(n + 1)) : fexp2(a.lgb * (float)(a.seqN - n));
#pragma unroll
            for (int kb = 0; kb < 4; ++kb)
#pragma unroll
              for (int j = 0; j < 4; ++j) s[kb][rb][j] *= fac;
          }
        } else if (t0 + 63 < nq0) {
#pragma unroll
          for (int rb = 0; rb < 2; ++rb) {
            const float rf = fexp2(a.lgf * (float)(nq0 + rb * 16 + lr - t0));
#pragma unroll
            for (int kb = 0; kb < 4; ++kb)
#pragma unroll
              for (int j = 0; j < 4; ++j) s[kb][rb][j] *= rf * cff[kb][j];
          }
        } else if (t0 > nq0 + 31) {
#pragma unroll
          for (int rb = 0; rb < 2; ++rb) {
            const float rf = fexp2(a.lgb * (float)(t0 - (nq0 + rb * 16 + lr)));
#pragma unroll
            for (int kb = 0; kb < 4; ++kb)
#pragma unroll
              for (int j = 0; j < 4; ++j) s[kb][rb][j] *= rf * cfb[kb][j];
          }
        } else {
#pragma unroll
          for (int rb = 0; rb < 2; ++rb) {
            const int n = nq0 + rb * 16 + lr;
#pragma unroll
            for (int kb = 0; kb < 4; ++kb)
#pragma unroll
              for (int j = 0; j < 4; ++j) {
                const int m = t0 + kb * 16 + lq * 4 + j; const int d = n - m;
                const float fac = d > 0 ? fexp2(a.lgf * (float)d) : (d < 0 ? fexp2(a.lgb * (float)(-d)) : 2.0f);
                s[kb][rb][j] *= fac;
              }
          }
        }
      } else {
        auto softmax_tile = [&](auto wv_tag) {
          constexpr int WV = decltype(wv_tag)::value;
#define KB_USED(kb_, rb_) (WV == 0 || (WV == 1 ? ((kb_) <= 1 + (rb_)) : ((kb_) >= 1 + (rb_))))
          if (WV != 0) {
#pragma unroll
            for (int rb = 0; rb < 2; ++rb) {
              const int c = (w & 1) * 32 + rb * 16 + lr;
              int cs = c - 8; cs = cs < 0 ? 0 : (cs > 48 ? 48 : cs);
              const float* bp = rpbs + (kr - myrow + 7) * 31 + (15 - c);
#pragma unroll
              for (int kb = 0; kb < 4; ++kb) {
                if (!KB_USED(kb, rb)) continue;
#pragma unroll
                for (int j = 0; j < 4; ++j) {
                  const int kc = kb * 16 + lq * 4 + j;
                  const bool valid = (kc >= cs) && (kc < cs + 16);
                  const float bias = valid ? bp[kc] : 0.f;
                  s[kb][rb][j] = valid ? (s[kb][rb][j] * a.scale + bias) : -1e30f;
                }
              }
            }
          }
          const float sc = (WV != 0) ? 1.0f : a.scale;
          float mxl[2];
#pragma unroll
          for (int rb = 0; rb < 2; ++rb) {
            float mx = -1e30f;
#pragma unroll
            for (int kb = 0; kb < 4; ++kb) {
              if (!KB_USED(kb, rb)) continue;
#pragma unroll
              for (int j = 0; j < 4; ++j) mx = fmaxf(mx, s[kb][rb][j]);
            }
            mxl[rb] = mx * sc;
          }
          const bool need = (mxl[0] > mrow[0] + 16.0f) || (mxl[1] > mrow[1] + 16.0f);
          if (__builtin_amdgcn_ballot_w64(need) != 0ull) {
#pragma unroll
            for (int rb = 0; rb < 2; ++rb) {
              float mx = mxl[rb];
              mx = fmaxf(mx, __shfl_xor(mx, 16)); mx = fmaxf(mx, __shfl_xor(mx, 32));
              const float mn = fmaxf(mrow[rb], mx); const float alpha = fexp2(mrow[rb] - mn); mrow[rb] = mn;
              lrow[rb] *= alpha;
#pragma unroll
              for (int nb = 0; nb < NB; ++nb) o[nb][rb] *= alpha;
            }
          }
#pragma unroll
          for (int rb = 0; rb < 2; ++rb) {
            const float mn = mrow[rb];
            float rs = 0.f;
#pragma unroll
            for (int kb = 0; kb < 4; ++kb) {
              if (!KB_USED(kb, rb)) { s[kb][rb] = (f32x4){0.f, 0.f, 0.f, 0.f}; continue; }
#pragma unroll
              for (int j = 0; j < 4; ++j) { const float pv = fexp2(fmaf(s[kb][rb][j], sc, -mn)); s[kb][rb][j] = pv; rs += pv; }
            }
            lrow[rb] += rs;
          }
#undef KB_USED
        };
        if (MODE == 1 && ti < a.n0) { if (w & 1) softmax_tile(IntTag<2>{}); else softmax_tile(IntTag<1>{}); }
        else softmax_tile(IntTag<0>{});
      }
      const bf16* vs = Vs + cur * DV * 72 + lr * 72 + lq * 4;
      bf16x8 pf[2][2];
#pragma unroll
      for (int pp = 0; pp < 2; ++pp)
#pragma unroll
        for (int rb = 0; rb < 2; ++rb) {
          u32x4 t; t.x = pack2(s[2 * pp][rb][0], s[2 * pp][rb][1]); t.y = pack2(s[2 * pp][rb][2], s[2 * pp][rb][3]);
          t.z = pack2(s[2 * pp + 1][rb][0], s[2 * pp + 1][rb][1]); t.w = pack2(s[2 * pp + 1][rb][2], s[2 * pp + 1][rb][3]);
          pf[pp][rb] = __builtin_bit_cast(bf16x8, t);
        }
      constexpr int NG = NB / 4, TOT = 2 * NG;
      bf16x8 vbuf[2][4];
#define ATT_LDV(gi_, dst_) do { const int pp_ = (gi_) / NG, nb0_ = ((gi_) % NG) * 4; \
        _Pragma("unroll") for (int q_ = 0; q_ < 4; ++q_) { \
          const uint2 vlo_ = *(const uint2*)(vs + (nb0_ + q_) * 16 * 72 + (2 * pp_) * 16); \
          const uint2 vhi_ = *(const uint2*)(vs + (nb0_ + q_) * 16 * 72 + (2 * pp_ + 1) * 16); \
          u32x4 t_; t_.x = vlo_.x; t_.y = vlo_.y; t_.z = vhi_.x; t_.w = vhi_.y; dst_[q_] = __builtin_bit_cast(bf16x8, t_); } } while (0)
      ATT_LDV(0, vbuf[0]);
#pragma unroll
      for (int gi = 0; gi < TOT; ++gi) {
        if (gi + 1 < TOT) ATT_LDV(gi + 1, vbuf[(gi + 1) & 1]);
        __builtin_amdgcn_sched_barrier(0);
        const int pp = gi / NG, nb0 = (gi % NG) * 4;
        __builtin_amdgcn_s_setprio(1);
#pragma unroll
        for (int q = 0; q < 4; ++q) {
          o[nb0 + q][0] = __builtin_amdgcn_mfma_f32_16x16x32_bf16(vbuf[gi & 1][q], pf[pp][0], o[nb0 + q][0], 0, 0, 0);
          o[nb0 + q][1] = __builtin_amdgcn_mfma_f32_16x16x32_bf16(vbuf[gi & 1][q], pf[pp][1], o[nb0 + q][1], 0, 0, 0);
        }
        __builtin_amdgcn_s_setprio(0);
        __builtin_amdgcn_sched_barrier(0);
      }
#undef ATT_LDV
    }
    __builtin_amdgcn_sched_barrier(0);
    att_store<DV, NV, NL>(Ks, Vs, cur ^ 1, krow, kch, Rs);
    __syncthreads();
  };
  for (int ti = 0; ti < ntiles; ti += 2) {
    step(ti, 0, R1, R0);
    if (ti + 1 < ntiles) step(ti + 1, 1, R0, R1);
  }
  asm volatile("s_waitcnt vmcnt(0)" : "+v"(R0.k0), "+v"(R0.v0), "+v"(R0.v1), "+v"(R1.k0), "+v"(R1.v0), "+v"(R1.v1) : : "memory");
  if (MODE == 2) {
#pragma unroll
    for (int rb = 0; rb < 2; ++rb) {
      float sum = 0.f;
#pragma unroll
      for (int nb = 0; nb < NB; ++nb)
#pragma unroll
        for (int j = 0; j < 4; ++j) sum += o[nb][rb][j];
      sum += __shfl_xor(sum, 16); sum += __shfl_xor(sum, 32);
      const float mean = sum * (1.0f / (float)DV);
      float var = 0.f;
#pragma unroll
      for (int nb = 0; nb < NB; ++nb)
#pragma unroll
        for (int j = 0; j < 4; ++j) { const float d = o[nb][rb][j] - mean; var += d * d; }
      var += __shfl_xor(var, 16); var += __shfl_xor(var, 32);
      const float rstd = rsqrtf(var * (1.0f / (float)DV) + 1e-5f);
      const size_t tok = (size_t)(a.tok0 + w * 32 + rb * 16 + lr);
      uint2 ovs[NB];
#pragma unroll
      for (int nb = 0; nb < NB; ++nb) {
        const int e0 = nb * 16 + lq * 4;
        const uint2 gv = *(const uint2*)(a.gr + tok * 1024 + a.h * DV + e0);
        const float4 gn = *(const float4*)(a.gn + a.h * DV + e0);
        const float g0 = bf2f((unsigned short)(gv.x & 0xffffu)), g1 = bf2f((unsigned short)(gv.x >> 16));
        const float g2 = bf2f((unsigned short)(gv.y & 0xffffu)), g3 = bf2f((unsigned short)(gv.y >> 16));
        uint2 ov;
        ov.x = pack2((o[nb][rb][0] - mean) * rstd * gn.x * silu_f(g0), (o[nb][rb][1] - mean) * rstd * gn.y * silu_f(g1));
        ov.y = pack2((o[nb][rb][2] - mean) * rstd * gn.z * silu_f(g2), (o[nb][rb][3] - mean) * rstd * gn.w * silu_f(g3));
        ovs[nb] = ov;
      }
#pragma unroll
      for (int k = 0; k < NB / 2; ++k) store_pair16(a.out + tok * a.ldo + a.h * DV + 32 * k, lq, ovs[2 * k], ovs[2 * k + 1]);
    }
  } else {
#pragma unroll
    for (int rb = 0; rb < 2; ++rb) {
      float lt = lrow[rb]; lt += __shfl_xor(lt, 16); lt += __shfl_xor(lt, 32);
      const float inv = __builtin_amdgcn_rcpf(lt);
      bf16* op = a.out + (size_t)(w * 32 + rb * 16 + lr) * a.ldo;
      uint2 ovs[NB];
#pragma unroll
      for (int nb = 0; nb < NB; ++nb) { ovs[nb].x = pack2(o[nb][rb][0] * inv, o[nb][rb][1] * inv); ovs[nb].y = pack2(o[nb][rb][2] * inv, o[nb][rb][3] * inv); }
#pragma unroll
      for (int k = 0; k < NB / 2; ++k) store_pair16(op + 32 * k, lq, ovs[2 * k], ovs[2 * k + 1]);
    }
  }
}

DEV int xcd_item(int item, int per) {
  const int g = item / per, i = item - g * per;
  const int sub = per >> 3;
  return g * per + (i & 7) * sub + (i >> 3);
}

DEV void even_attn_args(const Params& p, AttnArgs& a, int item, int& b, int& h, int& seq0, int& tok0, bool& lat) {
  int qt;
  lat = item < 256;
  if (lat) { b = item >> 5; h = (item >> 2) & 7; qt = item & 3; }
  else { const int i2 = item - 256; b = i2 >> 3; h = i2 & 7; qt = 0; }
  seq0 = lat ? 8192 + b * 1024 : b * 256;
  tok0 = seq0 + qt * 256;
  a.n1 = 0; a.n2 = 0; a.k1 = nullptr; a.vt1 = nullptr; a.vt2 = nullptr; a.ldk1 = 0; a.ldvt1 = 0; a.ldvt2 = 0;
  a.r0 = 0; a.lo = 0; a.scale = 0.125f * LOG2E; a.qpos0 = qt * 256; a.seqN = lat ? 1024 : 256; a.lgf = 0.f; a.lgb = 0.f;
  a.gr = nullptr; a.gn = nullptr; a.tok0 = tok0; a.h = h;
}

DEV void even_mixer_phase(const Params& p, unsigned char* smem) {
  unsigned char* ws = p.ws;
  bf16* MO = (bf16*)(ws + OFF_R1);
  for (int item = blockIdx.x; item < 512; item += gridDim.x) {
    const float* lg2 = (const float*)(ws + OFF_LG2);
    bool lat; int b, h, seq0, tok0; AttnArgs a;
    even_attn_args(p, a, xcd_item(item, 256), b, h, seq0, tok0, lat);
    const size_t hb = lat ? (size_t)8192 * 512 + (size_t)(b * 8 + h) * 1024 * 64 : (size_t)(b * 8 + h) * 256 * 64;
    a.q = (const bf16*)(ws + B_QR) + hb + (size_t)a.qpos0 * 64; a.ldq = 64;
    a.k0 = (const bf16*)(ws + B_KR) + hb; a.ldk0 = 64;
    if (lat) { a.vt0 = (const bf16*)(ws + B_VRT) + (size_t)8192 * 1024 + (size_t)(b * 8 + h) * 16 * 8192; a.ldvt0 = 64; a.n0 = 16;
      a.n1 = 1; a.vt1 = (const bf16*)(ws + S0T_F) + (size_t)(b * 8 + h) * 128 * 64; a.ldvt1 = 64;
      a.n2 = 1; a.vt2 = (const bf16*)(ws + S0T_B) + (size_t)(b * 8 + h) * 128 * 64; a.ldvt2 = 64; }
    else { a.vt0 = (const bf16*)(ws + B_VRT) + (size_t)(b * 8 + h) * 4 * 8192; a.ldvt0 = 64; a.n0 = 4; }
    a.lgf = lg2[h]; a.lgb = lg2[8 + h];
    a.gr = (const bf16*)(ws + B_GR); a.gn = p.ret_gn; a.out = MO; a.ldo = 1536;
    attn_item<128, 2>(a, smem, nullptr);
  }
  for (int item = blockIdx.x; item < 512; item += gridDim.x) {
    bool lat; int b, h, seq0, tok0; AttnArgs a;
    even_attn_args(p, a, xcd_item(item, 256), b, h, seq0, tok0, lat);
    const int kvh = h >> 2;
    const size_t hb = lat ? (size_t)8192 * 512 + (size_t)(b * 8 + h) * 1024 * 64 : (size_t)(b * 8 + h) * 256 * 64;
    a.q = (const bf16*)(ws + B_QA) + hb + (size_t)a.qpos0 * 64; a.ldq = 64;
    a.k0 = (const bf16*)(ws + B_KA) + (lat ? (size_t)8192 * 128 + (size_t)(b * 2 + kvh) * 1024 * 64 : (size_t)(b * 2 + kvh) * 256 * 64); a.ldk0 = 64;
    if (lat) { a.vt0 = (const bf16*)(ws + B_VAT) + (size_t)32 * 2 * 64 * 256 + (size_t)(b * 2 + kvh) * 16 * 4096; a.ldvt0 = 64; a.n0 = 16;
      a.n1 = 4; a.k1 = (const bf16*)(ws + CK_GQA) + (size_t)(b * 2 + kvh) * 256 * 64; a.ldk1 = 64;
      a.vt1 = (const bf16*)(ws + CVT_GQA) + (size_t)(b * 2 + kvh) * 64 * 256; a.ldvt1 = 256; }
    else { a.vt0 = (const bf16*)(ws + B_VAT) + (size_t)(b * 2 + kvh) * 4 * 4096; a.ldvt0 = 64; a.n0 = 4; }
    a.out = MO + (size_t)tok0 * 1536 + 1024 + h * 64; a.ldo = 1536;
    attn_item<64, 0>(a, smem, nullptr);
  }
  for (int item = blockIdx.x; item < 256; item += gridDim.x) {
    const int b = item >> 3, h = item & 7;
    gemm_core((const bf16*)(ws + B_KTFB) + (size_t)(b * 8 + h) * 2 * 64 * 256, 256, (const bf16*)(ws + B_VRT) + (size_t)(b * 8 + h) * 4 * 8192, 64, 8192, 256, smem);
    epi_state(p, b, h, (const float*)smem);
  }
}

DEV void odd_mixer_phase(const Params& p, unsigned char* smem) {
  unsigned char* ws = p.ws;
  bf16* MO = (bf16*)(ws + OFF_R1);
  float* rpbs = (float*)(smem + 65536);
  for (int item = blockIdx.x; item < 1024; item += gridDim.x) {
    AttnArgs a;
    a.n1 = 0; a.n2 = 0; a.k1 = nullptr; a.vt1 = nullptr; a.vt2 = nullptr; a.ldk1 = 0; a.ldvt1 = 0; a.ldvt2 = 0;
    a.r0 = 0; a.lo = 0; a.scale = 0.125f * LOG2E; a.qpos0 = 0; a.seqN = 0; a.lgf = 0.f; a.lgb = 0.f;
    a.gr = nullptr; a.gn = nullptr; a.tok0 = 0; a.h = 0;
    if (item < 512) {
      const int it2 = xcd_item(item, 512);
      const int b = it2 >> 6, h = (it2 >> 2) & 15, rq = (it2 & 3) ^ ((item >> 8) & 1); const int r0 = rq * 4;
      int lo = r0 - 4; lo = lo < 0 ? 0 : (lo > 8 ? 8 : lo);
      int hi = r0 + 3 - 4; hi = hi < 0 ? 0 : (hi > 8 ? 8 : hi); hi += 8;
      const int seq0 = 8192 + b * 1024; const int tok0 = seq0 + r0 * 64;
      for (int idx = threadIdx.x; idx < 465; idx += 512) rpbs[idx] = p.na_rpb[h * 465 + idx] * LOG2E;
      const size_t hb = (size_t)8192 * 1024 + (size_t)(b * 16 + h) * 1024 * 64;
      a.q = (const bf16*)(ws + B_Q) + hb + (size_t)r0 * 64 * 64; a.ldq = 64;
      a.k0 = (const bf16*)(ws + B_K) + hb + (size_t)lo * 64 * 64; a.ldk0 = 64;
      a.vt0 = (const bf16*)(ws + B_VT) + (size_t)8192 * 1024 + ((size_t)(b * 16 + h) * 16 + lo) * 4096; a.ldvt0 = 64; a.n0 = hi - lo;
      a.n1 = 4; a.k1 = (const bf16*)(ws + CK_NA) + (size_t)(b * 16 + h) * 256 * 64; a.ldk1 = 64;
      a.vt1 = (const bf16*)(ws + CVT_NA) + (size_t)(b * 16 + h) * 64 * 256; a.ldvt1 = 256;
      a.r0 = r0; a.lo = lo;
      a.out = MO + (size_t)tok0 * 1024 + h * 64; a.ldo = 1024;
      attn_item<64, 1>(a, smem, rpbs);
    } else {
      const int i2 = item - 512; const int b = i2 >> 4, h = i2 & 15;
      const int seq0 = b * 256; const int tok0 = seq0;
      const size_t hb = (size_t)(b * 16 + h) * 256 * 64;
      a.q = (const bf16*)(ws + B_Q) + hb; a.ldq = 64;
      a.k0 = (const bf16*)(ws + B_K) + hb; a.ldk0 = 64;
      a.vt0 = (const bf16*)(ws + B_VT) + (size_t)(b * 16 + h) * 4 * 4096; a.ldvt0 = 64; a.n0 = 4;
      a.out = MO + (size_t)tok0 * 1024 + h * 64; a.ldo = 1024;
      attn_item<64, 0>(a, smem, nullptr);
    }
  }
}

__global__ void __launch_bounds__(512, 2) mega_kernel(Params p) {
  extern __shared__ __attribute__((aligned(16))) unsigned char smem[];
  if (threadIdx.x == 0) *(uint4*)(smem + SMEM_BYTES) = make_uint4(0u, 0u, 0u, 0u);
  __syncthreads();
  XcdBarrier bar = xcd_barrier_post((unsigned*)(p.ws + OFF_BAR), (volatile LAS unsigned*)(smem + SMEM_BYTES));
  unsigned char* ws = p.ws;

  for (int i = blockIdx.x; i < 785; i += gridDim.x) {
    const int old = i < 192 ? i : (i < 432 ? 384 + (i - 192) : (i < 496 ? 624 + (i - 432) : (i < 752 ? 624 + 576 + (i - 496) : (i < 784 ? 1456 + (i - 752) : 1744))));
    p0_item(p, old, smem);
  }
  xcd_barrier(bar);

  {
    float* mod = (float*)(ws + OFF_MOD); const float* mp = (const float*)(ws + OFF_MODP);
    for (int idx = blockIdx.x * 512 + threadIdx.x; idx < 9 * 6144; idx += gridDim.x * 512) {
      const int l = 0, n = idx % 6144;
      float s = p.ada_b[l * 6144 + n];
#pragma unroll
      for (int kq = 0; kq < 8; ++kq) s += mp[(size_t)kq * 110592 + idx];
      mod[idx] = s;
    }
  }
  norm_phase(p, 0, 0, 1, p.norm_mix, p.x_prompt, p.x_sample, true, smem);
  xcd_barrier(bar);

  gemm_phase<0>(p, (const bf16*)(ws + OFF_R1), (const bf16*)(ws + WT_EIN), 1024, 3840, 0, 0, nullptr, nullptr, smem);
  xcd_barrier(bar);
  even_mixer_phase(p, smem);
  xcd_barrier(bar);
  gemm_phase<2>(p, (const bf16*)(ws + OFF_R1), (const bf16*)(ws + WT_EOUT), 1536, 1024, 0, 2 | 16, p.x_prompt, p.x_sample, smem);
  xcd_barrier(bar);
  norm_phase(p, 0, 3, 4, p.norm_ffn, nullptr, nullptr, false, smem);
  xcd_barrier(bar);
  gemm_phase<3>(p, (const bf16*)(ws + OFF_R1), (const bf16*)(ws + WT_UP), 1024, 5632, 0, 0, nullptr, nullptr, smem);
  xcd_barrier(bar);
  {
    float* mod = (float*)(ws + OFF_MOD); const float* mp = (const float*)(ws + OFF_MODP);
    for (int idx = 55296 + blockIdx.x * 512 + threadIdx.x; idx < 2 * 55296; idx += gridDim.x * 512) {
      float sacc = p.ada_b[6144 + idx % 6144];
#pragma unroll
      for (int kq = 0; kq < 8; ++kq) sacc += mp[(size_t)kq * 110592 + idx];
      mod[idx] = sacc;
    }
  }
  gemm_phase<2>(p, (const bf16*)(ws + B_ACT), (const bf16*)(ws + WT_DN), 2816, 1024, 0, 5 | 16, nullptr, nullptr, smem);
  xcd_barrier(bar);

  norm_phase(p, 1, 0, 1, p.norm_mix + 1024, nullptr, nullptr, false, smem);
  xcd_barrier(bar);
  gemm_phase<1>(p, (const bf16*)(ws + OFF_R1), (const bf16*)(ws + WT_OIN), 1024, 3072, 1, 0, nullptr, nullptr, smem);
  xcd_barrier(bar);
  odd_mixer_phase(p, smem);
  xcd_barrier(bar);
  gemm_phase<2>(p, (const bf16*)(ws + OFF_R1), (const bf16*)(ws + WT_OOUT), 1024, 1024, 1, 2 | 16, nullptr, nullptr, smem);
  xcd_barrier(bar);
  norm_phase(p, 1, 3, 4, p.norm_ffn + 1024, nullptr, nullptr, false, smem);
  xcd_barrier(bar);
  gemm_phase<3>(p, (const bf16*)(ws + OFF_R1), (const bf16*)(ws + WT_UP) + (size_t)5632 * 1024, 1024, 5632, 1, 0, nullptr, nullptr, smem);
  xcd_barrier(bar);
  gemm_phase<2>(p, (const bf16*)(ws + B_ACT), (const bf16*)(ws + WT_DN) + (size_t)1024 * 2816, 2816, 1024, 1, 5 | 16, nullptr, nullptr, smem);
  xcd_barrier(bar);

  final_norm_phase(p);
}

extern "C" void kernel_launch(void* const* d_in, const int* in_sizes, int n_in, void* d_out, int out_size, void* d_ws, size_t ws_size,
                              hipStream_t stream) {
  static int grid_blocks = 0;
  if (!grid_blocks) {
    int dev = 0, cus = 0, per_cu = 0;
    hipGetDevice(&dev);
    hipDeviceGetAttribute(&cus, hipDeviceAttributeMultiprocessorCount, dev);
    if (hipFuncSetAttribute((const void*)mega_kernel, hipFuncAttributeMaxDynamicSharedMemorySize, LDS_TOTAL) != hipSuccess) fprintf(stderr, "hipFuncSetAttribute failed\n");
    hipOccupancyMaxActiveBlocksPerMultiprocessor(&per_cu, mega_kernel, 512, LDS_TOTAL);
    (void)hipGetLastError();
    if (per_cu > 1) per_cu = 1;
    if (per_cu < 1) per_cu = 1;
    grid_blocks = cus * per_cu;
    if (grid_blocks % 8) grid_blocks -= grid_blocks % 8;
  }
  if (ws_size < (size_t)WS_NEEDED) fprintf(stderr, "workspace too small: %zu < %llu\n", ws_size, (unsigned long long)WS_NEEDED);
  Params p{};
  const float** pp = (const float**)&p;
  for (int i = 0; i < 29; ++i) pp[i] = (const float*)d_in[i];
  p.out = (float*)d_out;
  p.ws = (unsigned char*)d_ws;
  hipMemsetAsync(d_ws, 0, XCD_BAR_WORDS * 4, stream);
  void* args[] = {&p};
  hipError_t e = hipLaunchCooperativeKernel((void*)mega_kernel, dim3(grid_blocks), dim3(512), args, LDS_TOTAL, stream);
  if (e != hipSuccess) fprintf(stderr, "cooperative launch failed: %s (grid %d)\n", hipGetErrorString(e), grid_blocks);
}
```

```cpp
#include <hip/hip_runtime.h>
#include <stdint.h>
#include <stdio.h>

typedef unsigned short bf16;
typedef __attribute__((ext_vector_type(8))) short bf16x8;
typedef __attribute__((ext_vector_type(4))) float f32x4;
typedef __attribute__((ext_vector_type(4))) unsigned u32x4;

#define DEV __device__ __forceinline__
#define LOG2E 1.4426950408889634f

#define OFF_BAR    0ull
#define OFF_ROPE   16384ull
#define OFF_LG2    (16384ull + 8192ull)
#define OFF_MOD    32768ull
#define OFF_MODP   491520ull
#define OFF_WT     4194304ull
#define WT_EIN     (OFF_WT)
#define WT_EOUT    (WT_EIN + 7864320ull)
#define WT_OIN     (WT_EOUT + 3145728ull)
#define WT_OOUT    (WT_OIN + 6291456ull)
#define WT_UP      (WT_OOUT + 2097152ull)
#define WT_DN      (WT_UP + 2ull * 11534336ull)
#define OFF_CACHE  (WT_DN + 2ull * 5767168ull)
#define CK_GQA     (OFF_CACHE)
#define CVT_GQA    (CK_GQA + 524288ull)
#define CK_NA      (CVT_GQA + 524288ull)
#define CVT_NA     (CK_NA + 4194304ull)
#define S0T_F      (CVT_NA + 4194304ull)
#define S0T_B      (S0T_F + 1048576ull)
#define OFF_R1     (S0T_B + 1048576ull)
#define OFF_R2     (OFF_R1 + 50331648ull)
#define B_QR       (OFF_R2)
#define B_KR       (B_QR + 16777216ull)
#define B_VRT      (B_KR + 16777216ull)
#define B_GR       (B_VRT + 33554432ull)
#define B_QA       (B_GR + 33554432ull)
#define B_KA       (B_QA + 16777216ull)
#define B_VAT      (B_KA + 4194304ull)
#define B_KTFB     (B_VAT + 4194304ull)
#define R2_END     (B_KTFB + 16777216ull)
#define B_Q        (OFF_R2)
#define B_K        (B_Q + 33554432ull)
#define B_VT       (B_K + 33554432ull)
#define B_ACT      (OFF_R2)
#define B_HALO     (B_ACT + 92274688ull)
#define B_XB       (OFF_R2 + 103809024ull)
#define WS_NEEDED  (R2_END)

#define O_YP 0ull
#define O_SF 16777216ull
#define O_SB 18874368ull
#define O_GK 20971520ull
#define O_GV 22020096ull
#define O_NK 23068672ull
#define O_NV 31457280ull

#define SMEM_BYTES 135168
#define NTHR 512
#define LDS_TOTAL (SMEM_BYTES + 16)

struct Params {
  const float *x_prompt, *x_sample, *state_f, *state_b, *cgk, *cgv, *cnk, *cnv, *c, *c_ctx, *ada_w, *ada_b,
      *norm_mix, *norm_ffn, *norm_final, *even_w_in, *even_w_out, *decay_f, *decay_b, *ret_gn, *q_norm, *k_norm,
      *odd_w_in, *odd_w_out, *na_rpb, *w_up, *conv_w, *conv_b, *w_down;
  float* out;
  unsigned char* ws;
};

DEV unsigned short f2bf(float f) { unsigned u = __float_as_uint(f); u += 0x7fffu + ((u >> 16) & 1u); return (unsigned short)(u >> 16); }
DEV float bf2f(unsigned short h) { return __uint_as_float(((unsigned)h) << 16); }
DEV unsigned pack2(float a, float b) { unsigned r; asm("v_cvt_pk_bf16_f32 %0, %1, %2" : "=v"(r) : "v"(a), "v"(b)); return r; }
DEV uint4 pack8(const float* v) { uint4 o; o.x = pack2(v[0], v[1]); o.y = pack2(v[2], v[3]); o.z = pack2(v[4], v[5]); o.w = pack2(v[6], v[7]); return o; }
DEV float fexp2(float x) { return __builtin_amdgcn_exp2f(x); }
DEV u32x4 gload16(const void* p) { u32x4 r; asm volatile("global_load_dwordx4 %0, %1, off" : "=v"(r) : "v"(p) : "memory"); return r; }
#define VMWAIT4(a, b, c, d) asm volatile("s_waitcnt vmcnt(0)" : "+v"(a), "+v"(b), "+v"(c), "+v"(d) : : "memory")
#define VMWAIT2(a, b) asm volatile("s_waitcnt vmcnt(0)" : "+v"(a), "+v"(b) : : "memory")
DEV float silu_f(float x) { return x * __builtin_amdgcn_rcpf(1.0f + __expf(-x)); }

#define XB_TMO      128
#define XB_XCNT(j)  (256  + 64 * (j))
#define XB_XSUB(j)  (1280 + 64 * (j))
#define XB_XGEN(j)  (2304 + 64 * (j))
#define XB_TOP      3328
#define XB_TOPGEN   3392
#define XCD_BAR_WORDS 3456
#define XB_SPIN_CAP (1u << 22)
#define LAS __attribute__((address_space(3)))

DEV unsigned xb_ld(unsigned* p) { return __hip_atomic_load(p, __ATOMIC_RELAXED, __HIP_MEMORY_SCOPE_AGENT); }
DEV unsigned xb_add(unsigned* p, unsigned v) { return __hip_atomic_fetch_add(p, v, __ATOMIC_RELAXED, __HIP_MEMORY_SCOPE_AGENT); }
DEV unsigned xb_xcc_id() { return (unsigned)__builtin_amdgcn_s_getreg((3 << 11) | 20) & 0xFu; }
#define XB_SPIN(cond, bar) do { unsigned _sp = 0; while (cond) { __builtin_amdgcn_s_sleep(1); \
    if ((++_sp & 255u) == 0u) { if (xb_ld(&(bar)[XB_TMO])) break; if (_sp > XB_SPIN_CAP) { atomicAdd(&(bar)[XB_TMO], 1u); break; } } } } while (0)

struct XcdBarrier { unsigned* bar; unsigned x; volatile LAS unsigned* st; };

DEV XcdBarrier xcd_barrier_post(unsigned* bar, volatile LAS unsigned* st) {
  XcdBarrier b; b.bar = bar; b.x = xb_xcc_id(); b.st = st;
  if (threadIdx.x == 0) (void)xb_add(&bar[XB_XCNT(b.x)], 1u);
  return b;
}
DEV void xcd_barrier_complete(unsigned* bar, unsigned x, unsigned& nloc, unsigned& nx) {
  const unsigned G = gridDim.x * gridDim.y * gridDim.z;
  unsigned sum, cnt, mine, sp = 0u;
  for (;;) {
    sum = 0u; cnt = 0u; mine = 0u;
#pragma unroll
    for (unsigned j = 0; j < 16; ++j) { const unsigned c = xb_ld(&bar[XB_XCNT(j)]); sum += c; cnt += (c > 0u) ? 1u : 0u; mine = (j == x) ? c : mine; }
    if (sum == G) break;
    __builtin_amdgcn_s_sleep(1);
    if ((++sp & 255u) == 0u) { if (xb_ld(&bar[XB_TMO])) break; if (sp > XB_SPIN_CAP) { atomicAdd(&bar[XB_TMO], 1u); break; } }
  }
  nloc = mine > 0u ? mine : 1u; nx = cnt > 0u ? cnt : 1u;
}
DEV void xcd_barrier(const XcdBarrier& b) {
  asm volatile("s_waitcnt vmcnt(0)" ::: "memory");
  __syncthreads();
  if (threadIdx.x == 0) {
    unsigned* bar = b.bar;
    __builtin_amdgcn_s_waitcnt(0);
    unsigned nloc = b.st[0], nx = b.st[1];
    if (nloc == 0u) { xcd_barrier_complete(bar, b.x, nloc, nx); b.st[0] = nloc; b.st[1] = nx; }
    const unsigned old = xb_add(&bar[XB_XSUB(b.x)], 1u);
    const unsigned gen = old / nloc;
    if (old + 1u == (gen + 1u) * nloc) {
      __builtin_amdgcn_fence(__ATOMIC_RELEASE, "agent");
      asm volatile("s_waitcnt vmcnt(0)" ::: "memory");
      const unsigned og = xb_add(&bar[XB_TOP], 1u);
      const unsigned tg = og / nx;
      if (og + 1u == (tg + 1u) * nx) xb_add(&bar[XB_TOPGEN], 1u);
      else XB_SPIN(xb_ld(&bar[XB_TOPGEN]) == tg, bar);
      __builtin_amdgcn_fence(__ATOMIC_ACQUIRE, "agent");
      xb_add(&bar[XB_XGEN(b.x)], 1u);
      asm volatile("s_waitcnt vmcnt(0)" ::: "memory");
    } else {
      XB_SPIN(xb_ld(&bar[XB_XGEN(b.x)]) == gen, bar);
      __builtin_amdgcn_fence(__ATOMIC_ACQUIRE, "agent");
      asm volatile("s_waitcnt vmcnt(0)" ::: "memory");
    }
  }
  __syncthreads();
}

DEV void p0_transpose(const float* __restrict__ src, int ld, bf16* __restrict__ dst, int ldd, float* sm) {
  int tid = threadIdx.x; asm volatile("" : "+v"(tid));
#pragma unroll
  for (int i = 0; i < 2; ++i) {
    int idx = tid + 512 * i; int r = idx >> 4, c4 = idx & 15;
    float4 v = *(const float4*)(src + (size_t)r * ld + c4 * 4);
    float* d = sm + r * 65 + c4 * 4; d[0] = v.x; d[1] = v.y; d[2] = v.z; d[3] = v.w;
  }
  __syncthreads();
  {
    int idx = tid; int c = idx >> 3, rc = idx & 7; float v[8];
#pragma unroll
    for (int e = 0; e < 8; ++e) v[e] = sm[(rc * 8 + e) * 65 + c];
    *(uint4*)(dst + (size_t)c * ldd + rc * 8) = pack8(v);
  }
  __syncthreads();
}

DEV void p0_transpose4(const float* __restrict__ src, int ld, bf16* __restrict__ d0, bf16* __restrict__ d1, bf16* __restrict__ d2, bf16* __restrict__ d3, int ldd, float scale, float* sm) {
  int tid = threadIdx.x; asm volatile("" : "+v"(tid));
  float4 v[8];
#pragma unroll
  for (int i = 0; i < 8; ++i) { const int idx = tid + 512 * i; const int r = idx >> 6, c4 = idx & 63; v[i] = *(const float4*)(src + (size_t)r * ld + c4 * 4); }
#pragma unroll
  for (int i = 0; i < 8; ++i) { const int idx = tid + 512 * i; const int r = idx >> 6, c4 = idx & 63; float* d = sm + r * 257 + c4 * 4; d[0] = v[i].x; d[1] = v[i].y; d[2] = v[i].z; d[3] = v[i].w; }
  __syncthreads();
#pragma unroll
  for (int i = 0; i < 4; ++i) {
    const int idx = tid + 512 * i; const int c = idx >> 3, rc = idx & 7; float o[8];
#pragma unroll
    for (int e = 0; e < 8; ++e) o[e] = sm[(rc * 8 + e) * 257 + c] * scale;
    bf16* db = (i == 0) ? d0 : (i == 1) ? d1 : (i == 2) ? d2 : d3;
    *(uint4*)(db + (size_t)(c & 63) * ldd + rc * 8) = pack8(o);
  }
  __syncthreads();
}

DEV void p0_weight(const Params& p, int item, unsigned char* smem) {
  unsigned char* ws = p.ws;
  const float* src; bf16* dst; int R, C, remap = 0; int t = item;
  if (t < 240) { src = p.even_w_in; R = 1024; C = 3840; dst = (bf16*)(ws + WT_EIN); }
  else if ((t -= 240) < 96) { src = p.even_w_out; R = 1536; C = 1024; dst = (bf16*)(ws + WT_EOUT); }
  else if ((t -= 96) < 192) { src = p.odd_w_in; R = 1024; C = 3072; dst = (bf16*)(ws + WT_OIN); }
  else if ((t -= 192) < 64) { src = p.odd_w_out; R = 1024; C = 1024; dst = (bf16*)(ws + WT_OOUT); }
  else if ((t -= 64) < 704) { int l = t / 352; t %= 352; src = p.w_up + (size_t)l * 1024 * 5632; R = 1024; C = 5632; dst = (bf16*)(ws + WT_UP) + (size_t)l * 5632 * 1024; remap = 1; }
  else { t -= 704; int l = t / 176; t %= 176; src = p.w_down + (size_t)l * 2816 * 1024; R = 2816; C = 1024; dst = (bf16*)(ws + WT_DN) + (size_t)l * 1024 * 2816; }
  const int tcn = C >> 8; const int rt = t / tcn, c4 = t % tcn;
  bf16* d[4];
#pragma unroll
  for (int j = 0; j < 4; ++j) { const int ct = c4 * 4 + j; const int drow = remap ? ((ct % 44) * 128 + (ct / 44) * 64) : ct * 64; d[j] = dst + (size_t)drow * R + rt * 64; }
  const float wscale = (item < 240 && (c4 == 2 || c4 == 3)) ? 0.125f : 1.0f;
  p0_transpose4(src + (size_t)rt * 64 * C + c4 * 256, C, d[0], d[1], d[2], d[3], R, wscale, (float*)smem);
}
DEV void p0_item(const Params& p, int item, unsigned char* smem);
DEV void p0_weight_tail(const Params& p, int group, int total_units, unsigned char* smem) {
  const int G = (int)gridDim.x, c = (int)blockIdx.x;
  const int nfull = total_units % G;
  const int first = nfull ? nfull : 0, nw = nfull ? (G - nfull) : G;
  if (c < first) return;
  const int n = group ? 784 + 960 : 624;
  for (int i = c - first; i < n; i += nw) {
    if (i >= 784) {
      const int j = i - 784;
      p0_item(p, j < 192 ? 192 + j : (j < 704 ? 624 + 64 + (j - 192) : 1456 + 32 + (j - 704)), smem);
      continue;
    }
    int t;
    if (group == 0) t = i < 96 ? 240 + i : (i < 448 ? 592 + (i - 96) : 1296 + (i - 448));
    else t = i < 192 ? 336 + i : (i < 256 ? 528 + (i - 192) : (i < 608 ? 944 + (i - 256) : 1472 + (i - 608)));
    p0_weight(p, t, smem);
  }
}

DEV void p0_item(const Params& p, int item, unsigned char* smem) {
  int tid = threadIdx.x; asm volatile("" : "+v"(tid)); const int lane = tid & 63, w = tid >> 6;
  unsigned char* ws = p.ws;
  if (item < 384) {
    const int l = item / 192, rem = item % 192, cb = rem >> 3, kq = rem & 7;
    float* sc = (float*)smem;
    float* red = sc + 9 * 128;
    for (int idx = tid; idx < 9 * 128; idx += 512) {
      int crow = idx >> 7, kk = idx & 127, k = kq * 128 + kk;
      float v = crow < 8 ? p.c[crow * 1024 + k] : p.c_ctx[k];
      sc[idx] = silu_f(v);
    }
    __syncthreads();
    float acc[9][4];
#pragma unroll
    for (int r = 0; r < 9; ++r) { acc[r][0] = 0.f; acc[r][1] = 0.f; acc[r][2] = 0.f; acc[r][3] = 0.f; }
    const float* wp = p.ada_w + ((size_t)(l * 1024 + kq * 128 + w * 16)) * 6144 + cb * 256 + lane * 4;
#pragma unroll 8
    for (int kk = 0; kk < 16; ++kk) {
      float4 wv = *(const float4*)(wp + (size_t)kk * 6144);
#pragma unroll
      for (int r = 0; r < 9; ++r) {
        float s = sc[r * 128 + w * 16 + kk];
        acc[r][0] += s * wv.x; acc[r][1] += s * wv.y; acc[r][2] += s * wv.z; acc[r][3] += s * wv.w;
      }
    }
#pragma unroll
    for (int r = 0; r < 9; ++r) {
      float* d = red + (w * 9 + r) * 256 + lane * 4;
      d[0] = acc[r][0]; d[1] = acc[r][1]; d[2] = acc[r][2]; d[3] = acc[r][3];
    }
    __syncthreads();
    float* modp = (float*)(ws + OFF_MODP);
    for (int idx = tid; idx < 9 * 256; idx += 512) {
      int r = idx >> 8, cc = idx & 255;
      float s = 0.f;
#pragma unroll
      for (int ww = 0; ww < 8; ++ww) s += red[(ww * 9 + r) * 256 + cc];
      modp[((size_t)(kq * 2 + l) * 9 + r) * 6144 + cb * 256 + cc] = s;
    }
    __syncthreads();
    return;
  }
  item -= 384;
  if (item < 240) { p0_weight(p, item, smem); return; }
  item -= 240;
  if (item < 832) {
    const float* src; bf16* dst; int R, C, tiled = 0; int t = item;
    if (t < 64) { int mat = t >> 2; t &= 3; src = p.cgv + (size_t)mat * 256 * 64; R = 256; C = 64; dst = (bf16*)(ws + CVT_GQA) + (size_t)mat * 64 * 256; tiled = 1; }
    else if ((t -= 64) < 512) { int mat = t >> 2; t &= 3; src = p.cnv + (size_t)mat * 256 * 64; R = 256; C = 64; dst = (bf16*)(ws + CVT_NA) + (size_t)mat * 64 * 256; tiled = 1; }
    else { t -= 512; int which = t >> 7; t &= 127; int mat = t >> 1; t &= 1; src = (which ? p.state_b : p.state_f) + (size_t)mat * 64 * 128; R = 64; C = 128; dst = (bf16*)(ws + (which ? S0T_B : S0T_F)) + (size_t)mat * 128 * 64; }
    const int tcn = C >> 6; const int rt = t / tcn, ct = t % tcn;
    if (tiled) p0_transpose(src + (size_t)rt * 64 * C, C, dst + (size_t)rt * 4096, 64, (float*)smem);
    else p0_transpose(src + (size_t)rt * 64 * C + ct * 64, C, dst + (size_t)(ct * 64) * R + rt * 64, R, (float*)smem);
    return;
  }
  item -= 832;
  if (item < 288) {
    const float* src; bf16* dst; size_t base;
    if (item < 32) { src = p.cgk; dst = (bf16*)(ws + CK_GQA); base = (size_t)item * 8192; }
    else { src = p.cnk; dst = (bf16*)(ws + CK_NA); base = (size_t)(item - 32) * 8192; }
#pragma unroll
    for (int i = 0; i < 2; ++i) {
      size_t o = base + (size_t)(i * 512 + tid) * 8;
      float4 a = *(const float4*)(src + o), b = *(const float4*)(src + o + 4);
      float v[8] = {a.x, a.y, a.z, a.w, b.x, b.y, b.z, b.w};
      *(uint4*)(dst + o) = pack8(v);
    }
    return;
  }
  {
    float2* rope = (float2*)(ws + OFF_ROPE);
    for (int idx = tid; idx < 1024; idx += 512) {
      int pos = idx >> 4, fi = idx & 15;
      float inv = exp2f(-(float)fi * 0.8304820237218406f);
      float ang = (float)pos * inv;
      float k = rintf(ang * 0.15915494309189535f);
      float r = fmaf(-k, 6.2831854820251465f, ang);
      r = fmaf(-k, -1.7484556e-7f, r);
      rope[idx] = make_float2(__cosf(r), __sinf(r));
    }
    if (tid < 16) {
      int fb = tid >> 3, h = tid & 7;
      float x = (fb ? p.decay_b : p.decay_f)[h];
      float lg = -log1pf(expf(-x)) * LOG2E;
      ((float*)(ws + OFF_LG2))[tid] = lg;
    }
  }
}

DEV float modval(const Params& p, int l, int crow, int n, bool partial) {
  if (!partial) return ((const float*)(p.ws + OFF_MOD))[(size_t)(l * 9 + crow) * 6144 + n];
  const float* mp = (const float*)(p.ws + OFF_MODP);
  float s = p.ada_b[l * 6144 + n];
#pragma unroll
  for (int kq = 0; kq < 8; ++kq) s += mp[((size_t)(kq * 2 + l) * 9 + crow) * 6144 + n];
  return s;
}

DEV void norm_phase(const Params& p, int l, int si, int sci, const float* g, const float* xc, const float* xs, bool partial, unsigned char* smem) {
  int tid = threadIdx.x; asm volatile("" : "+v"(tid)); const int lane = tid & 63, w = tid >> 6;
  float* ssh = (float*)smem; float* ssc = ssh + 1024;
  bf16* H = (bf16*)(p.ws + OFF_R1);
  for (int chunk = blockIdx.x; chunk < 512; chunk += gridDim.x) {
    const int row0 = chunk * 32; const int crow = row0 < 8192 ? 8 : ((row0 - 8192) >> 10);
    for (int idx = tid; idx < 1024; idx += 512) {
      ssh[idx] = modval(p, l, crow, si * 1024 + idx, partial);
      ssc[idx] = (1.0f + modval(p, l, crow, sci * 1024 + idx, partial)) * g[idx];
    }
    __syncthreads();
    for (int rr = 0; rr < 4; ++rr) {
      const int row = row0 + w * 4 + rr;
      float4 v[4]; float ss = 0.f;
      if (xc) {
        const float* xp = row < 8192 ? xc + (size_t)row * 1024 : xs + (size_t)(row - 8192) * 1024;
#pragma unroll
        for (int i = 0; i < 4; ++i) v[i] = *(const float4*)(xp + lane * 4 + 256 * i);
      } else {
        const bf16* xp = (const bf16*)(p.ws + B_XB) + (size_t)row * 1024;
#pragma unroll
        for (int i = 0; i < 4; ++i) { const uint2 q = *(const uint2*)(xp + lane * 4 + 256 * i);
          v[i] = make_float4(__uint_as_float(q.x << 16), __uint_as_float(q.x & 0xffff0000u), __uint_as_float(q.y << 16), __uint_as_float(q.y & 0xffff0000u)); }
      }
#pragma unroll
      for (int i = 0; i < 4; ++i) ss += v[i].x * v[i].x + v[i].y * v[i].y + v[i].z * v[i].z + v[i].w * v[i].w;
#pragma unroll
      for (int o = 1; o < 64; o <<= 1) ss += __shfl_xor(ss, o);
      const float rstd = rsqrtf(ss * (1.0f / 1024.0f) + 1e-6f);
#pragma unroll
      for (int i = 0; i < 4; ++i) {
        const int col = lane * 4 + 256 * i;
        float4 sc = *(const float4*)(ssc + col), sh = *(const float4*)(ssh + col);
        uint2 o; o.x = pack2(v[i].x * rstd * sc.x + sh.x, v[i].y * rstd * sc.y + sh.y);
        o.y = pack2(v[i].z * rstd * sc.z + sh.z, v[i].w * rstd * sc.w + sh.w);
        *(uint2*)(H + (size_t)row * 1024 + col) = o;
      }
    }
    __syncthreads();
  }
}

DEV void final_norm_phase(const Params& p) {
  int tid = threadIdx.x; asm volatile("" : "+v"(tid)); const int lane = tid & 63, w = tid >> 6;
  for (int row = blockIdx.x * 8 + w; row < 16384; row += gridDim.x * 8) {
    const bf16* xp = (const bf16*)(p.ws + B_XB) + (size_t)row * 1024;
    float* yp = p.out + (size_t)row * 1024;
    float4 v[4]; float ss = 0.f;
#pragma unroll
    for (int i = 0; i < 4; ++i) { const uint2 q = *(const uint2*)(xp + lane * 4 + 256 * i);
      v[i] = make_float4(__uint_as_float(q.x << 16), __uint_as_float(q.x & 0xffff0000u), __uint_as_float(q.y << 16), __uint_as_float(q.y & 0xffff0000u));
      ss += v[i].x * v[i].x + v[i].y * v[i].y + v[i].z * v[i].z + v[i].w * v[i].w; }
#pragma unroll
    for (int o = 1; o < 64; o <<= 1) ss += __shfl_xor(ss, o);
    const float rstd = rsqrtf(ss * (1.0f / 1024.0f) + 1e-6f);
#pragma unroll
    for (int i = 0; i < 4; ++i) {
      const int col = lane * 4 + 256 * i;
      float4 g = *(const float4*)(p.norm_final + col);
      *(float4*)(yp + col) = make_float4(v[i].x * rstd * g.x, v[i].y * rstd * g.y, v[i].z * rstd * g.z, v[i].w * rstd * g.w);
    }
  }
}

#define CT_LD 132
DEV void gemm_core(const bf16* __restrict__ A, int lda, const bf16* __restrict__ B, int ldb, int kstepB, int K, unsigned char* smem) {
  int tid = threadIdx.x; asm volatile("" : "+v"(tid)); const int lane = tid & 63, w = tid >> 6;
  const int wr = w >> 2, wc = w & 3, lr = lane & 15, lq = lane >> 4;
  bf16* As = (bf16*)smem;
  bf16* Bs = As + 2 * 128 * 72;
  const int ldr = tid >> 3, ldc = (tid & 7) * 8;
  const bf16* Ap = A + (size_t)ldr * lda + ldc;
  const bf16* Bp = B + (size_t)ldr * ldb + ldc;
  {
    uint4 a0 = *(const uint4*)(Ap), a1 = *(const uint4*)(Ap + (size_t)64 * lda), b0 = *(const uint4*)(Bp), b1 = *(const uint4*)(Bp + (size_t)64 * ldb);
    *(uint4*)(As + ldr * 72 + ldc) = a0; *(uint4*)(As + (ldr + 64) * 72 + ldc) = a1;
    *(uint4*)(Bs + ldr * 72 + ldc) = b0; *(uint4*)(Bs + (ldr + 64) * 72 + ldc) = b1;
  }
  __syncthreads();
  f32x4 acc[4][2];
#pragma unroll
  for (int i = 0; i < 4; ++i) { acc[i][0] = (f32x4){0.f, 0.f, 0.f, 0.f}; acc[i][1] = (f32x4){0.f, 0.f, 0.f, 0.f}; }
  const int nk = K >> 6;
  for (int kt = 0; kt < nk; ++kt) {
    const int cur = kt & 1;
    const int kn = (kt + 1 < nk) ? (kt + 1) : kt;
    const bf16* Apk = Ap + kn * 64; const bf16* Bpk = Bp + (size_t)kn * kstepB;
    u32x4 pa0 = gload16(Apk), pa1 = gload16(Apk + (size_t)64 * lda), pb0 = gload16(Bpk), pb1 = gload16(Bpk + (size_t)64 * ldb);
    __builtin_amdgcn_sched_barrier(0);
    const bf16* as = As + cur * 128 * 72 + (wr * 64 + lr) * 72 + lq * 8;
    const bf16* bs = Bs + cur * 128 * 72 + (wc * 32 + lr) * 72 + lq * 8;
#pragma unroll
    for (int ks = 0; ks < 2; ++ks) {
      bf16x8 a[4], b[2];
#pragma unroll
      for (int i = 0; i < 4; ++i) a[i] = *(const bf16x8*)(as + i * 16 * 72 + ks * 32);
#pragma unroll
      for (int i = 0; i < 2; ++i) b[i] = *(const bf16x8*)(bs + i * 16 * 72 + ks * 32);
#pragma unroll
      for (int mi = 0; mi < 4; ++mi)
#pragma unroll
        for (int ni = 0; ni < 2; ++ni) acc[mi][ni] = __builtin_amdgcn_mfma_f32_16x16x32_bf16(a[mi], b[ni], acc[mi][ni], 0, 0, 0);
    }
    __builtin_amdgcn_sched_barrier(0);
    {
      VMWAIT4(pa0, pa1, pb0, pb1);
      bf16* ad = As + (cur ^ 1) * 128 * 72 + ldr * 72 + ldc; bf16* bd = Bs + (cur ^ 1) * 128 * 72 + ldr * 72 + ldc;
      *(u32x4*)(ad) = pa0; *(u32x4*)(ad + 64 * 72) = pa1; *(u32x4*)(bd) = pb0; *(u32x4*)(bd + 64 * 72) = pb1;
    }
    __syncthreads();
  }
  float* Ct = (float*)smem;
#pragma unroll
  for (int mi = 0; mi < 4; ++mi)
#pragma unroll
    for (int ni = 0; ni < 2; ++ni)
#pragma unroll
      for (int j = 0; j < 4; ++j) Ct[(wr * 64 + mi * 16 + lq * 4 + j) * CT_LD + wc * 32 + ni * 16 + lr] = acc[mi][ni][j];
  __syncthreads();
}

#define CT16_LD 264
DEV void ld8h(const bf16* Ct, int r, int c, float* v) {
  const uint4 q = *(const uint4*)(Ct + r * CT16_LD + c);
  v[0] = __uint_as_float(q.x << 16); v[1] = __uint_as_float(q.x & 0xffff0000u); v[2] = __uint_as_float(q.y << 16); v[3] = __uint_as_float(q.y & 0xffff0000u);
  v[4] = __uint_as_float(q.z << 16); v[5] = __uint_as_float(q.z & 0xffff0000u); v[6] = __uint_as_float(q.w << 16); v[7] = __uint_as_float(q.w & 0xffff0000u);
}
DEV float ldh(const bf16* Ct, int r, int c) { return bf2f(Ct[r * CT16_LD + c]); }
DEV void ld8(const float* Ct, int r, int c, float* v) {
  float4 a = *(const float4*)(Ct + r * CT_LD + c), b = *(const float4*)(Ct + r * CT_LD + c + 4);
  v[0] = a.x; v[1] = a.y; v[2] = a.z; v[3] = a.w; v[4] = b.x; v[5] = b.y; v[6] = b.z; v[7] = b.w;
}

template <class F>
DEV void epi_transposed(const bf16* Ct, F dstrow, int tstride) {
  int tid = threadIdx.x; asm volatile("" : "+v"(tid));
#pragma unroll
  for (int i = 0; i < 4; ++i) {
    int idx = tid + 512 * i; int tcl = idx & 3, c = (idx >> 2) & 127, tch = idx >> 9; int tc = tch * 4 + tcl;
    unsigned hv[8];
#pragma unroll
    for (int e = 0; e < 8; ++e) hv[e] = Ct[(tc * 8 + e) * CT16_LD + c];
    uint4 ov; ov.x = hv[0] | (hv[1] << 16); ov.y = hv[2] | (hv[3] << 16); ov.z = hv[4] | (hv[5] << 16); ov.w = hv[6] | (hv[7] << 16);
    *(uint4*)(dstrow(c) + (size_t)(tc >> 3) * tstride + (tc & 7) * 8) = ov;
  }
}

DEV void epi_even(const Params& p, int mt, int nt, const bf16* Ct) {
  int tid = threadIdx.x; asm volatile("" : "+v"(tid));
  const int cg = tid & 15, rg = tid >> 4;
  unsigned char* ws = p.ws;
  const int m0 = mt * 128; const bool lat = m0 >= 8192;
  const int bseq = lat ? ((m0 - 8192) >> 10) : (m0 >> 8);
  const int t0 = lat ? ((m0 - 8192) & 1023) : (m0 & 255);
  int type; int cb;
  if (nt < 4) { type = 0; cb = nt * 128; } else if (nt < 8) { type = 1; cb = (nt - 4) * 128; } else if (nt < 16) { type = 2; cb = (nt - 8) * 128; }
  else if (nt < 24) { type = 3; cb = (nt - 16) * 128; } else if (nt < 28) { type = 4; cb = (nt - 24) * 128; } else if (nt == 28) { type = 5; cb = 0; } else { type = 6; cb = 0; }
  if (type == 2) {
    const int h = nt - 8;
    bf16* base = (bf16*)(ws + B_VRT) + (lat ? (size_t)8192 * 1024 + ((size_t)(bseq * 8 + h) * 16 + (t0 >> 6)) * 8192 : ((size_t)(bseq * 8 + h) * 4 + (t0 >> 6)) * 8192);
    epi_transposed(Ct, [&](int c) { return base + (size_t)c * 64; }, 8192);
  } else if (type == 6) {
    bf16* base = (bf16*)(ws + B_VAT) + (lat ? (size_t)32 * 2 * 64 * 256 : (size_t)0);
    const int ntk = lat ? 16 : 4;
    epi_transposed(Ct, [&](int c) { return base + ((size_t)(bseq * 2 + (c >> 6)) * ntk + (t0 >> 6)) * 4096 + (size_t)(c & 63) * 64; }, 4096);
    if (!lat) {
#pragma unroll
      for (int i = 0; i < 4; ++i) {
        const int r = rg + 32 * i; float v[8]; ld8h(Ct, r, cg * 8, v);
        const int kvh = cg >> 3, d0 = (cg & 7) * 8;
        float* o = p.out + O_GV + ((size_t)(bseq * 2 + kvh) * 256 + t0 + r) * 64 + d0;
        *(float4*)o = make_float4(v[0], v[1], v[2], v[3]); *(float4*)(o + 4) = make_float4(v[4], v[5], v[6], v[7]);
      }
    }
  } else {
    const int j0 = (cg * 8) & 63;
    if (type == 3 || ((type == 0 || type == 1) && !lat)) {
      bf16* dstc; size_t off; int rstride;
      if (type == 3) { dstc = (bf16*)(ws + B_GR); off = (size_t)m0 * 1024 + cb + cg * 8; rstride = 1024; }
      else { dstc = (bf16*)(ws + (type == 0 ? B_QR : B_KR)); off = ((size_t)(bseq * 8 + ((cb + cg * 8) >> 6)) * 256 + t0) * 64 + j0; rstride = 64; }
#pragma unroll
      for (int i = 0; i < 4; ++i) { const int r = rg + 32 * i; *(uint4*)(dstc + off + (size_t)r * rstride) = *(const uint4*)(Ct + r * CT16_LD + cg * 8); }
    } else {
    const float2* rope = (const float2*)(ws + OFF_ROPE);
    const bool dorope = lat && (type == 0 || type == 1 || type == 4 || type == 5);
    float gain[8], pgain[8];
#pragma unroll
    for (int e = 0; e < 8; ++e) { gain[e] = 1.f; pgain[e] = 1.f; }
    if (type == 4 || type == 5) {
      const float* gp = (type == 4) ? p.q_norm : p.k_norm;
#pragma unroll
      for (int e = 0; e < 8; ++e) { gain[e] = gp[j0 + e]; pgain[e] = gp[(j0 ^ 16) + e]; }
    }
    bf16* dst; int nh;
    if (type == 0) { dst = (bf16*)(ws + B_QR); nh = 8; } else if (type == 1) { dst = (bf16*)(ws + B_KR); nh = 8; }
    else if (type == 3) { dst = (bf16*)(ws + B_GR); nh = 0; } else if (type == 4) { dst = (bf16*)(ws + B_QA); nh = 8; } else { dst = (bf16*)(ws + B_KA); nh = 2; }
    const int hh = (cb + cg * 8) >> 6;
    const size_t hbase = lat ? (size_t)8192 * 64 * nh + ((size_t)(bseq * nh + hh) * 1024 + t0) * 64 : ((size_t)(bseq * nh + hh) * 256 + t0) * 64;
#pragma unroll
    for (int i = 0; i < 4; ++i) {
      const int r = rg + 32 * i; const int row = m0 + r;
      float v[8]; ld8h(Ct, r, cg * 8, v);
      float mul = 1.0f;
      if (type == 4 || type == 5) {
        float ss = 0.f;
#pragma unroll
        for (int e = 0; e < 8; ++e) ss += v[e] * v[e];
        ss += __shfl_xor(ss, 1); ss += __shfl_xor(ss, 2); ss += __shfl_xor(ss, 4);
        mul = rsqrtf(ss * (1.0f / 64.0f) + 1e-6f);
      }
#pragma unroll
      for (int e = 0; e < 8; ++e) v[e] *= mul * gain[e];
      if (type == 5 && !lat) {
        const int kvh = cg >> 3;
        float* o = p.out + O_GK + ((size_t)(bseq * 2 + kvh) * 256 + t0 + r) * 64 + j0;
        *(float4*)o = make_float4(v[0], v[1], v[2], v[3]); *(float4*)(o + 4) = make_float4(v[4], v[5], v[6], v[7]);
      }
      if (dorope) {
        float pv[8]; ld8h(Ct, r, (cg * 8) ^ 16, pv);
        const int t = t0 + r; const int pos = (j0 & 32) ? (t & 63) : (t >> 6); const int f0 = j0 & 15;
        const float sgn = (j0 & 16) ? 1.0f : -1.0f;
#pragma unroll
        for (int e = 0; e < 8; ++e) {
          float2 cs = rope[pos * 16 + f0 + e];
          float pe = pv[e] * mul * pgain[e];
          v[e] = v[e] * cs.x + sgn * pe * cs.y;
        }
      }
      if (nh) *(uint4*)(dst + hbase + (size_t)r * 64 + j0) = pack8(v);
      else *(uint4*)(dst + (size_t)row * 1024 + cb + cg * 8) = pack8(v);
    }
    }
    if (type == 1 && !lat) {
      const float* lg2 = (const float*)(ws + OFF_LG2);
      bf16* base = (bf16*)(ws + B_KTFB);
#pragma unroll
      for (int i = 0; i < 4; ++i) {
        int idx = tid + 512 * i; int tcl = idx & 3, c = (idx >> 2) & 127, tch = idx >> 9; int tc = tch * 4 + tcl;
        const int h = (nt - 4) * 2 + (c >> 6), d = c & 63;
        const float lgf = lg2[h], lgb = lg2[8 + h];
        float f[8], g[8];
#pragma unroll
        for (int e = 0; e < 8; ++e) {
          const int tt = t0 + tc * 8 + e; const float val = ldh(Ct, tc * 8 + e, c);
          f[e] = val * fexp2(lgf * (float)(255 - tt)); g[e] = val * fexp2(lgb * (float)tt);
        }
        bf16* o = base + (((size_t)(bseq * 8 + h) * 2) * 64 + d) * 256 + t0 + tc * 8;
        *(uint4*)o = pack8(f); *(uint4*)(o + 64 * 256) = pack8(g);
      }
    }
  }
}

DEV void epi_odd(const Params& p, int mt, int nt, const bf16* Ct) {
  int tid = threadIdx.x; asm volatile("" : "+v"(tid));
  const int cg = tid & 15, rg = tid >> 4;
  unsigned char* ws = p.ws;
  const int m0 = mt * 128; const bool lat = m0 >= 8192;
  const int bseq = lat ? ((m0 - 8192) >> 10) : (m0 >> 8);
  const int t0 = lat ? ((m0 - 8192) & 1023) : (m0 & 255);
  if (nt < 16) {
    bf16* dst = (bf16*)(ws + (nt < 8 ? B_Q : B_K));
    const int hh = (nt & 7) * 2 + (cg >> 3), dd0 = (cg & 7) * 8;
    const size_t hbase = lat ? (size_t)8192 * 1024 + ((size_t)(bseq * 16 + hh) * 1024 + t0) * 64 : ((size_t)(bseq * 16 + hh) * 256 + t0) * 64;
#pragma unroll
    for (int i = 0; i < 4; ++i) {
      const int r = rg + 32 * i;
      *(uint4*)(dst + hbase + (size_t)r * 64 + dd0) = *(const uint4*)(Ct + r * CT16_LD + cg * 8);
      if (nt >= 8 && !lat) {
        float v[8]; ld8h(Ct, r, cg * 8, v);
        const int h = (nt - 8) * 2 + (cg >> 3), d0 = (cg & 7) * 8;
        float* o = p.out + O_NK + ((size_t)(bseq * 16 + h) * 256 + t0 + r) * 64 + d0;
        *(float4*)o = make_float4(v[0], v[1], v[2], v[3]); *(float4*)(o + 4) = make_float4(v[4], v[5], v[6], v[7]);
      }
    }
  } else {
    const int h0 = (nt - 16) * 2;
    bf16* base = (bf16*)(ws + B_VT) + (lat ? (size_t)8192 * 1024 : (size_t)0);
    const int ntk = lat ? 16 : 4;
    epi_transposed(Ct, [&](int c) { return base + ((size_t)(bseq * 16 + h0 + (c >> 6)) * ntk + (t0 >> 6)) * 4096 + (size_t)(c & 63) * 64; }, 4096);
    if (!lat) {
#pragma unroll
      for (int i = 0; i < 4; ++i) {
        const int r = rg + 32 * i; float v[8]; ld8h(Ct, r, cg * 8, v);
        const int h = h0 + (cg >> 3), d0 = (cg & 7) * 8;
        float* o = p.out + O_NV + ((size_t)(bseq * 16 + h) * 256 + t0 + r) * 64 + d0;
        *(float4*)o = make_float4(v[0], v[1], v[2], v[3]); *(float4*)(o + 4) = make_float4(v[4], v[5], v[6], v[7]);
      }
    }
  }
}

DEV void epi_resid(const Params& p, int mt, int nt, const bf16* Ct, int l, int gi_, const float* xc, const float* xs) {
  int tid = threadIdx.x; asm volatile("" : "+v"(tid));
  const int cg = tid & 15, rg = tid >> 4;
  const bool ob = (gi_ & 16) != 0; const int gi = gi_ & 15;
  const int m0 = mt * 128; const int col = nt * 128 + cg * 8;
  const int crow = m0 < 8192 ? 8 : ((m0 - 8192) >> 10);
  const float* gp = (const float*)(p.ws + OFF_MOD) + (size_t)(l * 9 + crow) * 6144 + gi * 1024 + col;
  const float4 g0 = *(const float4*)gp, g1 = *(const float4*)(gp + 4);
  bf16* xb = (bf16*)(p.ws + B_XB);
#pragma unroll
  for (int i = 0; i < 4; ++i) {
    const int r = rg + 32 * i; const int row = m0 + r; float v[8]; ld8h(Ct, r, cg * 8, v);
    float x[8];
    if (xc) {
      const float* xp = (row < 8192 ? xc + (size_t)row * 1024 : xs + (size_t)(row - 8192) * 1024) + col;
      const float4 a = *(const float4*)xp, b = *(const float4*)(xp + 4);
      x[0] = a.x; x[1] = a.y; x[2] = a.z; x[3] = a.w; x[4] = b.x; x[5] = b.y; x[6] = b.z; x[7] = b.w;
    } else {
      const uint4 q = *(const uint4*)(xb + (size_t)row * 1024 + col);
      x[0] = __uint_as_float(q.x << 16); x[1] = __uint_as_float(q.x & 0xffff0000u); x[2] = __uint_as_float(q.y << 16); x[3] = __uint_as_float(q.y & 0xffff0000u);
      x[4] = __uint_as_float(q.z << 16); x[5] = __uint_as_float(q.z & 0xffff0000u); x[6] = __uint_as_float(q.w << 16); x[7] = __uint_as_float(q.w & 0xffff0000u);
    }
    x[0] += g0.x * v[0]; x[1] += g0.y * v[1]; x[2] += g0.z * v[2]; x[3] += g0.w * v[3];
    x[4] += g1.x * v[4]; x[5] += g1.y * v[5]; x[6] += g1.z * v[6]; x[7] += g1.w * v[7];
    if (ob) *(uint4*)(xb + (size_t)row * 1024 + col) = pack8(x);
    else {
      float* o = p.out + (size_t)row * 1024 + col;
      *(float4*)o = make_float4(x[0], x[1], x[2], x[3]);
      *(float4*)(o + 4) = make_float4(x[4], x[5], x[6], x[7]);
    }
  }
}

DEV void epi_ffn_up_unit(const Params& p, int pm, int pn, const bf16* Ct, int l) {
  int tid = threadIdx.x; asm volatile("" : "+v"(tid));
  const int cgp = tid & 15, rgp = tid >> 4;
  const int bj = cgp >> 3, j0 = (cgp & 7) * 8;
  const int ca = bj * 128 + j0;
  const int oc = (2 * pn + bj) * 64 + j0;
  const bool lat = pm >= 32;
  const bool firstu = !lat || ((pm & 3) == 0), lastu = !lat || ((pm & 3) == 3);
  const float* cw = p.conv_w + (size_t)l * 3 * 5632; const float* cbp = p.conv_b + (size_t)l * 5632;
  float wa0[8], wa1[8], wa2[8], wab[8], wg0[8], wg1[8], wg2[8], wgb[8];
#pragma unroll
  for (int e = 0; e < 8; ++e) {
    wa0[e] = cw[oc + e]; wa1[e] = cw[5632 + oc + e]; wa2[e] = cw[2 * 5632 + oc + e]; wab[e] = cbp[oc + e];
    wg0[e] = cw[2816 + oc + e]; wg1[e] = cw[5632 + 2816 + oc + e]; wg2[e] = cw[2 * 5632 + 2816 + oc + e]; wgb[e] = cbp[2816 + oc + e];
  }
  bf16* act = (bf16*)(p.ws + B_ACT);
  const int r0 = rgp * 8;
  float ap[8], ac[8], an[8], gp[8], gc[8], gn[8];
  if (r0 > 0) { ld8h(Ct, r0 - 1, ca, ap); ld8h(Ct, r0 - 1, ca + 64, gp); }
  else {
#pragma unroll
    for (int e = 0; e < 8; ++e) { ap[e] = 0.f; gp[e] = 0.f; }
  }
  ld8h(Ct, r0, ca, ac); ld8h(Ct, r0, ca + 64, gc);
#pragma unroll
  for (int i = 0; i < 8; ++i) {
    const int r = r0 + i;
    if (r < 255) { ld8h(Ct, r + 1, ca, an); ld8h(Ct, r + 1, ca + 64, gn); }
    else {
#pragma unroll
      for (int e = 0; e < 8; ++e) { an[e] = 0.f; gn[e] = 0.f; }
    }
    const bool skip = (r == 0 && !firstu) || (r == 255 && !lastu);
    if (!skip) {
      float res[8];
#pragma unroll
      for (int e = 0; e < 8; ++e) {
        const float a = wab[e] + wa0[e] * ap[e] + wa1[e] * ac[e] + wa2[e] * an[e];
        const float g = wgb[e] + wg0[e] * gp[e] + wg1[e] * gc[e] + wg2[e] * gn[e];
        res[e] = silu_f(a) * g;
      }
      *(uint4*)(act + (size_t)(pm * 256 + r) * 2816 + oc) = pack8(res);
    }
#pragma unroll
    for (int e = 0; e < 8; ++e) { ap[e] = ac[e]; ac[e] = an[e]; gp[e] = gc[e]; gc[e] = gn[e]; }
  }
  if (lat) {
    float* halo = (float*)(p.ws + B_HALO);
    for (int idx = tid; idx < 1024; idx += 512) {
      const int hr = idx >> 8, c = idx & 255; const int r = (hr < 2) ? hr : 252 + hr;
      halo[((size_t)(pm * 4 + hr)) * 5632 + pn * 256 + c] = ldh(Ct, r, c);
    }
  }
}

DEV void ffn_seam_rows(const Params& p, int l, int pm) {
  if (pm < 32) return;
  int tid = threadIdx.x; asm volatile("" : "+v"(tid));
  const float* cw = p.conv_w + (size_t)l * 3 * 5632; const float* cbp = p.conv_b + (size_t)l * 5632;
  const float* halo = (const float*)(p.ws + B_HALO);
  bf16* act = (bf16*)(p.ws + B_ACT);
#pragma unroll 1
  for (int which = 0; which < 2; ++which) {
    if (which == 0 ? ((pm & 3) == 0) : ((pm & 3) == 3)) continue;
    const float *up, *uc, *un; int row;
    if (which == 0) { up = halo + (size_t)((pm - 1) * 4 + 3) * 5632; uc = halo + (size_t)(pm * 4 + 0) * 5632; un = halo + (size_t)(pm * 4 + 1) * 5632; row = pm * 256; }
    else { up = halo + (size_t)(pm * 4 + 2) * 5632; uc = halo + (size_t)(pm * 4 + 3) * 5632; un = halo + (size_t)((pm + 1) * 4 + 0) * 5632; row = pm * 256 + 255; }
    for (int j = tid; j < 2816; j += 512) {
      const int ca = (j >> 6) * 128 + (j & 63), cgi = ca + 64;
      const float a = cbp[j] + cw[j] * up[ca] + cw[5632 + j] * uc[ca] + cw[2 * 5632 + j] * un[ca];
      const float g = cbp[2816 + j] + cw[2816 + j] * up[cgi] + cw[5632 + 2816 + j] * uc[cgi] + cw[2 * 5632 + 2816 + j] * un[cgi];
      act[(size_t)row * 2816 + j] = f2bf(silu_f(a) * g);
    }
  }
  asm volatile("s_waitcnt vmcnt(0)" ::: "memory");
  __syncthreads();
}

DEV void epi_state(const Params& p, int b, int h, const float* Ct) {
  int tid = threadIdx.x; asm volatile("" : "+v"(tid)); const int cg = tid & 15, rg = tid >> 4;
#pragma unroll 1
  for (int i = 0; i < 4; ++i) {
    const int r = rg + 32 * i; float v[8]; ld8(Ct, r, cg * 8, v);
    float* o = p.out + (r < 64 ? O_SF : O_SB) + ((size_t)(b * 8 + h) * 64 + (r & 63)) * 128 + cg * 8;
    *(float4*)o = make_float4(v[0], v[1], v[2], v[3]); *(float4*)(o + 4) = make_float4(v[4], v[5], v[6], v[7]);
  }
  __syncthreads();
}

namespace pg8 {
#define PG8_LAS __attribute__((address_space(3)))
typedef unsigned short bf16_t;
typedef short bf16x8 __attribute__((ext_vector_type(8)));
typedef float f32x4 __attribute__((ext_vector_type(4)));
typedef unsigned u32x4 __attribute__((ext_vector_type(4)));
constexpr int BM = 256, BK = 64, HALF = 128, HTB = HALF * BK * 2  , STAGE_BYTES = 8 * HTB, NXCD = 8, WGM = 8;

__host__ __device__ __forceinline__ int lds_byte(int r, int c) { const int st = (r >> 4) * 2 + (c >> 5), rr = r & 15, cc = c & 31, ob = rr * 64 + cc * 2; return st * 1024 + (ob ^ (((ob >> 9) & 1) << 5)); }
__host__ __device__ __forceinline__ void stage_rc(int b, int& R, int& C) { const int st = b / 1024, sb = b % 1024, swz = sb ^ (((sb >> 9) & 1) << 5); R = (st >> 1) * 16 + swz / 64; C = (st & 1) * 32 + (swz % 64) / 2; }
__host__ __device__ __forceinline__ int perm32(int rho) { const int n = rho >> 4, i = rho & 15; return 8 * (i >> 2) + 4 * n + (i & 3); }

struct Unit { int pm, pn; };
struct Gemm { const bf16_t* A; const bf16_t* Bt; int M, N, K; };

struct StaticOrder {
    int nM, nN, nwg, G, c;
    __host__ __device__ void init(int M, int N, int G_, int c_) { nM = M / BM; nN = N / BM; nwg = nM * nN; G = G_; c = c_; }
    __host__ __device__ bool next(int i, Unit& u) const {
        const long L = (long)i * G + c; if (L >= nwg) return false;
        int wgid = (int)L; { const int q = nwg / NXCD, r = nwg % NXCD, xcd = wgid % NXCD, off = wgid / NXCD; wgid = (xcd < r ? xcd * (q + 1) : r * (q + 1) + (xcd - r) * q) + off; }
        const int nig = WGM * nN, gid = wgid / nig, fm = gid * WGM, gsz = (nM - fm) < WGM ? (nM - fm) : WGM;
        u.pm = fm + ((wgid % nig) % gsz); u.pn = (wgid % nig) / gsz; return true;
    }
    __device__ __forceinline__ void a_ready(const Unit&) const {}
    __device__ __forceinline__ void done(const Unit&) const {}
};
template <class Epi, class Sched, bool STAMP = false>
__device__ __forceinline__ void gemm_phase(PG8_LAS unsigned char* lds, const Gemm g, const Sched& S, const Epi& E, unsigned long long* stamps) {
    int tid = threadIdx.x; asm volatile("" : "+v"(tid)); const int wid = __builtin_amdgcn_readfirstlane(tid >> 6), lane = tid & 63, wr = wid >> 2, wc = wid & 3, fr = lane & 15, fq = lane >> 4;
    const int K = g.K, nt = K / BK;
    int ts_lo = 0, ts_hi = 0, nts = 0; const unsigned long long rt_entry = STAMP ? (unsigned long long)wall_clock64() : 0ull;
#define PG8_STAMP() do { if (STAMP && wid == 0 && nts < 64) { const unsigned long long _c = (unsigned long long)clock64(); \
        ts_lo = (lane == nts) ? (int)(unsigned)_c : ts_lo; ts_hi = (lane == nts) ? (int)(unsigned)(_c >> 32) : ts_hi; ++nts; } } while (0)
    PG8_STAMP();
    unsigned voffA[2], voffB[2];
#pragma unroll
    for (int i = 0; i < 2; ++i) { int R, C; stage_rc(tid * 16 + i * 8192, R, C); const int Rb = Epi::PERM ? ((R & ~31) + perm32(R & 31)) : R;
        voffA[i] = (unsigned)(R * K + C) * 2u; voffB[i] = (unsigned)(Rb * K + C) * 2u; }
    const size_t kstep = (size_t)(BK * 2);
    const size_t hstep = (size_t)HALF * K * 2;
    const size_t tstep = 2 * hstep;
    const unsigned ldsw = (unsigned)wid * 1024u;
    const int aoff = lds_byte(wr * 64 + fr, fq * 8), boff = lds_byte(wc * 32 + fr, fq * 8);
#define PG8_SA(b, h) (((b) * 2 + (h)) * HTB)
#define PG8_SB(b, h) ((4 + (b) * 2 + (h)) * HTB)
#define PG8_STAGE(bufoff, gbase, voff) do { _Pragma("unroll") for (int _i = 0; _i < 2; ++_i) \
        __builtin_amdgcn_global_load_lds((const unsigned*)((const char*)(gbase) + (voff)[_i]), (PG8_LAS unsigned*)(lds + (bufoff) + ldsw + _i * 8192), 16, 0, 0); } while (0)
#define PG8_LDA(dst, b, h) do { _Pragma("unroll") for (int m = 0; m < 4; ++m) _Pragma("unroll") for (int k = 0; k < 2; ++k) dst[m][k] = *(const PG8_LAS bf16x8*)(lds + PG8_SA(b, h) + aoff + m * 2048 + k * 1024); } while (0)
#define PG8_LDB(dst, b, h) do { _Pragma("unroll") for (int n = 0; n < 2; ++n) _Pragma("unroll") for (int k = 0; k < 2; ++k) dst[n][k] = *(const PG8_LAS bf16x8*)(lds + PG8_SB(b, h) + boff + n * 2048 + k * 1024); } while (0)
#define PG8_MMA(ai, bj, At, Bt) do { __builtin_amdgcn_s_setprio(1); _Pragma("unroll") for (int m = 0; m < 4; ++m) _Pragma("unroll") for (int n = 0; n < 2; ++n) _Pragma("unroll") for (int k = 0; k < 2; ++k) \
        acc[ai][bj][m][n] = __builtin_amdgcn_mfma_f32_16x16x32_bf16(Bt[n][k], At[m][k], acc[ai][bj][m][n], 0, 0, 0); __builtin_amdgcn_s_setprio(0); } while (0)
#define PG8_WAIT_V(n) asm volatile("s_waitcnt vmcnt(" #n ")" ::: "memory")
#define PG8_WAIT_L(n) asm volatile("s_waitcnt lgkmcnt(" #n ")" ::: "memory")
#define PG8_BAR __builtin_amdgcn_s_barrier()
#define PG8_SCHED __builtin_amdgcn_sched_barrier(0)
    Unit cur, nxt; int ui = 0;
    if (!S.next(0, cur)) return;
    f32x4 acc[2][2][4][2];
#pragma unroll
    for (int a = 0; a < 2; ++a)
#pragma unroll
        for (int b = 0; b < 2; ++b)
#pragma unroll
            for (int m = 0; m < 4; ++m)
#pragma unroll
                for (int n = 0; n < 2; ++n) acc[a][b][m][n] = (f32x4){0.f, 0.f, 0.f, 0.f};
    bf16x8 At[4][2], B0[2][2], B1[2][2];
    const char* cA = (const char*)g.A + (size_t)cur.pm * tstep; const char* cB = (const char*)g.Bt + (size_t)cur.pn * tstep;
    S.a_ready(cur);
    PG8_STAGE(PG8_SB(0, 0), cB, voffB); PG8_STAGE(PG8_SA(0, 0), cA, voffA); PG8_STAGE(PG8_SB(0, 1), cB + hstep, voffB); PG8_STAGE(PG8_SA(0, 1), cA + hstep, voffA);
    if (wr == 1) PG8_BAR;
    PG8_WAIT_V(4); PG8_BAR;
    PG8_STAGE(PG8_SB(1, 0), cB + kstep, voffB); PG8_STAGE(PG8_SA(1, 0), cA + kstep, voffA); PG8_STAGE(PG8_SB(1, 1), cB + hstep + kstep, voffB);
    PG8_WAIT_V(6); PG8_BAR;
    PG8_STAMP();
    for (;;) {
        const bool has_next = S.next(ui + 1, nxt);
        const char* nA = has_next ? (const char*)g.A + (size_t)nxt.pm * tstep : cA; const char* nB = has_next ? (const char*)g.Bt + (size_t)nxt.pn * tstep : cB;
        for (int t = 0; t < nt; t += 2) {
            const bool last = (t == nt - 2);
            const char* a1 = cA + (size_t)(t + 1) * kstep;
            const char* a2 = last ? nA : cA + (size_t)(t + 2) * kstep; const char* b2 = last ? nB : cB + (size_t)(t + 2) * kstep;
            const char* a3 = a2 + kstep; const char* b3 = b2 + kstep;
            if (last && has_next) S.a_ready(nxt);
            PG8_LDB(B0, 0, 0); PG8_SCHED; PG8_LDA(At, 0, 0); PG8_STAGE(PG8_SA(1, 1), a1 + hstep, voffA);
            PG8_WAIT_L(8); PG8_BAR; PG8_WAIT_L(0); PG8_MMA(0, 0, At, B0); PG8_BAR; PG8_SCHED;
            PG8_LDB(B1, 0, 1); PG8_STAGE(PG8_SB(0, 0), b2, voffB);
            PG8_BAR; PG8_WAIT_L(0); PG8_MMA(0, 1, At, B1); PG8_BAR;
            PG8_LDA(At, 0, 1); PG8_STAGE(PG8_SA(0, 0), a2, voffA);
            PG8_BAR; PG8_WAIT_L(0); PG8_MMA(1, 0, At, B0); PG8_BAR; PG8_SCHED;
            PG8_STAGE(PG8_SB(0, 1), b2 + hstep, voffB);
            PG8_WAIT_V(6); PG8_BAR; PG8_MMA(1, 1, At, B1); PG8_BAR;
            PG8_LDB(B0, 1, 0); PG8_SCHED; PG8_LDA(At, 1, 0); PG8_STAGE(PG8_SA(0, 1), a2 + hstep, voffA);
            PG8_WAIT_L(8); PG8_BAR; PG8_WAIT_L(0); PG8_MMA(0, 0, At, B0); PG8_BAR; PG8_SCHED;
            PG8_LDB(B1, 1, 1); PG8_STAGE(PG8_SB(1, 0), b3, voffB);
            PG8_BAR; PG8_WAIT_L(0); PG8_MMA(0, 1, At, B1); PG8_BAR;
            PG8_LDA(At, 1, 1); PG8_STAGE(PG8_SA(1, 0), a3, voffA);
            PG8_BAR; PG8_WAIT_L(0); PG8_MMA(1, 0, At, B0); PG8_BAR; PG8_SCHED;
            PG8_STAGE(PG8_SB(1, 1), b3 + hstep, voffB);
            PG8_WAIT_V(6); PG8_BAR; PG8_MMA(1, 1, At, B1); PG8_BAR;
        }
        PG8_STAMP();
        if constexpr (!Epi::AFTER_DRAIN) { E(acc, cur, wr, wc, fr, fq); S.done(cur); }
        PG8_STAMP();
        if (!has_next) break;
#pragma unroll
        for (int a = 0; a < 2; ++a)
#pragma unroll
            for (int b = 0; b < 2; ++b)
#pragma unroll
                for (int m = 0; m < 4; ++m)
#pragma unroll
                    for (int n = 0; n < 2; ++n) acc[a][b][m][n] = (f32x4){0.f, 0.f, 0.f, 0.f};
        cur = nxt; cA = nA; cB = nB; ++ui;
    }
    PG8_WAIT_V(0);
    if (wr == 0) PG8_BAR;
    PG8_BAR;
    if constexpr (Epi::AFTER_DRAIN) { E.fused(acc, cur, wr, wc, fr, fq, lds, wid, lane); S.done(cur); }
    PG8_STAMP();
    if (STAMP && wid == 0) { stamps[lane] = lane < nts ? (((unsigned long long)(unsigned)ts_hi << 32) | (unsigned)ts_lo) : 0ull;
        if (lane == 62) stamps[62] = rt_entry; if (lane == 63) stamps[63] = (unsigned long long)wall_clock64(); }
#undef PG8_STAMP
#undef PG8_SA
#undef PG8_SB
#undef PG8_STAGE
#undef PG8_LDA
#undef PG8_LDB
#undef PG8_MMA
#undef PG8_WAIT_V
#undef PG8_WAIT_L
#undef PG8_BAR
#undef PG8_SCHED
}
}

struct OneUnit {
  pg8::Unit u;
  DEV bool next(int i, pg8::Unit& o) const { if (i != 0) return false; o = u; return true; }
  DEV void a_ready(const pg8::Unit&) const {}
  DEV void done(const pg8::Unit&) const {}
};
template <int EPI>
struct EpiStage {
  static constexpr bool PERM = false, AFTER_DRAIN = true;
  const Params* p; unsigned char* smem; int l, gi; const float* xc; const float* xs;
  const bf16* A; const bf16* B; int K, npm, npn;
  DEV void fused(pg8::f32x4 (&acc)[2][2][4][2], const pg8::Unit& u, int wr, int wc, int fr, int fq, PG8_LAS unsigned char* lds, int wid, int lane) const {
    unsigned pf0 = 0u, pf1 = 0u;
    if (npm >= 0) {
      const int t_ = threadIdx.x;
      const bf16* pa = A + ((size_t)(npm * 256 + (t_ >> 1)) * K + (t_ & 1) * 64);
      const bf16* pb = B + ((size_t)(npn * 256 + (t_ >> 1)) * K + (t_ & 1) * 64);
      asm volatile("global_load_dword %0, %1, off" : "=v"(pf0) : "v"(pa) : "memory");
      asm volatile("global_load_dword %0, %1, off" : "=v"(pf1) : "v"(pb) : "memory");
    }
    bf16* Ct = (bf16*)smem;
    int ctoff = (wr * 64 + fr) * CT16_LD + wc * 32 + fq * 4; asm volatile("" : "+v"(ctoff));
#pragma unroll
    for (int ai = 0; ai < 2; ++ai)
#pragma unroll
      for (int bj = 0; bj < 2; ++bj)
#pragma unroll
        for (int m = 0; m < 4; ++m)
#pragma unroll
          for (int n = 0; n < 2; ++n) {
            uint2 pk; pk.x = pack2(acc[ai][bj][m][n][0], acc[ai][bj][m][n][1]); pk.y = pack2(acc[ai][bj][m][n][2], acc[ai][bj][m][n][3]);
            *(uint2*)(Ct + ctoff + (ai * 128 + m * 16) * CT16_LD + bj * 128 + n * 16) = pk;
          }
    __syncthreads();
    if (EPI == 3) epi_ffn_up_unit(*p, u.pm, u.pn, Ct, l);
    else
#pragma unroll 1
    for (int q = 0; q < 4; ++q) {
      const int ai = q >> 1, bj = q & 1;
      const int mt = 2 * u.pm + ai, nt = 2 * u.pn + bj;
      const bf16* Cq = Ct + ai * 128 * CT16_LD + bj * 128;
      if (EPI == 0) epi_even(*p, mt, nt, Cq);
      else if (EPI == 1) epi_odd(*p, mt, nt, Cq);
      else epi_resid(*p, mt, nt, Cq, l, gi, xc, xs);
    }
    asm volatile("s_waitcnt vmcnt(0)" : "+v"(pf0), "+v"(pf1) : : "memory");
    __syncthreads();
  }
};

template <int EPI>
DEV void gemm_phase(const Params& p, const bf16* A, const bf16* B, int K, int N, int l, int gi, const float* xc, const float* xs, unsigned char* smem) {
  pg8::StaticOrder so; so.init(16384, N, (int)gridDim.x, (int)blockIdx.x);
  pg8::Gemm g; g.A = A; g.Bt = B; g.M = 16384; g.N = N; g.K = K;
  EpiStage<EPI> E; E.p = &p; E.smem = smem; E.l = l; E.gi = gi; E.xc = xc; E.xs = xs; E.A = A; E.B = B; E.K = K;
  for (int it = 0;; ++it) {
    OneUnit S;
    if (!so.next(it, S.u)) break;
    if (EPI == 2 && K == 2816) ffn_seam_rows(p, l, S.u.pm);
    { pg8::Unit nu; if (so.next(it + 1, nu)) { E.npm = nu.pm; E.npn = nu.pn; } else { E.npm = -1; E.npn = -1; } }
    pg8::gemm_phase<EpiStage<EPI>, OneUnit, false>((PG8_LAS unsigned char*)smem, g, S, E, nullptr);
  }
  if (EPI == 0) p0_weight_tail(p, 0, 64 * (N / 256), smem);
  if (EPI == 3 && l == 0) p0_weight_tail(p, 1, 64 * (N / 256), smem);
}

struct AttnArgs {
  const bf16* q; int ldq;
  const bf16* k0; const bf16* vt0; int ldk0, ldvt0, n0;
  const bf16* k1; const bf16* vt1; int ldk1, ldvt1, n1;
  const bf16* vt2; int ldvt2, n2;
  float scale;
  int qpos0, seqN; float lgf, lgb;
  int r0, lo;
  bf16* out; int ldo;
  const bf16* gr; const float* gn; int tok0; int h;
};


#define KLD 80
#define VLD 76
struct AttRegs { u32x4 k0, v0, v1; int ident; };
template <int NV>
DEV void att_load(const AttnArgs& a, int ti, int tid8, AttRegs& R) {
  const bf16* kp; const bf16* vp;
  if (ti < a.n0) { kp = a.k0 + (size_t)ti * 4096; vp = a.vt0 + (size_t)ti * (NV * 4096); }
  else if (ti < a.n0 + a.n1) { const int j = ti - a.n0; kp = a.k1 ? a.k1 + (size_t)j * 4096 : (const bf16*)0; vp = a.vt1 + (size_t)j * (NV * 4096); }
  else { const int j = ti - a.n0 - a.n1; kp = (const bf16*)0; vp = a.vt2 + (size_t)j * (NV * 4096); }
  R.ident = (kp == (const bf16*)0) ? 1 : 0;
  const bf16* ksrc = kp ? kp + tid8 : vp + tid8;
  R.k0 = gload16(ksrc);
  R.v0 = gload16(vp + tid8);
  if (NV > 1) R.v1 = gload16(vp + tid8 + 4096);
}
template <int DV, int NV, int WAITN>
DEV void att_store(bf16* Ks, bf16* Vs, int buf, int krow, int kch, AttRegs& R) {
  if (NV > 1) asm volatile("s_waitcnt vmcnt(%3)" : "+v"(R.k0), "+v"(R.v0), "+v"(R.v1) : "n"(WAITN) : "memory");
  else asm volatile("s_waitcnt vmcnt(%2)" : "+v"(R.k0), "+v"(R.v0) : "n"(WAITN) : "memory");
  u32x4 kv = R.k0;
  if (R.ident) {
    const int d = krow - kch * 8; const unsigned one = (d & 1) ? 0x3F800000u : 0x00003F80u; const bool in = (d >= 0 && d < 8);
    kv.x = (in && (d >> 1) == 0) ? one : 0u; kv.y = (in && (d >> 1) == 1) ? one : 0u; kv.z = (in && (d >> 1) == 2) ? one : 0u; kv.w = (in && (d >> 1) == 3) ? one : 0u;
  }
  *(u32x4*)(Ks + buf * 64 * KLD + krow * KLD + kch * 8) = kv;
  bf16* vd = Vs + buf * DV * VLD + krow * VLD + kch * 8;
  { uint2 lo, hi; lo.x = R.v0.x; lo.y = R.v0.y; hi.x = R.v0.z; hi.y = R.v0.w; *(uint2*)(vd) = lo; *(uint2*)(vd + 4) = hi; }
  if (NV > 1) { uint2 lo, hi; lo.x = R.v1.x; lo.y = R.v1.y; hi.x = R.v1.z; hi.y = R.v1.w; *(uint2*)(vd + 64 * VLD) = lo; *(uint2*)(vd + 64 * VLD + 4) = hi; }
}

template <int V> struct IntTag { static constexpr int value = V; };
DEV void store_pair16(bf16* rowp  , int lq, uint2 ve, uint2 vo) {
  const bool odd = (lq & 1) != 0;
  uint2 snd = odd ? ve : vo, rcv;
  rcv.x = (unsigned)__shfl_xor((int)snd.x, 16); rcv.y = (unsigned)__shfl_xor((int)snd.y, 16);
  uint4 q;
  if (!odd) { q.x = ve.x; q.y = ve.y; q.z = rcv.x; q.w = rcv.y; }
  else { q.x = rcv.x; q.y = rcv.y; q.z = vo.x; q.w = vo.y; }
  *(uint4*)(rowp + (odd ? 16 : 0) + (lq & ~1) * 4) = q;
}
template <int DV, int MODE>
DEV void attn_item(const AttnArgs& a, unsigned char* smem, const float* rpbs) {
  constexpr int NB = DV / 16, NV = DV / 64;
  int tid = threadIdx.x; asm volatile("" : "+v"(tid)); const int lane = tid & 63, w = __builtin_amdgcn_readfirstlane(tid >> 6), lr = lane & 15, lq = lane >> 4;
  bf16* Ks = (bf16*)smem;
  bf16* Vs = Ks + 2 * 64 * KLD;
  const int ntiles = a.n0 + a.n1 + a.n2;
  bf16x8 qf[2][2];
#pragma unroll
  for (int rb = 0; rb < 2; ++rb)
#pragma unroll
    for (int ds = 0; ds < 2; ++ds) qf[rb][ds] = *(const bf16x8*)(a.q + (size_t)(w * 32 + rb * 16 + lr) * a.ldq + ds * 32 + lq * 8);
  f32x4 o[NB][2];
#pragma unroll
  for (int nb = 0; nb < NB; ++nb) { o[nb][0] = (f32x4){0.f, 0.f, 0.f, 0.f}; o[nb][1] = (f32x4){0.f, 0.f, 0.f, 0.f}; }
  float mrow[2] = {-1e30f, -1e30f}, lrow[2] = {0.f, 0.f};
  float cff[4][4], cfb[4][4];
  if (MODE == 2) {
#pragma unroll
    for (int kb = 0; kb < 4; ++kb)
#pragma unroll
      for (int j = 0; j < 4; ++j) { const float mm = (float)(kb * 16 + lq * 4 + j); cff[kb][j] = fexp2(-a.lgf * mm); cfb[kb][j] = fexp2(a.lgb * mm); }
  }
  AttRegs R0, R1;
  R0.v1 = (u32x4){0u, 0u, 0u, 0u}; R1.v1 = R0.v1;
  const int krow = tid >> 3, kch = tid & 7;
  constexpr int NL = 1 + NV;

  att_load<NV>(a, 0, tid * 8, R0);
  att_store<DV, NV, 0>(Ks, Vs, 0, krow, kch, R0);
  att_load<NV>(a, (1 < ntiles) ? 1 : 0, tid * 8, R0);
  __syncthreads();
  auto step = [&](const int ti, const int cur, AttRegs& Rl, AttRegs& Rs) {
    att_load<NV>(a, (ti + 2 < ntiles) ? (ti + 2) : (ntiles - 1), tid * 8, Rl);
    __builtin_amdgcn_sched_barrier(0);
    bool active = true;
    const int myrow = a.r0 + (w >> 1);
    int rs_ = myrow - 4; rs_ = rs_ < 0 ? 0 : (rs_ > 8 ? 8 : rs_);
    const int kr = a.lo + ti;
    if (MODE == 1 && ti < a.n0) active = (kr >= rs_ && kr < rs_ + 8);
    if (active) {
      const bf16* ks = Ks + cur * 64 * KLD + lr * KLD + lq * 8;
      f32x4 s[4][2];
      {
        bf16x8 kf[2][4];
#pragma unroll
        for (int ds = 0; ds < 2; ++ds)
#pragma unroll
          for (int kb = 0; kb < 4; ++kb) kf[ds][kb] = *(const bf16x8*)(ks + kb * 16 * KLD + ds * 32);
        __builtin_amdgcn_sched_barrier(0);
        __builtin_amdgcn_s_setprio(1);
#pragma unroll
        for (int kb = 0; kb < 4; ++kb) {
          s[kb][0] = __builtin_amdgcn_mfma_f32_16x16x32_bf16(kf[0][kb], qf[0][0], (f32x4){0.f, 0.f, 0.f, 0.f}, 0, 0, 0);
          s[kb][1] = __builtin_amdgcn_mfma_f32_16x16x32_bf16(kf[0][kb], qf[1][0], (f32x4){0.f, 0.f, 0.f, 0.f}, 0, 0, 0);
        }
#pragma unroll
        for (int kb = 0; kb < 4; ++kb) {
          s[kb][0] = __builtin_amdgcn_mfma_f32_16x16x32_bf16(kf[1][kb], qf[0][1], s[kb][0], 0, 0, 0);
          s[kb][1] = __builtin_amdgcn_mfma_f32_16x16x32_bf16(kf[1][kb], qf[1][1], s[kb][1], 0, 0, 0);
        }
        __builtin_amdgcn_s_setprio(0);
      }
      if (MODE == 2) {
        const int nq0 = a.qpos0 + w * 32, t0 = ti * 64;
        if (ti >= a.n0) {
#pragma unroll
          for (int rb = 0; rb < 2; ++rb) {
            const int n = nq0 + rb * 16 + lr;
            const float fac = (ti < a.n0 + a.n1) ? fexp2(a.lgf * (float)(n + 1)) : fexp2(a.lgb * (float)(a.seqN - n));
#pragma unroll
            for (int kb = 0; kb < 4; ++kb)
#pragma unroll
              for (int j = 0; j < 4; ++j) s[kb][rb][j] *= fac;
          }
        } else if (t0 + 63 < nq0) {
#pragma unroll
          for (int rb = 0; rb < 2; ++rb) {
            const float rf = fexp2(a.lgf * (float)(nq0 + rb * 16 + lr - t0));
#pragma unroll
            for (int kb = 0; kb < 4; ++kb)
#pragma unroll
              for (int j = 0; j < 4; ++j) s[kb][rb][j] *= rf * cff[kb][j];
          }
        } else if (t0 > nq0 + 31) {
#pragma unroll
          for (int rb = 0; rb < 2; ++rb) {
            const float rf = fexp2(a.lgb * (float)(t0 - (nq0 + rb * 16 + lr)));
#pragma unroll
            for (int kb = 0; kb < 4; ++kb)
#pragma unroll
              for (int j = 0; j < 4; ++j) s[kb][rb][j] *= rf * cfb[kb][j];
          }
        } else {
#pragma unroll
          for (int rb = 0; rb < 2; ++rb) {
            const int n = nq0 + rb * 16 + lr;
#pragma unroll
            for (int kb = 0; kb < 4; ++kb)
#pragma unroll
              for (int j = 0; j < 4; ++j) {
                const int m = t0 + kb * 16 + lq * 4 + j; const int d = n - m;
                const float fac = d > 0 ? fexp2(a.lgf * (float)d) : (d < 0 ? fexp2(a.lgb * (float)(-d)) : 2.0f);
                s[kb][rb][j] *= fac;
              }
          }
        }
      } else {
        auto softmax_tile = [&](auto wv_tag) {
          constexpr int WV = decltype(wv_tag)::value;
#define KB_USED(kb_, rb_) (WV == 0 || (WV == 1 ? ((kb_) <= 1 + (rb_)) : ((kb_) >= 1 + (rb_))))
          if (WV != 0) {
#pragma unroll
            for (int rb = 0; rb < 2; ++rb) {
              const int c = (w & 1) * 32 + rb * 16 + lr;
              int cs = c - 8; cs = cs < 0 ? 0 : (cs > 48 ? 48 : cs);
              const float* bp = rpbs + (kr - myrow + 7) * 31 + (15 - c);
#pragma unroll
              for (int kb = 0; kb < 4; ++kb) {
                if (!KB_USED(kb, rb)) continue;
#pragma unroll
                for (int j = 0; j < 4; ++j) {
                  const int kc = kb * 16 + lq * 4 + j;
                  const bool valid = (kc >= cs) && (kc < cs + 16);
                  const float bias = valid ? bp[kc] : 0.f;
                  s[kb][rb][j] = valid ? (s[kb][rb][j] * a.scale + bias) : -1e30f;
                }
              }
            }
          }
          const float sc = (WV != 0) ? 1.0f : a.scale;
          float mxl[2];
#pragma unroll
          for (int rb = 0; rb < 2; ++rb) {
            float mx = -1e30f;
#pragma unroll
            for (int kb = 0; kb < 4; ++kb) {
              if (!KB_USED(kb, rb)) continue;
#pragma unroll
              for (int j = 0; j < 4; ++j) mx = fmaxf(mx, s[kb][rb][j]);
            }
            mxl[rb] = mx * sc;
          }
          const bool need = (mxl[0] > mrow[0] + 16.0f) || (mxl[1] > mrow[1] + 16.0f);
          if (__builtin_amdgcn_ballot_w64(need) != 0ull) {
#pragma unroll
            for (int rb = 0; rb < 2; ++rb) {
              float mx = mxl[rb];
              mx = fmaxf(mx, __shfl_xor(mx, 16)); mx = fmaxf(mx, __shfl_xor(mx, 32));
              const float mn = fmaxf(mrow[rb], mx); const float alpha = fexp2(mrow[rb] - mn); mrow[rb] = mn;
              lrow[rb] *= alpha;
#pragma unroll
              for (int nb = 0; nb < NB; ++nb) o[nb][rb] *= alpha;
            }
          }
#pragma unroll
          for (int rb = 0; rb < 2; ++rb) {
            const float mn = mrow[rb];
            float rs = 0.f;
#pragma unroll
            for (int kb = 0; kb < 4; ++kb) {
              if (!KB_USED(kb, rb)) { s[kb][rb] = (f32x4){0.f, 0.f, 0.f, 0.f}; continue; }
#pragma unroll
              for (int j = 0; j < 4; ++j) { const float pv = fexp2(fmaf(s[kb][rb][j], sc, -mn)); s[kb][rb][j] = pv; rs += pv; }
            }
            lrow[rb] += rs;
          }
#undef KB_USED
        };
        if (MODE == 1 && ti < a.n0) { if (w & 1) softmax_tile(IntTag<2>{}); else softmax_tile(IntTag<1>{}); }
        else softmax_tile(IntTag<0>{});
      }
      const bf16* vs = Vs + cur * DV * VLD + lr * VLD + lq * 4;
      bf16x8 pf[2][2];
#pragma unroll
      for (int pp = 0; pp < 2; ++pp)
#pragma unroll
        for (int rb = 0; rb < 2; ++rb) {
          u32x4 t; t.x = pack2(s[2 * pp][rb][0], s[2 * pp][rb][1]); t.y = pack2(s[2 * pp][rb][2], s[2 * pp][rb][3]);
          t.z = pack2(s[2 * pp + 1][rb][0], s[2 * pp + 1][rb][1]); t.w = pack2(s[2 * pp + 1][rb][2], s[2 * pp + 1][rb][3]);
          pf[pp][rb] = __builtin_bit_cast(bf16x8, t);
        }
      constexpr int NG = NB / 4, TOT = 2 * NG;
      bf16x8 vbuf[2][4];
#define ATT_LDV(gi_, dst_) do { const int pp_ = (gi_) / NG, nb0_ = ((gi_) % NG) * 4; \
        _Pragma("unroll") for (int q_ = 0; q_ < 4; ++q_) { \
          const uint2 vlo_ = *(const uint2*)(vs + (nb0_ + q_) * 16 * VLD + (2 * pp_) * 16); \
          const uint2 vhi_ = *(const uint2*)(vs + (nb0_ + q_) * 16 * VLD + (2 * pp_ + 1) * 16); \
          u32x4 t_; t_.x = vlo_.x; t_.y = vlo_.y; t_.z = vhi_.x; t_.w = vhi_.y; dst_[q_] = __builtin_bit_cast(bf16x8, t_); } } while (0)
      ATT_LDV(0, vbuf[0]);
#pragma unroll
      for (int gi = 0; gi < TOT; ++gi) {
        if (gi + 1 < TOT) ATT_LDV(gi + 1, vbuf[(gi + 1) & 1]);
        __builtin_amdgcn_sched_barrier(0);
        const int pp = gi / NG, nb0 = (gi % NG) * 4;
        __builtin_amdgcn_s_setprio(1);
#pragma unroll
        for (int q = 0; q < 4; ++q) {
          o[nb0 + q][0] = __builtin_amdgcn_mfma_f32_16x16x32_bf16(vbuf[gi & 1][q], pf[pp][0], o[nb0 + q][0], 0, 0, 0);
          o[nb0 + q][1] = __builtin_amdgcn_mfma_f32_16x16x32_bf16(vbuf[gi & 1][q], pf[pp][1], o[nb0 + q][1], 0, 0, 0);
        }
        __builtin_amdgcn_s_setprio(0);
        __builtin_amdgcn_sched_barrier(0);
      }
#undef ATT_LDV
    }
    __builtin_amdgcn_sched_barrier(0);
    att_store<DV, NV, NL>(Ks, Vs, cur ^ 1, krow, kch, Rs);
    __syncthreads();
  };
  for (int ti = 0; ti < ntiles; ti += 2) {
    step(ti, 0, R1, R0);
    if (ti + 1 < ntiles) step(ti + 1, 1, R0, R1);
  }
  asm volatile("s_waitcnt vmcnt(0)" : "+v"(R0.k0), "+v"(R0.v0), "+v"(R0.v1), "+v"(R1.k0), "+v"(R1.v0), "+v"(R1.v1) : : "memory");
  if (MODE == 2) {
#pragma unroll
    for (int rb = 0; rb < 2; ++rb) {
      float sum = 0.f;
#pragma unroll
      for (int nb = 0; nb < NB; ++nb)
#pragma unroll
        for (int j = 0; j < 4; ++j) sum += o[nb][rb][j];
      sum += __shfl_xor(sum, 16); sum += __shfl_xor(sum, 32);
      const float mean = sum * (1.0f / (float)DV);
      float var = 0.f;
#pragma unroll
      for (int nb = 0; nb < NB; ++nb)
#pragma unroll
        for (int j = 0; j < 4; ++j) { const float d = o[nb][rb][j] - mean; var += d * d; }
      var += __shfl_xor(var, 16); var += __shfl_xor(var, 32);
      const float rstd = rsqrtf(var * (1.0f / (float)DV) + 1e-5f);
      const size_t tok = (size_t)(a.tok0 + w * 32 + rb * 16 + lr);
      uint2 ovs[NB];
#pragma unroll
      for (int nb = 0; nb < NB; ++nb) {
        const int e0 = nb * 16 + lq * 4;
        const uint2 gv = *(const uint2*)(a.gr + tok * 1024 + a.h * DV + e0);
        const float4 gn = *(const float4*)(a.gn + a.h * DV + e0);
        const float g0 = bf2f((unsigned short)(gv.x & 0xffffu)), g1 = bf2f((unsigned short)(gv.x >> 16));
        const float g2 = bf2f((unsigned short)(gv.y & 0xffffu)), g3 = bf2f((unsigned short)(gv.y >> 16));
        uint2 ov;
        ov.x = pack2((o[nb][rb][0] - mean) * rstd * gn.x * silu_f(g0), (o[nb][rb][1] - mean) * rstd * gn.y * silu_f(g1));
        ov.y = pack2((o[nb][rb][2] - mean) * rstd * gn.z * silu_f(g2), (o[nb][rb][3] - mean) * rstd * gn.w * silu_f(g3));
        ovs[nb] = ov;
      }
#pragma unroll
      for (int k = 0; k < NB / 2; ++k) store_pair16(a.out + tok * a.ldo + a.h * DV + 32 * k, lq, ovs[2 * k], ovs[2 * k + 1]);
    }
  } else {
#pragma unroll
    for (int rb = 0; rb < 2; ++rb) {
      float lt = lrow[rb]; lt += __shfl_xor(lt, 16); lt += __shfl_xor(lt, 32);
      const float inv = __builtin_amdgcn_rcpf(lt);
      bf16* op = a.out + (size_t)(w * 32 + rb * 16 + lr) * a.ldo;
      uint2 ovs[NB];
#pragma unroll
      for (int nb = 0; nb < NB; ++nb) { ovs[nb].x = pack2(o[nb][rb][0] * inv, o[nb][rb][1] * inv); ovs[nb].y = pack2(o[nb][rb][2] * inv, o[nb][rb][3] * inv); }
#pragma unroll
      for (int k = 0; k < NB / 2; ++k) store_pair16(op + 32 * k, lq, ovs[2 * k], ovs[2 * k + 1]);
    }
  }
}

DEV int xcd_item(int item, int per) {
  const int g = item / per, i = item - g * per;
  const int sub = per >> 3;
  return g * per + (i & 7) * sub + (i >> 3);
}

DEV void even_attn_args(const Params& p, AttnArgs& a, int item, int& b, int& h, int& seq0, int& tok0, bool& lat) {
  int qt;
  lat = item < 256;
  if (lat) { b = item >> 5; h = (item >> 2) & 7; qt = item & 3; }
  else { const int i2 = item - 256; b = i2 >> 3; h = i2 & 7; qt = 0; }
  seq0 = lat ? 8192 + b * 1024 : b * 256;
  tok0 = seq0 + qt * 256;
  a.n1 = 0; a.n2 = 0; a.k1 = nullptr; a.vt1 = nullptr; a.vt2 = nullptr; a.ldk1 = 0; a.ldvt1 = 0; a.ldvt2 = 0;
  a.r0 = 0; a.lo = 0; a.scale = 0.125f * LOG2E; a.qpos0 = qt * 256; a.seqN = lat ? 1024 : 256; a.lgf = 0.f; a.lgb = 0.f;
  a.gr = nullptr; a.gn = nullptr; a.tok0 = tok0; a.h = h;
}

DEV void even_mixer_phase(const Params& p, unsigned char* smem) {
  unsigned char* ws = p.ws;
  bf16* MO = (bf16*)(ws + OFF_R1);
  for (int item = blockIdx.x; item < 512; item += gridDim.x) {
    const float* lg2 = (const float*)(ws + OFF_LG2);
    bool lat; int b, h, seq0, tok0; AttnArgs a;
    even_attn_args(p, a, xcd_item(item, 256), b, h, seq0, tok0, lat);
    const size_t hb = lat ? (size_t)8192 * 512 + (size_t)(b * 8 + h) * 1024 * 64 : (size_t)(b * 8 + h) * 256 * 64;
    a.q = (const bf16*)(ws + B_QR) + hb + (size_t)a.qpos0 * 64; a.ldq = 64;
    a.k0 = (const bf16*)(ws + B_KR) + hb; a.ldk0 = 64;
    if (lat) { a.vt0 = (const bf16*)(ws + B_VRT) + (size_t)8192 * 1024 + (size_t)(b * 8 + h) * 16 * 8192; a.ldvt0 = 64; a.n0 = 16;
      a.n1 = 1; a.vt1 = (const bf16*)(ws + S0T_F) + (size_t)(b * 8 + h) * 128 * 64; a.ldvt1 = 64;
      a.n2 = 1; a.vt2 = (const bf16*)(ws + S0T_B) + (size_t)(b * 8 + h) * 128 * 64; a.ldvt2 = 64; }
    else { a.vt0 = (const bf16*)(ws + B_VRT) + (size_t)(b * 8 + h) * 4 * 8192; a.ldvt0 = 64; a.n0 = 4; }
    a.lgf = lg2[h]; a.lgb = lg2[8 + h];
    a.gr = (const bf16*)(ws + B_GR); a.gn = p.ret_gn; a.out = MO; a.ldo = 1536;
    attn_item<128, 2>(a, smem, nullptr);
  }
  for (int item = blockIdx.x; item < 512; item += gridDim.x) {
    bool lat; int b, h, seq0, tok0; AttnArgs a;
    even_attn_args(p, a, xcd_item(item, 256), b, h, seq0, tok0, lat);
    const int kvh = h >> 2;
    const size_t hb = lat ? (size_t)8192 * 512 + (size_t)(b * 8 + h) * 1024 * 64 : (size_t)(b * 8 + h) * 256 * 64;
    a.q = (const bf16*)(ws + B_QA) + hb + (size_t)a.qpos0 * 64; a.ldq = 64;
    a.k0 = (const bf16*)(ws + B_KA) + (lat ? (size_t)8192 * 128 + (size_t)(b * 2 + kvh) * 1024 * 64 : (size_t)(b * 2 + kvh) * 256 * 64); a.ldk0 = 64;
    if (lat) { a.vt0 = (const bf16*)(ws + B_VAT) + (size_t)32 * 2 * 64 * 256 + (size_t)(b * 2 + kvh) * 16 * 4096; a.ldvt0 = 64; a.n0 = 16;
      a.n1 = 4; a.k1 = (const bf16*)(ws + CK_GQA) + (size_t)(b * 2 + kvh) * 256 * 64; a.ldk1 = 64;
      a.vt1 = (const bf16*)(ws + CVT_GQA) + (size_t)(b * 2 + kvh) * 64 * 256; a.ldvt1 = 256; }
    else { a.vt0 = (const bf16*)(ws + B_VAT) + (size_t)(b * 2 + kvh) * 4 * 4096; a.ldvt0 = 64; a.n0 = 4; }
    a.out = MO + (size_t)tok0 * 1536 + 1024 + h * 64; a.ldo = 1536;
    attn_item<64, 0>(a, smem, nullptr);
  }
  for (int item = blockIdx.x; item < 256; item += gridDim.x) {
    const int b = item >> 3, h = item & 7;
    gemm_core((const bf16*)(ws + B_KTFB) + (size_t)(b * 8 + h) * 2 * 64 * 256, 256, (const bf16*)(ws + B_VRT) + (size_t)(b * 8 + h) * 4 * 8192, 64, 8192, 256, smem);
    epi_state(p, b, h, (const float*)smem);
  }
}

DEV void odd_mixer_phase(const Params& p, unsigned char* smem) {
  unsigned char* ws = p.ws;
  bf16* MO = (bf16*)(ws + OFF_R1);
  float* rpbs = (float*)(smem + 65536);
  for (int item = blockIdx.x; item < 1024; item += gridDim.x) {
    AttnArgs a;
    a.n1 = 0; a.n2 = 0; a.k1 = nullptr; a.vt1 = nullptr; a.vt2 = nullptr; a.ldk1 = 0; a.ldvt1 = 0; a.ldvt2 = 0;
    a.r0 = 0; a.lo = 0; a.scale = 0.125f * LOG2E; a.qpos0 = 0; a.seqN = 0; a.lgf = 0.f; a.lgb = 0.f;
    a.gr = nullptr; a.gn = nullptr; a.tok0 = 0; a.h = 0;
    if (item < 512) {
      const int it2 = xcd_item(item, 512);
      const int b = it2 >> 6, h = (it2 >> 2) & 15, rq = (it2 & 3) ^ ((item >> 8) & 1); const int r0 = rq * 4;
      int lo = r0 - 4; lo = lo < 0 ? 0 : (lo > 8 ? 8 : lo);
      int hi = r0 + 3 - 4; hi = hi < 0 ? 0 : (hi > 8 ? 8 : hi); hi += 8;
      const int seq0 = 8192 + b * 1024; const int tok0 = seq0 + r0 * 64;
      for (int idx = threadIdx.x; idx < 465; idx += 512) rpbs[idx] = p.na_rpb[h * 465 + idx] * LOG2E;
      const size_t hb = (size_t)8192 * 1024 + (size_t)(b * 16 + h) * 1024 * 64;
      a.q = (const bf16*)(ws + B_Q) + hb + (size_t)r0 * 64 * 64; a.ldq = 64;
      a.k0 = (const bf16*)(ws + B_K) + hb + (size_t)lo * 64 * 64; a.ldk0 = 64;
      a.vt0 = (const bf16*)(ws + B_VT) + (size_t)8192 * 1024 + ((size_t)(b * 16 + h) * 16 + lo) * 4096; a.ldvt0 = 64; a.n0 = hi - lo;
      a.n1 = 4; a.k1 = (const bf16*)(ws + CK_NA) + (size_t)(b * 16 + h) * 256 * 64; a.ldk1 = 64;
      a.vt1 = (const bf16*)(ws + CVT_NA) + (size_t)(b * 16 + h) * 64 * 256; a.ldvt1 = 256;
      a.r0 = r0; a.lo = lo;
      a.out = MO + (size_t)tok0 * 1024 + h * 64; a.ldo = 1024;
      attn_item<64, 1>(a, smem, rpbs);
    } else {
      const int i2 = item - 512; const int b = i2 >> 4, h = i2 & 15;
      const int seq0 = b * 256; const int tok0 = seq0;
      const size_t hb = (size_t)(b * 16 + h) * 256 * 64;
      a.q = (const bf16*)(ws + B_Q) + hb; a.ldq = 64;
      a.k0 = (const bf16*)(ws + B_K) + hb; a.ldk0 = 64;
      a.vt0 = (const bf16*)(ws + B_VT) + (size_t)(b * 16 + h) * 4 * 4096; a.ldvt0 = 64; a.n0 = 4;
      a.out = MO + (size_t)tok0 * 1024 + h * 64; a.ldo = 1024;
      attn_item<64, 0>(a, smem, nullptr);
    }
  }
}

__global__ void __launch_bounds__(512, 2) mega_kernel(Params p) {
  extern __shared__ __attribute__((aligned(16))) unsigned char smem[];
  if (threadIdx.x == 0) *(uint4*)(smem + SMEM_BYTES) = make_uint4(0u, 0u, 0u, 0u);
  __syncthreads();
  XcdBarrier bar = xcd_barrier_post((unsigned*)(p.ws + OFF_BAR), (volatile LAS unsigned*)(smem + SMEM_BYTES));
  unsigned char* ws = p.ws;

  for (int i = blockIdx.x; i < 785; i += gridDim.x) {
    const int old = i < 192 ? i : (i < 432 ? 384 + (i - 192) : (i < 496 ? 624 + (i - 432) : (i < 752 ? 624 + 576 + (i - 496) : (i < 784 ? 1456 + (i - 752) : 1744))));
    p0_item(p, old, smem);
  }
  xcd_barrier(bar);

  {
    float* mod = (float*)(ws + OFF_MOD); const float* mp = (const float*)(ws + OFF_MODP);
    for (int idx = blockIdx.x * 512 + threadIdx.x; idx < 9 * 6144; idx += gridDim.x * 512) {
      const int l = 0, n = idx % 6144;
      float s = p.ada_b[l * 6144 + n];
#pragma unroll
      for (int kq = 0; kq < 8; ++kq) s += mp[(size_t)kq * 110592 + idx];
      mod[idx] = s;
    }
  }
  norm_phase(p, 0, 0, 1, p.norm_mix, p.x_prompt, p.x_sample, true, smem);
  xcd_barrier(bar);

  gemm_phase<0>(p, (const bf16*)(ws + OFF_R1), (const bf16*)(ws + WT_EIN), 1024, 3840, 0, 0, nullptr, nullptr, smem);
  xcd_barrier(bar);
  even_mixer_phase(p, smem);
  xcd_barrier(bar);
  gemm_phase<2>(p, (const bf16*)(ws + OFF_R1), (const bf16*)(ws + WT_EOUT), 1536, 1024, 0, 2 | 16, p.x_prompt, p.x_sample, smem);
  xcd_barrier(bar);
  norm_phase(p, 0, 3, 4, p.norm_ffn, nullptr, nullptr, false, smem);
  xcd_barrier(bar);
  gemm_phase<3>(p, (const bf16*)(ws + OFF_R1), (const bf16*)(ws + WT_UP), 1024, 5632, 0, 0, nullptr, nullptr, smem);
  xcd_barrier(bar);
  {
    float* mod = (float*)(ws + OFF_MOD); const float* mp = (const float*)(ws + OFF_MODP);
    for (int idx = 55296 + blockIdx.x * 512 + threadIdx.x; idx < 2 * 55296; idx += gridDim.x * 512) {
      float sacc = p.ada_b[6144 + idx % 6144];
#pragma unroll
      for (int kq = 0; kq < 8; ++kq) sacc += mp[(size_t)kq * 110592 + idx];
      mod[idx] = sacc;
    }
  }
  gemm_phase<2>(p, (const bf16*)(ws + B_ACT), (const bf16*)(ws + WT_DN), 2816, 1024, 0, 5 | 16, nullptr, nullptr, smem);
  xcd_barrier(bar);

  norm_phase(p, 1, 0, 1, p.norm_mix + 1024, nullptr, nullptr, false, smem);
  xcd_barrier(bar);
  gemm_phase<1>(p, (const bf16*)(ws + OFF_R1), (const bf16*)(ws + WT_OIN), 1024, 3072, 1, 0, nullptr, nullptr, smem);
  xcd_barrier(bar);
  odd_mixer_phase(p, smem);
  xcd_barrier(bar);
  gemm_phase<2>(p, (const bf16*)(ws + OFF_R1), (const bf16*)(ws + WT_OOUT), 1024, 1024, 1, 2 | 16, nullptr, nullptr, smem);
  xcd_barrier(bar);
  norm_phase(p, 1, 3, 4, p.norm_ffn + 1024, nullptr, nullptr, false, smem);
  xcd_barrier(bar);
  gemm_phase<3>(p, (const bf16*)(ws + OFF_R1), (const bf16*)(ws + WT_UP) + (size_t)5632 * 1024, 1024, 5632, 1, 0, nullptr, nullptr, smem);
  xcd_barrier(bar);
  gemm_phase<2>(p, (const bf16*)(ws + B_ACT), (const bf16*)(ws + WT_DN) + (size_t)1024 * 2816, 2816, 1024, 1, 5 | 16, nullptr, nullptr, smem);
  xcd_barrier(bar);

  final_norm_phase(p);
}

extern "C" void kernel_launch(void* const* d_in, const int* in_sizes, int n_in, void* d_out, int out_size, void* d_ws, size_t ws_size,
                              hipStream_t stream) {
  static int grid_blocks = 0;
  if (!grid_blocks) {
    int dev = 0, cus = 0, per_cu = 0;
    hipGetDevice(&dev);
    hipDeviceGetAttribute(&cus, hipDeviceAttributeMultiprocessorCount, dev);
    if (hipFuncSetAttribute((const void*)mega_kernel, hipFuncAttributeMaxDynamicSharedMemorySize, LDS_TOTAL) != hipSuccess) fprintf(stderr, "hipFuncSetAttribute failed\n");
    hipOccupancyMaxActiveBlocksPerMultiprocessor(&per_cu, mega_kernel, 512, LDS_TOTAL);
    (void)hipGetLastError();
    if (per_cu > 1) per_cu = 1;
    if (per_cu < 1) per_cu = 1;
    grid_blocks = cus * per_cu;
    if (grid_blocks % 8) grid_blocks -= grid_blocks % 8;
  }
  if (ws_size < (size_t)WS_NEEDED) fprintf(stderr, "workspace too small: %zu < %llu\n", ws_size, (unsigned long long)WS_NEEDED);
  Params p{};
  const float** pp = (const float**)&p;
  for (int i = 0; i < 29; ++i) pp[i] = (const float*)d_in[i];
  p.out = (float*)d_out;
  p.ws = (unsigned char*)d_ws;
  hipMemsetAsync(d_ws, 0, XCD_BAR_WORDS * 4, stream);
  void* args[] = {&p};
  hipError_t e = hipLaunchCooperativeKernel((void*)mega_kernel, dim3(grid_blocks), dim3(512), args, LDS_TOTAL, stream);
  if (e != hipSuccess) fprintf(stderr, "cooperative launch failed: %s (grid %d)\n", hipGetErrorString(e), grid_blocks);
}
```

```cpp
#include <hip/hip_runtime.h>
#include <stdint.h>
#include <stdio.h>

typedef unsigned short bf16;
typedef __attribute__((ext_vector_type(8))) short bf16x8;
typedef __attribute__((ext_vector_type(4))) float f32x4;
typedef __attribute__((ext_vector_type(4))) unsigned u32x4;

#define DEV __device__ __forceinline__
#define LOG2E 1.4426950408889634f

#define OFF_BAR    0ull
#define OFF_ROPE   16384ull
#define OFF_LG2    (16384ull + 8192ull)
#define OFF_MOD    32768ull
#define OFF_MODP   491520ull
#define OFF_WT     4194304ull
#define WT_EIN     (OFF_WT)
#define WT_EOUT    (WT_EIN + 7864320ull)
#define WT_OIN     (WT_EOUT + 3145728ull)
#define WT_OOUT    (WT_OIN + 6291456ull)
#define WT_UP      (WT_OOUT + 2097152ull)
#define WT_DN      (WT_UP + 2ull * 11534336ull)
#define OFF_CACHE  (WT_DN + 2ull * 5767168ull)
#define CK_GQA     (OFF_CACHE)
#define CVT_GQA    (CK_GQA + 524288ull)
#define CK_NA      (CVT_GQA + 524288ull)
#define CVT_NA     (CK_NA + 4194304ull)
#define S0T_F      (CVT_NA + 4194304ull)
#define S0T_B      (S0T_F + 1048576ull)
#define OFF_R1     (S0T_B + 1048576ull)
#define OFF_R2     (OFF_R1 + 50331648ull)
#define B_QR       (OFF_R2)
#define B_KR       (B_QR + 16777216ull)
#define B_VRT      (B_KR + 16777216ull)
#define B_GR       (B_VRT + 33554432ull)
#define B_QA       (B_GR + 33554432ull)
#define B_KA       (B_QA + 16777216ull)
#define B_VAT      (B_KA + 4194304ull)
#define B_KTFB     (B_VAT + 4194304ull)
#define R2_END     (B_KTFB + 16777216ull)
#define B_Q        (OFF_R2)
#define B_K        (B_Q + 33554432ull)
#define B_VT       (B_K + 33554432ull)
#define B_ACT      (OFF_R2)
#define B_HALO     (B_ACT + 92274688ull)
#define B_XB       (OFF_R2 + 103809024ull)
#define WS_NEEDED  (R2_END)

#define O_YP 0ull
#define O_SF 16777216ull
#define O_SB 18874368ull
#define O_GK 20971520ull
#define O_GV 22020096ull
#define O_NK 23068672ull
#define O_NV 31457280ull

#define SMEM_BYTES 135168
#define NTHR 512
#define LDS_TOTAL (SMEM_BYTES + 16)

struct Params {
  const float *x_prompt, *x_sample, *state_f, *state_b, *cgk, *cgv, *cnk, *cnv, *c, *c_ctx, *ada_w, *ada_b,
      *norm_mix, *norm_ffn, *norm_final, *even_w_in, *even_w_out, *decay_f, *decay_b, *ret_gn, *q_norm, *k_norm,
      *odd_w_in, *odd_w_out, *na_rpb, *w_up, *conv_w, *conv_b, *w_down;
  float* out;
  unsigned char* ws;
};

DEV unsigned short f2bf(float f) { unsigned u = __float_as_uint(f); u += 0x7fffu + ((u >> 16) & 1u); return (unsigned short)(u >> 16); }
DEV float bf2f(unsigned short h) { return __uint_as_float(((unsigned)h) << 16); }
DEV unsigned pack2(float a, float b) { unsigned r; asm("v_cvt_pk_bf16_f32 %0, %1, %2" : "=v"(r) : "v"(a), "v"(b)); return r; }
DEV uint4 pack8(const float* v) { uint4 o; o.x = pack2(v[0], v[1]); o.y = pack2(v[2], v[3]); o.z = pack2(v[4], v[5]); o.w = pack2(v[6], v[7]); return o; }
DEV float fexp2(float x) { return __builtin_amdgcn_exp2f(x); }
DEV u32x4 gload16(const void* p) { u32x4 r; asm volatile("global_load_dwordx4 %0, %1, off" : "=v"(r) : "v"(p) : "memory"); return r; }
#define VMWAIT4(a, b, c, d) asm volatile("s_waitcnt vmcnt(0)" : "+v"(a), "+v"(b), "+v"(c), "+v"(d) : : "memory")
#define VMWAIT2(a, b) asm volatile("s_waitcnt vmcnt(0)" : "+v"(a), "+v"(b) : : "memory")
DEV float silu_f(float x) { return x * __builtin_amdgcn_rcpf(1.0f + __expf(-x)); }

#define XB_TMO      128
#define XB_XCNT(j)  (256  + 64 * (j))
#define XB_XSUB(j)  (1280 + 64 * (j))
#define XB_XGEN(j)  (2304 + 64 * (j))
#define XB_TOP      3328
#define XB_TOPGEN   3392
#define XCD_BAR_WORDS 3456
#define XB_SPIN_CAP (1u << 22)
#define LAS __attribute__((address_space(3)))

DEV unsigned xb_ld(unsigned* p) { return __hip_atomic_load(p, __ATOMIC_RELAXED, __HIP_MEMORY_SCOPE_AGENT); }
DEV unsigned xb_add(unsigned* p, unsigned v) { return __hip_atomic_fetch_add(p, v, __ATOMIC_RELAXED, __HIP_MEMORY_SCOPE_AGENT); }
DEV unsigned xb_xcc_id() { return (unsigned)__builtin_amdgcn_s_getreg((3 << 11) | 20) & 0xFu; }
#define XB_SPIN(cond, bar) do { unsigned _sp = 0; while (cond) { __builtin_amdgcn_s_sleep(1); \
    if ((++_sp & 255u) == 0u) { if (xb_ld(&(bar)[XB_TMO])) break; if (_sp > XB_SPIN_CAP) { atomicAdd(&(bar)[XB_TMO], 1u); break; } } } } while (0)

struct XcdBarrier { unsigned* bar; unsigned x; volatile LAS unsigned* st; };

DEV XcdBarrier xcd_barrier_post(unsigned* bar, volatile LAS unsigned* st) {
  XcdBarrier b; b.bar = bar; b.x = xb_xcc_id(); b.st = st;
  if (threadIdx.x == 0) (void)xb_add(&bar[XB_XCNT(b.x)], 1u);
  return b;
}
DEV void xcd_barrier_complete(unsigned* bar, unsigned x, unsigned& nloc, unsigned& nx) {
  const unsigned G = gridDim.x * gridDim.y * gridDim.z;
  unsigned sum, cnt, mine, sp = 0u;
  for (;;) {
    sum = 0u; cnt = 0u; mine = 0u;
#pragma unroll
    for (unsigned j = 0; j < 16; ++j) { const unsigned c = xb_ld(&bar[XB_XCNT(j)]); sum += c; cnt += (c > 0u) ? 1u : 0u; mine = (j == x) ? c : mine; }
    if (sum == G) break;
    __builtin_amdgcn_s_sleep(1);
    if ((++sp & 255u) == 0u) { if (xb_ld(&bar[XB_TMO])) break; if (sp > XB_SPIN_CAP) { atomicAdd(&bar[XB_TMO], 1u); break; } }
  }
  nloc = mine > 0u ? mine : 1u; nx = cnt > 0u ? cnt : 1u;
}
DEV void xcd_barrier(const XcdBarrier& b) {
  asm volatile("s_waitcnt vmcnt(0)" ::: "memory");
  __syncthreads();
  if (threadIdx.x == 0) {
    unsigned* bar = b.bar;
    __builtin_amdgcn_s_waitcnt(0);
    unsigned nloc = b.st[0], nx = b.st[1];
    if (nloc == 0u) { xcd_barrier_complete(bar, b.x, nloc, nx); b.st[0] = nloc; b.st[1] = nx; }
    const unsigned old = xb_add(&bar[XB_XSUB(b.x)], 1u);
    const unsigned gen = old / nloc;
    if (old + 1u == (gen + 1u) * nloc) {
      __builtin_amdgcn_fence(__ATOMIC_RELEASE, "agent");
      asm volatile("s_waitcnt vmcnt(0)" ::: "memory");
      const unsigned og = xb_add(&bar[XB_TOP], 1u);
      const unsigned tg = og / nx;
      if (og + 1u == (tg + 1u) * nx) xb_add(&bar[XB_TOPGEN], 1u);
      else XB_SPIN(xb_ld(&bar[XB_TOPGEN]) == tg, bar);
      __builtin_amdgcn_fence(__ATOMIC_ACQUIRE, "agent");
      xb_add(&bar[XB_XGEN(b.x)], 1u);
      asm volatile("s_waitcnt vmcnt(0)" ::: "memory");
    } else {
      XB_SPIN(xb_ld(&bar[XB_XGEN(b.x)]) == gen, bar);
      __builtin_amdgcn_fence(__ATOMIC_ACQUIRE, "agent");
      asm volatile("s_waitcnt vmcnt(0)" ::: "memory");
    }
  }
  __syncthreads();
}

DEV void p0_transpose(const float* __restrict__ src, int ld, bf16* __restrict__ dst, int ldd, float* sm) {
  int tid = threadIdx.x; asm volatile("" : "+v"(tid));
#pragma unroll
  for (int i = 0; i < 2; ++i) {
    int idx = tid + 512 * i; int r = idx >> 4, c4 = idx & 15;
    float4 v = *(const float4*)(src + (size_t)r * ld + c4 * 4);
    float* d = sm + r * 65 + c4 * 4; d[0] = v.x; d[1] = v.y; d[2] = v.z; d[3] = v.w;
  }
  __syncthreads();
  {
    int idx = tid; int c = idx >> 3, rc = idx & 7; float v[8];
#pragma unroll
    for (int e = 0; e < 8; ++e) v[e] = sm[(rc * 8 + e) * 65 + c];
    *(uint4*)(dst + (size_t)c * ldd + rc * 8) = pack8(v);
  }
  __syncthreads();
}

DEV void p0_transpose4(const float* __restrict__ src, int ld, bf16* __restrict__ d0, bf16* __restrict__ d1, bf16* __restrict__ d2, bf16* __restrict__ d3, int ldd, float scale, float* sm) {
  int tid = threadIdx.x; asm volatile("" : "+v"(tid));
  float4 v[8];
#pragma unroll
  for (int i = 0; i < 8; ++i) { const int idx = tid + 512 * i; const int r = idx >> 6, c4 = idx & 63; v[i] = *(const float4*)(src + (size_t)r * ld + c4 * 4); }
#pragma unroll
  for (int i = 0; i < 8; ++i) { const int idx = tid + 512 * i; const int r = idx >> 6, c4 = idx & 63; float* d = sm + r * 257 + c4 * 4; d[0] = v[i].x; d[1] = v[i].y; d[2] = v[i].z; d[3] = v[i].w; }
  __syncthreads();
#pragma unroll
  for (int i = 0; i < 4; ++i) {
    const int idx = tid + 512 * i; const int c = idx >> 3, rc = idx & 7; float o[8];
#pragma unroll
    for (int e = 0; e < 8; ++e) o[e] = sm[(rc * 8 + e) * 257 + c] * scale;
    bf16* db = (i == 0) ? d0 : (i == 1) ? d1 : (i == 2) ? d2 : d3;
    *(uint4*)(db + (size_t)(c & 63) * ldd + rc * 8) = pack8(o);
  }
  __syncthreads();
}

DEV void p0_weight(const Params& p, int item, unsigned char* smem) {
  unsigned char* ws = p.ws;
  const float* src; bf16* dst; int R, C, remap = 0; int t = item;
  if (t < 240) { src = p.even_w_in; R = 1024; C = 3840; dst = (bf16*)(ws + WT_EIN); }
  else if ((t -= 240) < 96) { src = p.even_w_out; R = 1536; C = 1024; dst = (bf16*)(ws + WT_EOUT); }
  else if ((t -= 96) < 192) { src = p.odd_w_in; R = 1024; C = 3072; dst = (bf16*)(ws + WT_OIN); }
  else if ((t -= 192) < 64) { src = p.odd_w_out; R = 1024; C = 1024; dst = (bf16*)(ws + WT_OOUT); }
  else if ((t -= 64) < 704) { int l = t / 352; t %= 352; src = p.w_up + (size_t)l * 1024 * 5632; R = 1024; C = 5632; dst = (bf16*)(ws + WT_UP) + (size_t)l * 5632 * 1024; remap = 1; }
  else { t -= 704; int l = t / 176; t %= 176; src = p.w_down + (size_t)l * 2816 * 1024; R = 2816; C = 1024; dst = (bf16*)(ws + WT_DN) + (size_t)l * 1024 * 2816; }
  const int tcn = C >> 8; const int rt = t / tcn, c4 = t % tcn;
  bf16* d[4];
#pragma unroll
  for (int j = 0; j < 4; ++j) { const int ct = c4 * 4 + j; const int drow = remap ? ((ct % 44) * 128 + (ct / 44) * 64) : ct * 64; d[j] = dst + (size_t)drow * R + rt * 64; }
  const float wscale = (item < 240 && (c4 == 2 || c4 == 3)) ? 0.125f : 1.0f;
  p0_transpose4(src + (size_t)rt * 64 * C + c4 * 256, C, d[0], d[1], d[2], d[3], R, wscale, (float*)smem);
}
DEV void p0_item(const Params& p, int item, unsigned char* smem);
DEV void p0_weight_tail(const Params& p, int group, int total_units, unsigned char* smem) {
  const int G = (int)gridDim.x, c = (int)blockIdx.x;
  const int nfull = total_units % G;
  const int first = nfull ? nfull : 0, nw = nfull ? (G - nfull) : G;
  if (c < first) return;
  const int n = group ? 784 + 960 : 624;
  for (int i = c - first; i < n; i += nw) {
    if (i >= 784) {
      const int j = i - 784;
      p0_item(p, j < 192 ? 192 + j : (j < 704 ? 624 + 64 + (j - 192) : 1456 + 32 + (j - 704)), smem);
      continue;
    }
    int t;
    if (group == 0) t = i < 96 ? 240 + i : (i < 448 ? 592 + (i - 96) : 1296 + (i - 448));
    else t = i < 192 ? 336 + i : (i < 256 ? 528 + (i - 192) : (i < 608 ? 944 + (i - 256) : 1472 + (i - 608)));
    p0_weight(p, t, smem);
  }
}

DEV void p0_item(const Params& p, int item, unsigned char* smem) {
  int tid = threadIdx.x; asm volatile("" : "+v"(tid)); const int lane = tid & 63, w = tid >> 6;
  unsigned char* ws = p.ws;
  if (item < 384) {
    const int l = item / 192, rem = item % 192, cb = rem >> 3, kq = rem & 7;
    float* sc = (float*)smem;
    float* red = sc + 9 * 128;
    for (int idx = tid; idx < 9 * 128; idx += 512) {
      int crow = idx >> 7, kk = idx & 127, k = kq * 128 + kk;
      float v = crow < 8 ? p.c[crow * 1024 + k] : p.c_ctx[k];
      sc[idx] = silu_f(v);
    }
    __syncthreads();
    float acc[9][4];
#pragma unroll
    for (int r = 0; r < 9; ++r) { acc[r][0] = 0.f; acc[r][1] = 0.f; acc[r][2] = 0.f; acc[r][3] = 0.f; }
    const float* wp = p.ada_w + ((size_t)(l * 1024 + kq * 128 + w * 16)) * 6144 + cb * 256 + lane * 4;
#pragma unroll 8
    for (int kk = 0; kk < 16; ++kk) {
      float4 wv = *(const float4*)(wp + (size_t)kk * 6144);
#pragma unroll
      for (int r = 0; r < 9; ++r) {
        float s = sc[r * 128 + w * 16 + kk];
        acc[r][0] += s * wv.x; acc[r][1] += s * wv.y; acc[r][2] += s * wv.z; acc[r][3] += s * wv.w;
      }
    }
#pragma unroll
    for (int r = 0; r < 9; ++r) {
      float* d = red + (w * 9 + r) * 256 + lane * 4;
      d[0] = acc[r][0]; d[1] = acc[r][1]; d[2] = acc[r][2]; d[3] = acc[r][3];
    }
    __syncthreads();
    float* modp = (float*)(ws + OFF_MODP);
    for (int idx = tid; idx < 9 * 256; idx += 512) {
      int r = idx >> 8, cc = idx & 255;
      float s = 0.f;
#pragma unroll
      for (int ww = 0; ww < 8; ++ww) s += red[(ww * 9 + r) * 256 + cc];
      modp[((size_t)(kq * 2 + l) * 9 + r) * 6144 + cb * 256 + cc] = s;
    }
    __syncthreads();
    return;
  }
  item -= 384;
  if (item < 240) { p0_weight(p, item, smem); return; }
  item -= 240;
  if (item < 832) {
    const float* src; bf16* dst; int R, C, tiled = 0; int t = item;
    if (t < 64) { int mat = t >> 2; t &= 3; src = p.cgv + (size_t)mat * 256 * 64; R = 256; C = 64; dst = (bf16*)(ws + CVT_GQA) + (size_t)mat * 64 * 256; tiled = 1; }
    else if ((t -= 64) < 512) { int mat = t >> 2; t &= 3; src = p.cnv + (size_t)mat * 256 * 64; R = 256; C = 64; dst = (bf16*)(ws + CVT_NA) + (size_t)mat * 64 * 256; tiled = 1; }
    else { t -= 512; int which = t >> 7; t &= 127; int mat = t >> 1; t &= 1; src = (which ? p.state_b : p.state_f) + (size_t)mat * 64 * 128; R = 64; C = 128; dst = (bf16*)(ws + (which ? S0T_B : S0T_F)) + (size_t)mat * 128 * 64; }
    const int tcn = C >> 6; const int rt = t / tcn, ct = t % tcn;
    if (tiled) p0_transpose(src + (size_t)rt * 64 * C, C, dst + (size_t)rt * 4096, 64, (float*)smem);
    else p0_transpose(src + (size_t)rt * 64 * C + ct * 64, C, dst + (size_t)(ct * 64) * R + rt * 64, R, (float*)smem);
    return;
  }
  item -= 832;
  if (item < 288) {
    const float* src; bf16* dst; size_t base;
    if (item < 32) { src = p.cgk; dst = (bf16*)(ws + CK_GQA); base = (size_t)item * 8192; }
    else { src = p.cnk; dst = (bf16*)(ws + CK_NA); base = (size_t)(item - 32) * 8192; }
#pragma unroll
    for (int i = 0; i < 2; ++i) {
      size_t o = base + (size_t)(i * 512 + tid) * 8;
      float4 a = *(const float4*)(src + o), b = *(const float4*)(src + o + 4);
      float v[8] = {a.x, a.y, a.z, a.w, b.x, b.y, b.z, b.w};
      *(uint4*)(dst + o) = pack8(v);
    }
    return;
  }
  {
    float2* rope = (float2*)(ws + OFF_ROPE);
    for (int idx = tid; idx < 1024; idx += 512) {
      int pos = idx >> 4, fi = idx & 15;
      float inv = exp2f(-(float)fi * 0.8304820237218406f);
      float ang = (float)pos * inv;
      float k = rintf(ang * 0.15915494309189535f);
      float r = fmaf(-k, 6.2831854820251465f, ang);
      r = fmaf(-k, -1.7484556e-7f, r);
      rope[idx] = make_float2(__cosf(r), __sinf(r));
    }
    if (tid < 16) {
      int fb = tid >> 3, h = tid & 7;
      float x = (fb ? p.decay_b : p.decay_f)[h];
      float lg = -log1pf(expf(-x)) * LOG2E;
      ((float*)(ws + OFF_LG2))[tid] = lg;
    }
  }
}

DEV float modval(const Params& p, int l, int crow, int n, bool partial) {
  if (!partial) return ((const float*)(p.ws + OFF_MOD))[(size_t)(l * 9 + crow) * 6144 + n];
  const float* mp = (const float*)(p.ws + OFF_MODP);
  float s = p.ada_b[l * 6144 + n];
#pragma unroll
  for (int kq = 0; kq < 8; ++kq) s += mp[((size_t)(kq * 2 + l) * 9 + crow) * 6144 + n];
  return s;
}

DEV void norm_phase(const Params& p, int l, int si, int sci, const float* g, const float* xc, const float* xs, bool partial, unsigned char* smem) {
  int tid = threadIdx.x; asm volatile("" : "+v"(tid)); const int lane = tid & 63, w = tid >> 6;
  float* ssh = (float*)smem; float* ssc = ssh + 1024;
  bf16* H = (bf16*)(p.ws + OFF_R1);
  for (int chunk = blockIdx.x; chunk < 512; chunk += gridDim.x) {
    const int row0 = chunk * 32; const int crow = row0 < 8192 ? 8 : ((row0 - 8192) >> 10);
    for (int idx = tid; idx < 1024; idx += 512) {
      ssh[idx] = modval(p, l, crow, si * 1024 + idx, partial);
      ssc[idx] = (1.0f + modval(p, l, crow, sci * 1024 + idx, partial)) * g[idx];
    }
    __syncthreads();
    for (int rr = 0; rr < 4; ++rr) {
      const int row = row0 + w * 4 + rr;
      float4 v[4]; float ss = 0.f;
      if (xc) {
        const float* xp = row < 8192 ? xc + (size_t)row * 1024 : xs + (size_t)(row - 8192) * 1024;
#pragma unroll
        for (int i = 0; i < 4; ++i) v[i] = *(const float4*)(xp + lane * 4 + 256 * i);
      } else {
        const bf16* xp = (const bf16*)(p.ws + B_XB) + (size_t)row * 1024;
#pragma unroll
        for (int i = 0; i < 4; ++i) { const uint2 q = *(const uint2*)(xp + lane * 4 + 256 * i);
          v[i] = make_float4(__uint_as_float(q.x << 16), __uint_as_float(q.x & 0xffff0000u), __uint_as_float(q.y << 16), __uint_as_float(q.y & 0xffff0000u)); }
      }
#pragma unroll
      for (int i = 0; i < 4; ++i) ss += v[i].x * v[i].x + v[i].y * v[i].y + v[i].z * v[i].z + v[i].w * v[i].w;
#pragma unroll
      for (int o = 1; o < 64; o <<= 1) ss += __shfl_xor(ss, o);
      const float rstd = rsqrtf(ss * (1.0f / 1024.0f) + 1e-6f);
#pragma unroll
      for (int i = 0; i < 4; ++i) {
        const int col = lane * 4 + 256 * i;
        float4 sc = *(const float4*)(ssc + col), sh = *(const float4*)(ssh + col);
        uint2 o; o.x = pack2(v[i].x * rstd * sc.x + sh.x, v[i].y * rstd * sc.y + sh.y);
        o.y = pack2(v[i].z * rstd * sc.z + sh.z, v[i].w * rstd * sc.w + sh.w);
        *(uint2*)(H + (size_t)row * 1024 + col) = o;
      }
    }
    __syncthreads();
  }
}

DEV void final_norm_phase(const Params& p) {
  int tid = threadIdx.x; asm volatile("" : "+v"(tid)); const int lane = tid & 63, w = tid >> 6;
  for (int row = blockIdx.x * 8 + w; row < 16384; row += gridDim.x * 8) {
    const bf16* xp = (const bf16*)(p.ws + B_XB) + (size_t)row * 1024;
    float* yp = p.out + (size_t)row * 1024;
    float4 v[4]; float ss = 0.f;
#pragma unroll
    for (int i = 0; i < 4; ++i) { const uint2 q = *(const uint2*)(xp + lane * 4 + 256 * i);
      v[i] = make_float4(__uint_as_float(q.x << 16), __uint_as_float(q.x & 0xffff0000u), __uint_as_float(q.y << 16), __uint_as_float(q.y & 0xffff0000u));
      ss += v[i].x * v[i].x + v[i].y * v[i].y + v[i].z * v[i].z + v[i].w * v[i].w; }
#pragma unroll
    for (int o = 1; o < 64; o <<= 1) ss += __shfl_xor(ss, o);
    const float rstd = rsqrtf(ss * (1.0f / 1024.0f) + 1e-6f);
#pragma unroll
    for (int i = 0; i < 4; ++i) {
      const int col = lane * 4 + 256 * i;
      float4 g = *(const float4*)(p.norm_final + col);
      *(float4*)(yp + col) = make_float4(v[i].x * rstd * g.x, v[i].y * rstd * g.y, v[i].z * rstd * g.z, v[i].w * rstd * g.w);
    }
  }
}

#define CT_LD 132
DEV void gemm_core(const bf16* __restrict__ A, int lda, const bf16* __restrict__ B, int ldb, int kstepB, int K, unsigned char* smem) {
  int tid = threadIdx.x; asm volatile("" : "+v"(tid)); const int lane = tid & 63, w = tid >> 6;
  const int wr = w >> 2, wc = w & 3, lr = lane & 15, lq = lane >> 4;
  bf16* As = (bf16*)smem;
  bf16* Bs = As + 2 * 128 * 80;
  const int ldr = tid >> 3, ldc = (tid & 7) * 8;
  const bf16* Ap = A + (size_t)ldr * lda + ldc;
  const bf16* Bp = B + (size_t)ldr * ldb + ldc;
  {
    uint4 a0 = *(const uint4*)(Ap), a1 = *(const uint4*)(Ap + (size_t)64 * lda), b0 = *(const uint4*)(Bp), b1 = *(const uint4*)(Bp + (size_t)64 * ldb);
    *(uint4*)(As + ldr * 80 + ldc) = a0; *(uint4*)(As + (ldr + 64) * 80 + ldc) = a1;
    *(uint4*)(Bs + ldr * 80 + ldc) = b0; *(uint4*)(Bs + (ldr + 64) * 80 + ldc) = b1;
  }
  __syncthreads();
  f32x4 acc[4][2];
#pragma unroll
  for (int i = 0; i < 4; ++i) { acc[i][0] = (f32x4){0.f, 0.f, 0.f, 0.f}; acc[i][1] = (f32x4){0.f, 0.f, 0.f, 0.f}; }
  const int nk = K >> 6;
  for (int kt = 0; kt < nk; ++kt) {
    const int cur = kt & 1;
    const int kn = (kt + 1 < nk) ? (kt + 1) : kt;
    const bf16* Apk = Ap + kn * 64; const bf16* Bpk = Bp + (size_t)kn * kstepB;
    u32x4 pa0 = gload16(Apk), pa1 = gload16(Apk + (size_t)64 * lda), pb0 = gload16(Bpk), pb1 = gload16(Bpk + (size_t)64 * ldb);
    __builtin_amdgcn_sched_barrier(0);
    const bf16* as = As + cur * 128 * 80 + (wr * 64 + lr) * 80 + lq * 8;
    const bf16* bs = Bs + cur * 128 * 80 + (wc * 32 + lr) * 80 + lq * 8;
#pragma unroll
    for (int ks = 0; ks < 2; ++ks) {
      bf16x8 a[4], b[2];
#pragma unroll
      for (int i = 0; i < 4; ++i) a[i] = *(const bf16x8*)(as + i * 16 * 80 + ks * 32);
#pragma unroll
      for (int i = 0; i < 2; ++i) b[i] = *(const bf16x8*)(bs + i * 16 * 80 + ks * 32);
#pragma unroll
      for (int mi = 0; mi < 4; ++mi)
#pragma unroll
        for (int ni = 0; ni < 2; ++ni) acc[mi][ni] = __builtin_amdgcn_mfma_f32_16x16x32_bf16(a[mi], b[ni], acc[mi][ni], 0, 0, 0);
    }
    __builtin_amdgcn_sched_barrier(0);
    {
      VMWAIT4(pa0, pa1, pb0, pb1);
      bf16* ad = As + (cur ^ 1) * 128 * 80 + ldr * 80 + ldc; bf16* bd = Bs + (cur ^ 1) * 128 * 80 + ldr * 80 + ldc;
      *(u32x4*)(ad) = pa0; *(u32x4*)(ad + 64 * 80) = pa1; *(u32x4*)(bd) = pb0; *(u32x4*)(bd + 64 * 80) = pb1;
    }
    __syncthreads();
  }
  float* Ct = (float*)smem;
#pragma unroll
  for (int mi = 0; mi < 4; ++mi)
#pragma unroll
    for (int ni = 0; ni < 2; ++ni)
#pragma unroll
      for (int j = 0; j < 4; ++j) Ct[(wr * 64 + mi * 16 + lq * 4 + j) * CT_LD + wc * 32 + ni * 16 + lr] = acc[mi][ni][j];
  __syncthreads();
}

#define CT16_LD 264
DEV void ld8h(const bf16* Ct, int r, int c, float* v) {
  const uint4 q = *(const uint4*)(Ct + r * CT16_LD + c);
  v[0] = __uint_as_float(q.x << 16); v[1] = __uint_as_float(q.x & 0xffff0000u); v[2] = __uint_as_float(q.y << 16); v[3] = __uint_as_float(q.y & 0xffff0000u);
  v[4] = __uint_as_float(q.z << 16); v[5] = __uint_as_float(q.z & 0xffff0000u); v[6] = __uint_as_float(q.w << 16); v[7] = __uint_as_float(q.w & 0xffff0000u);
}
DEV float ldh(const bf16* Ct, int r, int c) { return bf2f(Ct[r * CT16_LD + c]); }
DEV void ld8(const float* Ct, int r, int c, float* v) {
  float4 a = *(const float4*)(Ct + r * CT_LD + c), b = *(const float4*)(Ct + r * CT_LD + c + 4);
  v[0] = a.x; v[1] = a.y; v[2] = a.z; v[3] = a.w; v[4] = b.x; v[5] = b.y; v[6] = b.z; v[7] = b.w;
}

template <class F>
DEV void epi_transposed(const bf16* Ct, F dstrow, int tstride) {
  int tid = threadIdx.x; asm volatile("" : "+v"(tid));
#pragma unroll
  for (int i = 0; i < 4; ++i) {
    int idx = tid + 512 * i; int tcl = idx & 3, c = (idx >> 2) & 127, tch = idx >> 9; int tc = tch * 4 + tcl;
    unsigned hv[8];
#pragma unroll
    for (int e = 0; e < 8; ++e) hv[e] = Ct[(tc * 8 + e) * CT16_LD + c];
    uint4 ov; ov.x = hv[0] | (hv[1] << 16); ov.y = hv[2] | (hv[3] << 16); ov.z = hv[4] | (hv[5] << 16); ov.w = hv[6] | (hv[7] << 16);
    *(uint4*)(dstrow(c) + (size_t)(tc >> 3) * tstride + (tc & 7) * 8) = ov;
  }
}

DEV void epi_even(const Params& p, int mt, int nt, const bf16* Ct) {
  int tid = threadIdx.x; asm volatile("" : "+v"(tid));
  const int cg = tid & 15, rg = tid >> 4;
  unsigned char* ws = p.ws;
  const int m0 = mt * 128; const bool lat = m0 >= 8192;
  const int bseq = lat ? ((m0 - 8192) >> 10) : (m0 >> 8);
  const int t0 = lat ? ((m0 - 8192) & 1023) : (m0 & 255);
  int type; int cb;
  if (nt < 4) { type = 0; cb = nt * 128; } else if (nt < 8) { type = 1; cb = (nt - 4) * 128; } else if (nt < 16) { type = 2; cb = (nt - 8) * 128; }
  else if (nt < 24) { type = 3; cb = (nt - 16) * 128; } else if (nt < 28) { type = 4; cb = (nt - 24) * 128; } else if (nt == 28) { type = 5; cb = 0; } else { type = 6; cb = 0; }
  if (type == 2) {
    const int h = nt - 8;
    bf16* base = (bf16*)(ws + B_VRT) + (lat ? (size_t)8192 * 1024 + ((size_t)(bseq * 8 + h) * 16 + (t0 >> 6)) * 8192 : ((size_t)(bseq * 8 + h) * 4 + (t0 >> 6)) * 8192);
    epi_transposed(Ct, [&](int c) { return base + (size_t)c * 64; }, 8192);
  } else if (type == 6) {
    bf16* base = (bf16*)(ws + B_VAT) + (lat ? (size_t)32 * 2 * 64 * 256 : (size_t)0);
    const int ntk = lat ? 16 : 4;
    epi_transposed(Ct, [&](int c) { return base + ((size_t)(bseq * 2 + (c >> 6)) * ntk + (t0 >> 6)) * 4096 + (size_t)(c & 63) * 64; }, 4096);
    if (!lat) {
#pragma unroll
      for (int i = 0; i < 4; ++i) {
        const int r = rg + 32 * i; float v[8]; ld8h(Ct, r, cg * 8, v);
        const int kvh = cg >> 3, d0 = (cg & 7) * 8;
        float* o = p.out + O_GV + ((size_t)(bseq * 2 + kvh) * 256 + t0 + r) * 64 + d0;
        *(float4*)o = make_float4(v[0], v[1], v[2], v[3]); *(float4*)(o + 4) = make_float4(v[4], v[5], v[6], v[7]);
      }
    }
  } else {
    const int j0 = (cg * 8) & 63;
    if (type == 3 || ((type == 0 || type == 1) && !lat)) {
      bf16* dstc; size_t off; int rstride;
      if (type == 3) { dstc = (bf16*)(ws + B_GR); off = (size_t)m0 * 1024 + cb + cg * 8; rstride = 1024; }
      else { dstc = (bf16*)(ws + (type == 0 ? B_QR : B_KR)); off = ((size_t)(bseq * 8 + ((cb + cg * 8) >> 6)) * 256 + t0) * 64 + j0; rstride = 64; }
#pragma unroll
      for (int i = 0; i < 4; ++i) { const int r = rg + 32 * i; *(uint4*)(dstc + off + (size_t)r * rstride) = *(const uint4*)(Ct + r * CT16_LD + cg * 8); }
    } else {
    const float2* rope = (const float2*)(ws + OFF_ROPE);
    const bool dorope = lat && (type == 0 || type == 1 || type == 4 || type == 5);
    float gain[8], pgain[8];
#pragma unroll
    for (int e = 0; e < 8; ++e) { gain[e] = 1.f; pgain[e] = 1.f; }
    if (type == 4 || type == 5) {
      const float* gp = (type == 4) ? p.q_norm : p.k_norm;
#pragma unroll
      for (int e = 0; e < 8; ++e) { gain[e] = gp[j0 + e]; pgain[e] = gp[(j0 ^ 16) + e]; }
    }
    bf16* dst; int nh;
    if (type == 0) { dst = (bf16*)(ws + B_QR); nh = 8; } else if (type == 1) { dst = (bf16*)(ws + B_KR); nh = 8; }
    else if (type == 3) { dst = (bf16*)(ws + B_GR); nh = 0; } else if (type == 4) { dst = (bf16*)(ws + B_QA); nh = 8; } else { dst = (bf16*)(ws + B_KA); nh = 2; }
    const int hh = (cb + cg * 8) >> 6;
    const size_t hbase = lat ? (size_t)8192 * 64 * nh + ((size_t)(bseq * nh + hh) * 1024 + t0) * 64 : ((size_t)(bseq * nh + hh) * 256 + t0) * 64;
#pragma unroll
    for (int i = 0; i < 4; ++i) {
      const int r = rg + 32 * i; const int row = m0 + r;
      float v[8]; ld8h(Ct, r, cg * 8, v);
      float mul = 1.0f;
      if (type == 4 || type == 5) {
        float ss = 0.f;
#pragma unroll
        for (int e = 0; e < 8; ++e) ss += v[e] * v[e];
        ss += __shfl_xor(ss, 1); ss += __shfl_xor(ss, 2); ss += __shfl_xor(ss, 4);
        mul = rsqrtf(ss * (1.0f / 64.0f) + 1e-6f);
      }
#pragma unroll
      for (int e = 0; e < 8; ++e) v[e] *= mul * gain[e];
      if (type == 5 && !lat) {
        const int kvh = cg >> 3;
        float* o = p.out + O_GK + ((size_t)(bseq * 2 + kvh) * 256 + t0 + r) * 64 + j0;
        *(float4*)o = make_float4(v[0], v[1], v[2], v[3]); *(float4*)(o + 4) = make_float4(v[4], v[5], v[6], v[7]);
      }
      if (dorope) {
        float pv[8]; ld8h(Ct, r, (cg * 8) ^ 16, pv);
        const int t = t0 + r; const int pos = (j0 & 32) ? (t & 63) : (t >> 6); const int f0 = j0 & 15;
        const float sgn = (j0 & 16) ? 1.0f : -1.0f;
#pragma unroll
        for (int e = 0; e < 8; ++e) {
          float2 cs = rope[pos * 16 + f0 + e];
          float pe = pv[e] * mul * pgain[e];
          v[e] = v[e] * cs.x + sgn * pe * cs.y;
        }
      }
      if (nh) *(uint4*)(dst + hbase + (size_t)r * 64 + j0) = pack8(v);
      else *(uint4*)(dst + (size_t)row * 1024 + cb + cg * 8) = pack8(v);
    }
    }
    if (type == 1 && !lat) {
      const float* lg2 = (const float*)(ws + OFF_LG2);
      bf16* base = (bf16*)(ws + B_KTFB);
#pragma unroll
      for (int i = 0; i < 4; ++i) {
        int idx = tid + 512 * i; int tcl = idx & 3, c = (idx >> 2) & 127, tch = idx >> 9; int tc = tch * 4 + tcl;
        const int h = (nt - 4) * 2 + (c >> 6), d = c & 63;
        const float lgf = lg2[h], lgb = lg2[8 + h];
        float f[8], g[8];
#pragma unroll
        for (int e = 0; e < 8; ++e) {
          const int tt = t0 + tc * 8 + e; const float val = ldh(Ct, tc * 8 + e, c);
          f[e] = val * fexp2(lgf * (float)(255 - tt)); g[e] = val * fexp2(lgb * (float)tt);
        }
        bf16* o = base + (((size_t)(bseq * 8 + h) * 2) * 64 + d) * 256 + t0 + tc * 8;
        *(uint4*)o = pack8(f); *(uint4*)(o + 64 * 256) = pack8(g);
      }
    }
  }
}

DEV void epi_odd(const Params& p, int mt, int nt, const bf16* Ct) {
  int tid = threadIdx.x; asm volatile("" : "+v"(tid));
  const int cg = tid & 15, rg = tid >> 4;
  unsigned char* ws = p.ws;
  const int m0 = mt * 128; const bool lat = m0 >= 8192;
  const int bseq = lat ? ((m0 - 8192) >> 10) : (m0 >> 8);
  const int t0 = lat ? ((m0 - 8192) & 1023) : (m0 & 255);
  if (nt < 16) {
    bf16* dst = (bf16*)(ws + (nt < 8 ? B_Q : B_K));
    const int hh = (nt & 7) * 2 + (cg >> 3), dd0 = (cg & 7) * 8;
    const size_t hbase = lat ? (size_t)8192 * 1024 + ((size_t)(bseq * 16 + hh) * 1024 + t0) * 64 : ((size_t)(bseq * 16 + hh) * 256 + t0) * 64;
#pragma unroll
    for (int i = 0; i < 4; ++i) {
      const int r = rg + 32 * i;
      *(uint4*)(dst + hbase + (size_t)r * 64 + dd0) = *(const uint4*)(Ct + r * CT16_LD + cg * 8);
      if (nt >= 8 && !lat) {
        float v[8]; ld8h(Ct, r, cg * 8, v);
        const int h = (nt - 8) * 2 + (cg >> 3), d0 = (cg & 7) * 8;
        float* o = p.out + O_NK + ((size_t)(bseq * 16 + h) * 256 + t0 + r) * 64 + d0;
        *(float4*)o = make_float4(v[0], v[1], v[2], v[3]); *(float4*)(o + 4) = make_float4(v[4], v[5], v[6], v[7]);
      }
    }
  } else {
    const int h0 = (nt - 16) * 2;
    bf16* base = (bf16*)(ws + B_VT) + (lat ? (size_t)8192 * 1024 : (size_t)0);
    const int ntk = lat ? 16 : 4;
    epi_transposed(Ct, [&](int c) { return base + ((size_t)(bseq * 16 + h0 + (c >> 6)) * ntk + (t0 >> 6)) * 4096 + (size_t)(c & 63) * 64; }, 4096);
    if (!lat) {
#pragma unroll
      for (int i = 0; i < 4; ++i) {
        const int r = rg + 32 * i; float v[8]; ld8h(Ct, r, cg * 8, v);
        const int h = h0 + (cg >> 3), d0 = (cg & 7) * 8;
        float* o = p.out + O_NV + ((size_t)(bseq * 16 + h) * 256 + t0 + r) * 64 + d0;
        *(float4*)o = make_float4(v[0], v[1], v[2], v[3]); *(float4*)(o + 4) = make_float4(v[4], v[5], v[6], v[7]);
      }
    }
  }
}

DEV void epi_resid(const Params& p, int mt, int nt, const bf16* Ct, int l, int gi_, const float* xc, const float* xs) {
  int tid = threadIdx.x; asm volatile("" : "+v"(tid));
  const int cg = tid & 15, rg = tid >> 4;
  const bool ob = (gi_ & 16) != 0; const int gi = gi_ & 15;
  const int m0 = mt * 128; const int col = nt * 128 + cg * 8;
  const int crow = m0 < 8192 ? 8 : ((m0 - 8192) >> 10);
  const float* gp = (const float*)(p.ws + OFF_MOD) + (size_t)(l * 9 + crow) * 6144 + gi * 1024 + col;
  const float4 g0 = *(const float4*)gp, g1 = *(const float4*)(gp + 4);
  bf16* xb = (bf16*)(p.ws + B_XB);
#pragma unroll
  for (int i = 0; i < 4; ++i) {
    const int r = rg + 32 * i; const int row = m0 + r; float v[8]; ld8h(Ct, r, cg * 8, v);
    float x[8];
    if (xc) {
      const float* xp = (row < 8192 ? xc + (size_t)row * 1024 : xs + (size_t)(row - 8192) * 1024) + col;
      const float4 a = *(const float4*)xp, b = *(const float4*)(xp + 4);
      x[0] = a.x; x[1] = a.y; x[2] = a.z; x[3] = a.w; x[4] = b.x; x[5] = b.y; x[6] = b.z; x[7] = b.w;
    } else {
      const uint4 q = *(const uint4*)(xb + (size_t)row * 1024 + col);
      x[0] = __uint_as_float(q.x << 16); x[1] = __uint_as_float(q.x & 0xffff0000u); x[2] = __uint_as_float(q.y << 16); x[3] = __uint_as_float(q.y & 0xffff0000u);
      x[4] = __uint_as_float(q.z << 16); x[5] = __uint_as_float(q.z & 0xffff0000u); x[6] = __uint_as_float(q.w << 16); x[7] = __uint_as_float(q.w & 0xffff0000u);
    }
    x[0] += g0.x * v[0]; x[1] += g0.y * v[1]; x[2] += g0.z * v[2]; x[3] += g0.w * v[3];
    x[4] += g1.x * v[4]; x[5] += g1.y * v[5]; x[6] += g1.z * v[6]; x[7] += g1.w * v[7];
    if (ob) *(uint4*)(xb + (size_t)row * 1024 + col) = pack8(x);
    else {
      float* o = p.out + (size_t)row * 1024 + col;
      *(float4*)o = make_float4(x[0], x[1], x[2], x[3]);
      *(float4*)(o + 4) = make_float4(x[4], x[5], x[6], x[7]);
    }
  }
}

DEV void epi_ffn_up_unit(const Params& p, int pm, int pn, const bf16* Ct, int l) {
  int tid = threadIdx.x; asm volatile("" : "+v"(tid));
  const int cgp = tid & 15, rgp = tid >> 4;
  const int bj = cgp >> 3, j0 = (cgp & 7) * 8;
  const int ca = bj * 128 + j0;
  const int oc = (2 * pn + bj) * 64 + j0;
  const bool lat = pm >= 32;
  const bool firstu = !lat || ((pm & 3) == 0), lastu = !lat || ((pm & 3) == 3);
  const float* cw = p.conv_w + (size_t)l * 3 * 5632; const float* cbp = p.conv_b + (size_t)l * 5632;
  float wa0[8], wa1[8], wa2[8], wab[8], wg0[8], wg1[8], wg2[8], wgb[8];
#pragma unroll
  for (int e = 0; e < 8; ++e) {
    wa0[e] = cw[oc + e]; wa1[e] = cw[5632 + oc + e]; wa2[e] = cw[2 * 5632 + oc + e]; wab[e] = cbp[oc + e];
    wg0[e] = cw[2816 + oc + e]; wg1[e] = cw[5632 + 2816 + oc + e]; wg2[e] = cw[2 * 5632 + 2816 + oc + e]; wgb[e] = cbp[2816 + oc + e];
  }
  bf16* act = (bf16*)(p.ws + B_ACT);
  const int r0 = rgp * 8;
  float ap[8], ac[8], an[8], gp[8], gc[8], gn[8];
  if (r0 > 0) { ld8h(Ct, r0 - 1, ca, ap); ld8h(Ct, r0 - 1, ca + 64, gp); }
  else {
#pragma unroll
    for (int e = 0; e < 8; ++e) { ap[e] = 0.f; gp[e] = 0.f; }
  }
  ld8h(Ct, r0, ca, ac); ld8h(Ct, r0, ca + 64, gc);
#pragma unroll
  for (int i = 0; i < 8; ++i) {
    const int r = r0 + i;
    if (r < 255) { ld8h(Ct, r + 1, ca, an); ld8h(Ct, r + 1, ca + 64, gn); }
    else {
#pragma unroll
      for (int e = 0; e < 8; ++e) { an[e] = 0.f; gn[e] = 0.f; }
    }
    const bool skip = (r == 0 && !firstu) || (r == 255 && !lastu);
    if (!skip) {
      float res[8];
#pragma unroll
      for (int e = 0; e < 8; ++e) {
        const float a = wab[e] + wa0[e] * ap[e] + wa1[e] * ac[e] + wa2[e] * an[e];
        const float g = wgb[e] + wg0[e] * gp[e] + wg1[e] * gc[e] + wg2[e] * gn[e];
        res[e] = silu_f(a) * g;
      }
      *(uint4*)(act + (size_t)(pm * 256 + r) * 2816 + oc) = pack8(res);
    }
#pragma unroll
    for (int e = 0; e < 8; ++e) { ap[e] = ac[e]; ac[e] = an[e]; gp[e] = gc[e]; gc[e] = gn[e]; }
  }
  if (lat) {
    float* halo = (float*)(p.ws + B_HALO);
    for (int idx = tid; idx < 1024; idx += 512) {
      const int hr = idx >> 8, c = idx & 255; const int r = (hr < 2) ? hr : 252 + hr;
      halo[((size_t)(pm * 4 + hr)) * 5632 + pn * 256 + c] = ldh(Ct, r, c);
    }
  }
}

DEV void ffn_seam_rows(const Params& p, int l, int pm) {
  if (pm < 32) return;
  int tid = threadIdx.x; asm volatile("" : "+v"(tid));
  const float* cw = p.conv_w + (size_t)l * 3 * 5632; const float* cbp = p.conv_b + (size_t)l * 5632;
  const float* halo = (const float*)(p.ws + B_HALO);
  bf16* act = (bf16*)(p.ws + B_ACT);
#pragma unroll 1
  for (int which = 0; which < 2; ++which) {
    if (which == 0 ? ((pm & 3) == 0) : ((pm & 3) == 3)) continue;
    const float *up, *uc, *un; int row;
    if (which == 0) { up = halo + (size_t)((pm - 1) * 4 + 3) * 5632; uc = halo + (size_t)(pm * 4 + 0) * 5632; un = halo + (size_t)(pm * 4 + 1) * 5632; row = pm * 256; }
    else { up = halo + (size_t)(pm * 4 + 2) * 5632; uc = halo + (size_t)(pm * 4 + 3) * 5632; un = halo + (size_t)((pm + 1) * 4 + 0) * 5632; row = pm * 256 + 255; }
    for (int j = tid; j < 2816; j += 512) {
      const int ca = (j >> 6) * 128 + (j & 63), cgi = ca + 64;
      const float a = cbp[j] + cw[j] * up[ca] + cw[5632 + j] * uc[ca] + cw[2 * 5632 + j] * un[ca];
      const float g = cbp[2816 + j] + cw[2816 + j] * up[cgi] + cw[5632 + 2816 + j] * uc[cgi] + cw[2 * 5632 + 2816 + j] * un[cgi];
      act[(size_t)row * 2816 + j] = f2bf(silu_f(a) * g);
    }
  }
  asm volatile("s_waitcnt vmcnt(0)" ::: "memory");
  __syncthreads();
}

DEV void epi_state(const Params& p, int b, int h, const float* Ct) {
  int tid = threadIdx.x; asm volatile("" : "+v"(tid)); const int cg = tid & 15, rg = tid >> 4;
#pragma unroll 1
  for (int i = 0; i < 4; ++i) {
    const int r = rg + 32 * i; float v[8]; ld8(Ct, r, cg * 8, v);
    float* o = p.out + (r < 64 ? O_SF : O_SB) + ((size_t)(b * 8 + h) * 64 + (r & 63)) * 128 + cg * 8;
    *(float4*)o = make_float4(v[0], v[1], v[2], v[3]); *(float4*)(o + 4) = make_float4(v[4], v[5], v[6], v[7]);
  }
  __syncthreads();
}

namespace pg8 {
#define PG8_LAS __attribute__((address_space(3)))
typedef unsigned short bf16_t;
typedef short bf16x8 __attribute__((ext_vector_type(8)));
typedef float f32x4 __attribute__((ext_vector_type(4)));
typedef unsigned u32x4 __attribute__((ext_vector_type(4)));
constexpr int BM = 256, BK = 64, HALF = 128, HTB = HALF * BK * 2  , STAGE_BYTES = 8 * HTB, NXCD = 8, WGM = 8;

__host__ __device__ __forceinline__ int lds_byte(int r, int c) { const int st = (r >> 4) * 2 + (c >> 5), rr = r & 15, cc = c & 31, ob = rr * 64 + cc * 2; return st * 1024 + (ob ^ (((ob >> 9) & 1) << 5)); }
__host__ __device__ __forceinline__ void stage_rc(int b, int& R, int& C) { const int st = b / 1024, sb = b % 1024, swz = sb ^ (((sb >> 9) & 1) << 5); R = (st >> 1) * 16 + swz / 64; C = (st & 1) * 32 + (swz % 64) / 2; }
__host__ __device__ __forceinline__ int perm32(int rho) { const int n = rho >> 4, i = rho & 15; return 8 * (i >> 2) + 4 * n + (i & 3); }

struct Unit { int pm, pn; };
struct Gemm { const bf16_t* A; const bf16_t* Bt; int M, N, K; };

struct StaticOrder {
    int nM, nN, nwg, G, c;
    __host__ __device__ void init(int M, int N, int G_, int c_) { nM = M / BM; nN = N / BM; nwg = nM * nN; G = G_; c = c_; }
    __host__ __device__ bool next(int i, Unit& u) const {
        const long L = (long)i * G + c; if (L >= nwg) return false;
        int wgid = (int)L; { const int q = nwg / NXCD, r = nwg % NXCD, xcd = wgid % NXCD, off = wgid / NXCD; wgid = (xcd < r ? xcd * (q + 1) : r * (q + 1) + (xcd - r) * q) + off; }
        const int nig = WGM * nN, gid = wgid / nig, fm = gid * WGM, gsz = (nM - fm) < WGM ? (nM - fm) : WGM;
        u.pm = fm + ((wgid % nig) % gsz); u.pn = (wgid % nig) / gsz; return true;
    }
    __device__ __forceinline__ void a_ready(const Unit&) const {}
    __device__ __forceinline__ void done(const Unit&) const {}
};
template <class Epi, class Sched, bool STAMP = false>
__device__ __forceinline__ void gemm_phase(PG8_LAS unsigned char* lds, const Gemm g, const Sched& S, const Epi& E, unsigned long long* stamps) {
    int tid = threadIdx.x; asm volatile("" : "+v"(tid)); const int wid = __builtin_amdgcn_readfirstlane(tid >> 6), lane = tid & 63, wr = wid >> 2, wc = wid & 3, fr = lane & 15, fq = lane >> 4;
    const int K = g.K, nt = K / BK;
    int ts_lo = 0, ts_hi = 0, nts = 0; const unsigned long long rt_entry = STAMP ? (unsigned long long)wall_clock64() : 0ull;
#define PG8_STAMP() do { if (STAMP && wid == 0 && nts < 64) { const unsigned long long _c = (unsigned long long)clock64(); \
        ts_lo = (lane == nts) ? (int)(unsigned)_c : ts_lo; ts_hi = (lane == nts) ? (int)(unsigned)(_c >> 32) : ts_hi; ++nts; } } while (0)
    PG8_STAMP();
    unsigned voffA[2], voffB[2];
#pragma unroll
    for (int i = 0; i < 2; ++i) { int R, C; stage_rc(tid * 16 + i * 8192, R, C); const int Rb = Epi::PERM ? ((R & ~31) + perm32(R & 31)) : R;
        voffA[i] = (unsigned)(R * K + C) * 2u; voffB[i] = (unsigned)(Rb * K + C) * 2u; }
    const size_t kstep = (size_t)(BK * 2);
    const size_t hstep = (size_t)HALF * K * 2;
    const size_t tstep = 2 * hstep;
    const unsigned ldsw = (unsigned)wid * 1024u;
    const int aoff = lds_byte(wr * 64 + fr, fq * 8), boff = lds_byte(wc * 32 + fr, fq * 8);
#define PG8_SA(b, h) (((b) * 2 + (h)) * HTB)
#define PG8_SB(b, h) ((4 + (b) * 2 + (h)) * HTB)
#define PG8_STAGE(bufoff, gbase, voff) do { _Pragma("unroll") for (int _i = 0; _i < 2; ++_i) \
        __builtin_amdgcn_global_load_lds((const unsigned*)((const char*)(gbase) + (voff)[_i]), (PG8_LAS unsigned*)(lds + (bufoff) + ldsw + _i * 8192), 16, 0, 0); } while (0)
#define PG8_LDA(dst, b, h) do { _Pragma("unroll") for (int m = 0; m < 4; ++m) _Pragma("unroll") for (int k = 0; k < 2; ++k) dst[m][k] = *(const PG8_LAS bf16x8*)(lds + PG8_SA(b, h) + aoff + m * 2048 + k * 1024); } while (0)
#define PG8_LDB(dst, b, h) do { _Pragma("unroll") for (int n = 0; n < 2; ++n) _Pragma("unroll") for (int k = 0; k < 2; ++k) dst[n][k] = *(const PG8_LAS bf16x8*)(lds + PG8_SB(b, h) + boff + n * 2048 + k * 1024); } while (0)
#define PG8_MMA(ai, bj, At, Bt) do { __builtin_amdgcn_s_setprio(1); _Pragma("unroll") for (int m = 0; m < 4; ++m) _Pragma("unroll") for (int n = 0; n < 2; ++n) _Pragma("unroll") for (int k = 0; k < 2; ++k) \
        acc[ai][bj][m][n] = __builtin_amdgcn_mfma_f32_16x16x32_bf16(Bt[n][k], At[m][k], acc[ai][bj][m][n], 0, 0, 0); __builtin_amdgcn_s_setprio(0); } while (0)
#define PG8_WAIT_V(n) asm volatile("s_waitcnt vmcnt(" #n ")" ::: "memory")
#define PG8_WAIT_L(n) asm volatile("s_waitcnt lgkmcnt(" #n ")" ::: "memory")
#define PG8_BAR __builtin_amdgcn_s_barrier()
#define PG8_SCHED __builtin_amdgcn_sched_barrier(0)
    Unit cur, nxt; int ui = 0;
    if (!S.next(0, cur)) return;
    f32x4 acc[2][2][4][2];
#pragma unroll
    for (int a = 0; a < 2; ++a)
#pragma unroll
        for (int b = 0; b < 2; ++b)
#pragma unroll
            for (int m = 0; m < 4; ++m)
#pragma unroll
                for (int n = 0; n < 2; ++n) acc[a][b][m][n] = (f32x4){0.f, 0.f, 0.f, 0.f};
    bf16x8 At[4][2], B0[2][2], B1[2][2];
    const char* cA = (const char*)g.A + (size_t)cur.pm * tstep; const char* cB = (const char*)g.Bt + (size_t)cur.pn * tstep;
    S.a_ready(cur);
    PG8_STAGE(PG8_SB(0, 0), cB, voffB); PG8_STAGE(PG8_SA(0, 0), cA, voffA); PG8_STAGE(PG8_SB(0, 1), cB + hstep, voffB); PG8_STAGE(PG8_SA(0, 1), cA + hstep, voffA);
    if (wr == 1) PG8_BAR;
    PG8_WAIT_V(4); PG8_BAR;
    PG8_STAGE(PG8_SB(1, 0), cB + kstep, voffB); PG8_STAGE(PG8_SA(1, 0), cA + kstep, voffA); PG8_STAGE(PG8_SB(1, 1), cB + hstep + kstep, voffB);
    PG8_WAIT_V(6); PG8_BAR;
    PG8_STAMP();
    for (;;) {
        const bool has_next = S.next(ui + 1, nxt);
        const char* nA = has_next ? (const char*)g.A + (size_t)nxt.pm * tstep : cA; const char* nB = has_next ? (const char*)g.Bt + (size_t)nxt.pn * tstep : cB;
        for (int t = 0; t < nt; t += 2) {
            const bool last = (t == nt - 2);
            const char* a1 = cA + (size_t)(t + 1) * kstep;
            const char* a2 = last ? nA : cA + (size_t)(t + 2) * kstep; const char* b2 = last ? nB : cB + (size_t)(t + 2) * kstep;
            const char* a3 = a2 + kstep; const char* b3 = b2 + kstep;
            if (last && has_next) S.a_ready(nxt);
            PG8_LDB(B0, 0, 0); PG8_SCHED; PG8_LDA(At, 0, 0); PG8_STAGE(PG8_SA(1, 1), a1 + hstep, voffA);
            PG8_WAIT_L(8); PG8_BAR; PG8_WAIT_L(0); PG8_MMA(0, 0, At, B0); PG8_BAR; PG8_SCHED;
            PG8_LDB(B1, 0, 1); PG8_STAGE(PG8_SB(0, 0), b2, voffB);
            PG8_BAR; PG8_WAIT_L(0); PG8_MMA(0, 1, At, B1); PG8_BAR;
            PG8_LDA(At, 0, 1); PG8_STAGE(PG8_SA(0, 0), a2, voffA);
            PG8_BAR; PG8_WAIT_L(0); PG8_MMA(1, 0, At, B0); PG8_BAR; PG8_SCHED;
            PG8_STAGE(PG8_SB(0, 1), b2 + hstep, voffB);
            PG8_WAIT_V(6); PG8_BAR; PG8_MMA(1, 1, At, B1); PG8_BAR;
            PG8_LDB(B0, 1, 0); PG8_SCHED; PG8_LDA(At, 1, 0); PG8_STAGE(PG8_SA(0, 1), a2 + hstep, voffA);
            PG8_WAIT_L(8); PG8_BAR; PG8_WAIT_L(0); PG8_MMA(0, 0, At, B0); PG8_BAR; PG8_SCHED;
            PG8_LDB(B1, 1, 1); PG8_STAGE(PG8_SB(1, 0), b3, voffB);
            PG8_BAR; PG8_WAIT_L(0); PG8_MMA(0, 1, At, B1); PG8_BAR;
            PG8_LDA(At, 1, 1); PG8_STAGE(PG8_SA(1, 0), a3, voffA);
            PG8_BAR; PG8_WAIT_L(0); PG8_MMA(1, 0, At, B0); PG8_BAR; PG8_SCHED;
            PG8_STAGE(PG8_SB(1, 1), b3 + hstep, voffB);
            PG8_WAIT_V(6); PG8_BAR; PG8_MMA(1, 1, At, B1); PG8_BAR;
        }
        PG8_STAMP();
        if constexpr (!Epi::AFTER_DRAIN) { E(acc, cur, wr, wc, fr, fq); S.done(cur); }
        PG8_STAMP();
        if (!has_next) break;
#pragma unroll
        for (int a = 0; a < 2; ++a)
#pragma unroll
            for (int b = 0; b < 2; ++b)
#pragma unroll
                for (int m = 0; m < 4; ++m)
#pragma unroll
                    for (int n = 0; n < 2; ++n) acc[a][b][m][n] = (f32x4){0.f, 0.f, 0.f, 0.f};
        cur = nxt; cA = nA; cB = nB; ++ui;
    }
    PG8_WAIT_V(0);
    if (wr == 0) PG8_BAR;
    PG8_BAR;
    if constexpr (Epi::AFTER_DRAIN) { E.fused(acc, cur, wr, wc, fr, fq, lds, wid, lane); S.done(cur); }
    PG8_STAMP();
    if (STAMP && wid == 0) { stamps[lane] = lane < nts ? (((unsigned long long)(unsigned)ts_hi << 32) | (unsigned)ts_lo) : 0ull;
        if (lane == 62) stamps[62] = rt_entry; if (lane == 63) stamps[63] = (unsigned long long)wall_clock64(); }
#undef PG8_STAMP
#undef PG8_SA
#undef PG8_SB
#undef PG8_STAGE
#undef PG8_LDA
#undef PG8_LDB
#undef PG8_MMA
#undef PG8_WAIT_V
#undef PG8_WAIT_L
#undef PG8_BAR
#undef PG8_SCHED
}
}

struct OneUnit {
  pg8::Unit u;
  DEV bool next(int i, pg8::Unit& o) const { if (i != 0) return false; o = u; return true; }
  DEV void a_ready(const pg8::Unit&) const {}
  DEV void done(const pg8::Unit&) const {}
};
template <int EPI>
struct EpiStage {
  static constexpr bool PERM = false, AFTER_DRAIN = true;
  const Params* p; unsigned char* smem; int l, gi; const float* xc; const float* xs;
  const bf16* A; const bf16* B; int K, npm, npn;
  DEV void fused(pg8::f32x4 (&acc)[2][2][4][2], const pg8::Unit& u, int wr, int wc, int fr, int fq, PG8_LAS unsigned char* lds, int wid, int lane) const {
    unsigned pf0 = 0u, pf1 = 0u;
    if (npm >= 0) {
      const int t_ = threadIdx.x;
      const bf16* pa = A + ((size_t)(npm * 256 + (t_ >> 1)) * K + (t_ & 1) * 64);
      const bf16* pb = B + ((size_t)(npn * 256 + (t_ >> 1)) * K + (t_ & 1) * 64);
      asm volatile("global_load_dword %0, %1, off" : "=v"(pf0) : "v"(pa) : "memory");
      asm volatile("global_load_dword %0, %1, off" : "=v"(pf1) : "v"(pb) : "memory");
    }
    bf16* Ct = (bf16*)smem;
    int ctoff = (wr * 64 + fr) * CT16_LD + wc * 32 + fq * 4; asm volatile("" : "+v"(ctoff));
#pragma unroll
    for (int ai = 0; ai < 2; ++ai)
#pragma unroll
      for (int bj = 0; bj < 2; ++bj)
#pragma unroll
        for (int m = 0; m < 4; ++m)
#pragma unroll
          for (int n = 0; n < 2; ++n) {
            uint2 pk; pk.x = pack2(acc[ai][bj][m][n][0], acc[ai][bj][m][n][1]); pk.y = pack2(acc[ai][bj][m][n][2], acc[ai][bj][m][n][3]);
            *(uint2*)(Ct + ctoff + (ai * 128 + m * 16) * CT16_LD + bj * 128 + n * 16) = pk;
          }
    __syncthreads();
    if (EPI == 3) epi_ffn_up_unit(*p, u.pm, u.pn, Ct, l);
    else
#pragma unroll 1
    for (int q = 0; q < 4; ++q) {
      const int ai = q >> 1, bj = q & 1;
      const int mt = 2 * u.pm + ai, nt = 2 * u.pn + bj;
      const bf16* Cq = Ct + ai * 128 * CT16_LD + bj * 128;
      if (EPI == 0) epi_even(*p, mt, nt, Cq);
      else if (EPI == 1) epi_odd(*p, mt, nt, Cq);
      else epi_resid(*p, mt, nt, Cq, l, gi, xc, xs);
    }
    asm volatile("s_waitcnt vmcnt(0)" : "+v"(pf0), "+v"(pf1) : : "memory");
    __syncthreads();
  }
};

template <int EPI>
DEV void gemm_phase(const Params& p, const bf16* A, const bf16* B, int K, int N, int l, int gi, const float* xc, const float* xs, unsigned char* smem) {
  pg8::StaticOrder so; so.init(16384, N, (int)gridDim.x, (int)blockIdx.x);
  pg8::Gemm g; g.A = A; g.Bt = B; g.M = 16384; g.N = N; g.K = K;
  EpiStage<EPI> E; E.p = &p; E.smem = smem; E.l = l; E.gi = gi; E.xc = xc; E.xs = xs; E.A = A; E.B = B; E.K = K;
  for (int it = 0;; ++it) {
    OneUnit S;
    if (!so.next(it, S.u)) break;
    if (EPI == 2 && K == 2816) ffn_seam_rows(p, l, S.u.pm);
    { pg8::Unit nu; if (so.next(it + 1, nu)) { E.npm = nu.pm; E.npn = nu.pn; } else { E.npm = -1; E.npn = -1; } }
    pg8::gemm_phase<EpiStage<EPI>, OneUnit, false>((PG8_LAS unsigned char*)smem, g, S, E, nullptr);
  }
  if (EPI == 0) p0_weight_tail(p, 0, 64 * (N / 256), smem);
  if (EPI == 3 && l == 0) p0_weight_tail(p, 1, 64 * (N / 256), smem);
}

struct AttnArgs {
  const bf16* q; int ldq;
  const bf16* k0; const bf16* vt0; int ldk0, ldvt0, n0;
  const bf16* k1; const bf16* vt1; int ldk1, ldvt1, n1;
  const bf16* vt2; int ldvt2, n2;
  float scale;
  int qpos0, seqN; float lgf, lgb;
  int r0, lo;
  bf16* out; int ldo;
  const bf16* gr; const float* gn; int tok0; int h;
};


#define KLD 80
#define VLD 76
struct AttRegs { u32x4 k0, v0, v1; int ident; };
template <int NV>
DEV void att_load(const AttnArgs& a, int ti, int tid8, AttRegs& R) {
  const bf16* kp; const bf16* vp;
  if (ti < a.n0) { kp = a.k0 + (size_t)ti * 4096; vp = a.vt0 + (size_t)ti * (NV * 4096); }
  else if (ti < a.n0 + a.n1) { const int j = ti - a.n0; kp = a.k1 ? a.k1 + (size_t)j * 4096 : (const bf16*)0; vp = a.vt1 + (size_t)j * (NV * 4096); }
  else { const int j = ti - a.n0 - a.n1; kp = (const bf16*)0; vp = a.vt2 + (size_t)j * (NV * 4096); }
  R.ident = (kp == (const bf16*)0) ? 1 : 0;
  const bf16* ksrc = kp ? kp + tid8 : vp + tid8;
  R.k0 = gload16(ksrc);
  R.v0 = gload16(vp + tid8);
  if (NV > 1) R.v1 = gload16(vp + tid8 + 4096);
}
template <int DV, int NV, int WAITN>
DEV void att_store(bf16* Ks, bf16* Vs, int buf, int krow, int kch, AttRegs& R) {
  if (NV > 1) asm volatile("s_waitcnt vmcnt(%3)" : "+v"(R.k0), "+v"(R.v0), "+v"(R.v1) : "n"(WAITN) : "memory");
  else asm volatile("s_waitcnt vmcnt(%2)" : "+v"(R.k0), "+v"(R.v0) : "n"(WAITN) : "memory");
  u32x4 kv = R.k0;
  if (R.ident) {
    const int d = krow - kch * 8; const unsigned one = (d & 1) ? 0x3F800000u : 0x00003F80u; const bool in = (d >= 0 && d < 8);
    kv.x = (in && (d >> 1) == 0) ? one : 0u; kv.y = (in && (d >> 1) == 1) ? one : 0u; kv.z = (in && (d >> 1) == 2) ? one : 0u; kv.w = (in && (d >> 1) == 3) ? one : 0u;
  }
  *(u32x4*)(Ks + buf * 64 * KLD + krow * KLD + kch * 8) = kv;
  bf16* vd = Vs + buf * DV * VLD + krow * VLD + kch * 8;
  { uint2 lo, hi; lo.x = R.v0.x; lo.y = R.v0.y; hi.x = R.v0.z; hi.y = R.v0.w; *(uint2*)(vd) = lo; *(uint2*)(vd + 4) = hi; }
  if (NV > 1) { uint2 lo, hi; lo.x = R.v1.x; lo.y = R.v1.y; hi.x = R.v1.z; hi.y = R.v1.w; *(uint2*)(vd + 64 * VLD) = lo; *(uint2*)(vd + 64 * VLD + 4) = hi; }
}

template <int V> struct IntTag { static constexpr int value = V; };
DEV void store_pair16(bf16* rowp  , int lq, uint2 ve, uint2 vo) {
  const bool odd = (lq & 1) != 0;
  uint2 snd = odd ? ve : vo, rcv;
  rcv.x = (unsigned)__shfl_xor((int)snd.x, 16); rcv.y = (unsigned)__shfl_xor((int)snd.y, 16);
  uint4 q;
  if (!odd) { q.x = ve.x; q.y = ve.y; q.z = rcv.x; q.w = rcv.y; }
  else { q.x = rcv.x; q.y = rcv.y; q.z = vo.x; q.w = vo.y; }
  *(uint4*)(rowp + (odd ? 16 : 0) + (lq & ~1) * 4) = q;
}
template <int DV, int MODE>
DEV void attn_item(const AttnArgs& a, unsigned char* smem, const float* rpbs) {
  constexpr int NB = DV / 16, NV = DV / 64;
  int tid = threadIdx.x; asm volatile("" : "+v"(tid)); const int lane = tid & 63, w = __builtin_amdgcn_readfirstlane(tid >> 6), lr = lane & 15, lq = lane >> 4;
  bf16* Ks = (bf16*)smem;
  bf16* Vs = Ks + 2 * 64 * KLD;
  const int ntiles = a.n0 + a.n1 + a.n2;
  bf16x8 qf[2][2];
#pragma unroll
  for (int rb = 0; rb < 2; ++rb)
#pragma unroll
    for (int ds = 0; ds < 2; ++ds) qf[rb][ds] = *(const bf16x8*)(a.q + (size_t)(w * 32 + rb * 16 + lr) * a.ldq + ds * 32 + lq * 8);
  f32x4 o[NB][2];
#pragma unroll
  for (int nb = 0; nb < NB; ++nb) { o[nb][0] = (f32x4){0.f, 0.f, 0.f, 0.f}; o[nb][1] = (f32x4){0.f, 0.f, 0.f, 0.f}; }
  float mrow[2] = {-1e30f, -1e30f}, lrow[2] = {0.f, 0.f};
  float cff[4][4], cfb[4][4];
  if (MODE == 2) {
#pragma unroll
    for (int kb = 0; kb < 4; ++kb)
#pragma unroll
      for (int j = 0; j < 4; ++j) { const float mm = (float)(kb * 16 + lq * 4 + j); cff[kb][j] = fexp2(-a.lgf * mm); cfb[kb][j] = fexp2(a.lgb * mm); }
  }
  AttRegs R0, R1;
  R0.v1 = (u32x4){0u, 0u, 0u, 0u}; R1.v1 = R0.v1;
  const int krow = tid >> 3, kch = tid & 7;
  constexpr int NL = 1 + NV;

  att_load<NV>(a, 0, tid * 8, R0);
  att_store<DV, NV, 0>(Ks, Vs, 0, krow, kch, R0);
  att_load<NV>(a, (1 < ntiles) ? 1 : 0, tid * 8, R0);
  __syncthreads();
  auto step = [&](const int ti, const int cur, AttRegs& Rl, AttRegs& Rs) {
    att_load<NV>(a, (ti + 2 < ntiles) ? (ti + 2) : (ntiles - 1), tid * 8, Rl);
    __builtin_amdgcn_sched_barrier(0);
    bool active = true;
    const int myrow = a.r0 + (w >> 1);
    int rs_ = myrow - 4; rs_ = rs_ < 0 ? 0 : (rs_ > 8 ? 8 : rs_);
    const int kr = a.lo + ti;
    if (MODE == 1 && ti < a.n0) active = (kr >= rs_ && kr < rs_ + 8);
    if (active) {
      const bf16* ks = Ks + cur * 64 * KLD + lr * KLD + lq * 8;
      f32x4 s[4][2];
      {
        bf16x8 kf[2][4];
#pragma unroll
        for (int ds = 0; ds < 2; ++ds)
#pragma unroll
          for (int kb = 0; kb < 4; ++kb) kf[ds][kb] = *(const bf16x8*)(ks + kb * 16 * KLD + ds * 32);
        __builtin_amdgcn_sched_barrier(0);
        __builtin_amdgcn_s_setprio(1);
#pragma unroll
        for (int kb = 0; kb < 4; ++kb) {
          s[kb][0] = __builtin_amdgcn_mfma_f32_16x16x32_bf16(kf[0][kb], qf[0][0], (f32x4){0.f, 0.f, 0.f, 0.f}, 0, 0, 0);
          s[kb][1] = __builtin_amdgcn_mfma_f32_16x16x32_bf16(kf[0][kb], qf[1][0], (f32x4){0.f, 0.f, 0.f, 0.f}, 0, 0, 0);
        }
#pragma unroll
        for (int kb = 0; kb < 4; ++kb) {
          s[kb][0] = __builtin_amdgcn_mfma_f32_16x16x32_bf16(kf[1][kb], qf[0][1], s[kb][0], 0, 0, 0);
          s[kb][1] = __builtin_amdgcn_mfma_f32_16x16x32_bf16(kf[1][kb], qf[1][1], s[kb][1], 0, 0, 0);
        }
        __builtin_amdgcn_s_setprio(0);
      }
      if (MODE == 2) {
        const int nq0 = a.qpos0 + w * 32, t0 = ti * 64;
        if (ti >= a.n0) {
#pragma unroll
          for (int rb = 0; rb < 2; ++rb) {
            const int n = nq0 + rb * 16 + lr;
            const float fac = (ti < a.n0 + a.n1) ? fexp2(a.lgf * (float)(n + 1)) : fexp2(a.lgb * (float)(a.seqN - n));
#pragma unroll
            for (int kb = 0; kb < 4; ++kb)
#pragma unroll
              for (int j = 0; j < 4; ++j) s[kb][rb][j] *= fac;
          }
        } else if (t0 + 63 < nq0) {
#pragma unroll
          for (int rb = 0; rb < 2; ++rb) {
            const float rf = fexp2(a.lgf * (float)(nq0 + rb * 16 + lr - t0));
#pragma unroll
            for (int kb = 0; kb < 4; ++kb)
#pragma unroll
              for (int j = 0; j < 4; ++j) s[kb][rb][j] *= rf * cff[kb][j];
          }
        } else if (t0 > nq0 + 31) {
#pragma unroll
          for (int rb = 0; rb < 2; ++rb) {
            const float rf = fexp2(a.lgb * (float)(t0 - (nq0 + rb * 16 + lr)));
#pragma unroll
            for (int kb = 0; kb < 4; ++kb)
#pragma unroll
              for (int j = 0; j < 4; ++j) s[kb][rb][j] *= rf * cfb[kb][j];
          }
        } else {
#pragma unroll
          for (int rb = 0; rb < 2; ++rb) {
            const int n = nq0 + rb * 16 + lr;
#pragma unroll
            for (int kb = 0; kb < 4; ++kb)
#pragma unroll
              for (int j = 0; j < 4; ++j) {
                const int m = t0 + kb * 16 + lq * 4 + j; const int d = n - m;
                const float fac = d > 0 ? fexp2(a.lgf * (float)d) : (d < 0 ? fexp2(a.lgb * (float)(-d)) : 2.0f);
                s[kb][rb][j] *= fac;
              }
          }
        }
      } else {
        auto softmax_tile = [&](auto wv_tag) {
          constexpr int WV = decltype(wv_tag)::value;
#define KB_USED(kb_, rb_) (WV == 0 || (WV == 1 ? ((kb_) <= 1 + (rb_)) : ((kb_) >= 1 + (rb_))))
          if (WV != 0) {
#pragma unroll
            for (int rb = 0; rb < 2; ++rb) {
              const int c = (w & 1) * 32 + rb * 16 + lr;
              int cs = c - 8; cs = cs < 0 ? 0 : (cs > 48 ? 48 : cs);
              const float* bp = rpbs + (kr - myrow + 7) * 31 + (15 - c);
#pragma unroll
              for (int kb = 0; kb < 4; ++kb) {
                if (!KB_USED(kb, rb)) continue;
#pragma unroll
                for (int j = 0; j < 4; ++j) {
                  const int kc = kb * 16 + lq * 4 + j;
                  const bool valid = (kc >= cs) && (kc < cs + 16);
                  const float bias = valid ? bp[kc] : 0.f;
                  s[kb][rb][j] = valid ? (s[kb][rb][j] * a.scale + bias) : -1e30f;
                }
              }
            }
          }
          const float sc = (WV != 0) ? 1.0f : a.scale;
          float mxl[2];
#pragma unroll
          for (int rb = 0; rb < 2; ++rb) {
            float mx = -1e30f;
#pragma unroll
            for (int kb = 0; kb < 4; ++kb) {
              if (!KB_USED(kb, rb)) continue;
#pragma unroll
              for (int j = 0; j < 4; ++j) mx = fmaxf(mx, s[kb][rb][j]);
            }
            mxl[rb] = mx * sc;
          }
          const bool need = (mxl[0] > mrow[0] + 16.0f) || (mxl[1] > mrow[1] + 16.0f);
          if (__builtin_amdgcn_ballot_w64(need) != 0ull) {
#pragma unroll
            for (int rb = 0; rb < 2; ++rb) {
              float mx = mxl[rb];
              mx = fmaxf(mx, __shfl_xor(mx, 16)); mx = fmaxf(mx, __shfl_xor(mx, 32));
              const float mn = fmaxf(mrow[rb], mx); const float alpha = fexp2(mrow[rb] - mn); mrow[rb] = mn;
              lrow[rb] *= alpha;
#pragma unroll
              for (int nb = 0; nb < NB; ++nb) o[nb][rb] *= alpha;
            }
          }
#pragma unroll
          for (int rb = 0; rb < 2; ++rb) {
            const float mn = mrow[rb];
            float rs = 0.f;
#pragma unroll
            for (int kb = 0; kb < 4; ++kb) {
              if (!KB_USED(kb, rb)) { s[kb][rb] = (f32x4){0.f, 0.f, 0.f, 0.f}; continue; }
#pragma unroll
              for (int j = 0; j < 4; ++j) { const float pv = fexp2(fmaf(s[kb][rb][j], sc, -mn)); s[kb][rb][j] = pv; rs += pv; }
            }
            lrow[rb] += rs;
          }
#undef KB_USED
        };
        if (MODE == 1 && ti < a.n0) { if (w & 1) softmax_tile(IntTag<2>{}); else softmax_tile(IntTag<1>{}); }
        else softmax_tile(IntTag<0>{});
      }
      const bf16* vs = Vs + cur * DV * VLD + lr * VLD + lq * 4;
      bf16x8 pf[2][2];
#pragma unroll
      for (int pp = 0; pp < 2; ++pp)
#pragma unroll
        for (int rb = 0; rb < 2; ++rb) {
          u32x4 t; t.x = pack2(s[2 * pp][rb][0], s[2 * pp][rb][1]); t.y = pack2(s[2 * pp][rb][2], s[2 * pp][rb][3]);
          t.z = pack2(s[2 * pp + 1][rb][0], s[2 * pp + 1][rb][1]); t.w = pack2(s[2 * pp + 1][rb][2], s[2 * pp + 1][rb][3]);
          pf[pp][rb] = __builtin_bit_cast(bf16x8, t);
        }
      constexpr int NG = NB / 4, TOT = 2 * NG;
      bf16x8 vbuf[2][4];
#define ATT_LDV(gi_, dst_) do { const int pp_ = (gi_) / NG, nb0_ = ((gi_) % NG) * 4; \
        _Pragma("unroll") for (int q_ = 0; q_ < 4; ++q_) { \
          const uint2 vlo_ = *(const uint2*)(vs + (nb0_ + q_) * 16 * VLD + (2 * pp_) * 16); \
          const uint2 vhi_ = *(const uint2*)(vs + (nb0_ + q_) * 16 * VLD + (2 * pp_ + 1) * 16); \
          u32x4 t_; t_.x = vlo_.x; t_.y = vlo_.y; t_.z = vhi_.x; t_.w = vhi_.y; dst_[q_] = __builtin_bit_cast(bf16x8, t_); } } while (0)
      ATT_LDV(0, vbuf[0]);
#pragma unroll
      for (int gi = 0; gi < TOT; ++gi) {
        if (gi + 1 < TOT) ATT_LDV(gi + 1, vbuf[(gi + 1) & 1]);
        __builtin_amdgcn_sched_barrier(0);
        const int pp = gi / NG, nb0 = (gi % NG) * 4;
        __builtin_amdgcn_s_setprio(1);
#pragma unroll
        for (int q = 0; q < 4; ++q) {
          o[nb0 + q][0] = __builtin_amdgcn_mfma_f32_16x16x32_bf16(vbuf[gi & 1][q], pf[pp][0], o[nb0 + q][0], 0, 0, 0);
          o[nb0 + q][1] = __builtin_amdgcn_mfma_f32_16x16x32_bf16(vbuf[gi & 1][q], pf[pp][1], o[nb0 + q][1], 0, 0, 0);
        }
        __builtin_amdgcn_s_setprio(0);
        __builtin_amdgcn_sched_barrier(0);
      }
#undef ATT_LDV
    }
    __builtin_amdgcn_sched_barrier(0);
    att_store<DV, NV, NL>(Ks, Vs, cur ^ 1, krow, kch, Rs);
    __syncthreads();
  };
  for (int ti = 0; ti < ntiles; ti += 2) {
    step(ti, 0, R1, R0);
    if (ti + 1 < ntiles) step(ti + 1, 1, R0, R1);
  }
  asm volatile("s_waitcnt vmcnt(0)" : "+v"(R0.k0), "+v"(R0.v0), "+v"(R0.v1), "+v"(R1.k0), "+v"(R1.v0), "+v"(R1.v1) : : "memory");
  if (MODE == 2) {
#pragma unroll
    for (int rb = 0; rb < 2; ++rb) {
      float sum = 0.f;
#pragma unroll
      for (int nb = 0; nb < NB; ++nb)
#pragma unroll
        for (int j = 0; j < 4; ++j) sum += o[nb][rb][j];
      sum += __shfl_xor(sum, 16); sum += __shfl_xor(sum, 32);
      const float mean = sum * (1.0f / (float)DV);
      float var = 0.f;
#pragma unroll
      for (int nb = 0; nb < NB; ++nb)
#pragma unroll
        for (int j = 0; j < 4; ++j) { const float d = o[nb][rb][j] - mean; var += d * d; }
      var += __shfl_xor(var, 16); var += __shfl_xor(var, 32);
      const float rstd = rsqrtf(var * (1.0f / (float)DV) + 1e-5f);
      const size_t tok = (size_t)(a.tok0 + w * 32 + rb * 16 + lr);
      uint2 ovs[NB];
#pragma unroll
      for (int nb = 0; nb < NB; ++nb) {
        const int e0 = nb * 16 + lq * 4;
        const uint2 gv = *(const uint2*)(a.gr + tok * 1024 + a.h * DV + e0);
        const float4 gn = *(const float4*)(a.gn + a.h * DV + e0);
        const float g0 = bf2f((unsigned short)(gv.x & 0xffffu)), g1 = bf2f((unsigned short)(gv.x >> 16));
        const float g2 = bf2f((unsigned short)(gv.y & 0xffffu)), g3 = bf2f((unsigned short)(gv.y >> 16));
        uint2 ov;
        ov.x = pack2((o[nb][rb][0] - mean) * rstd * gn.x * silu_f(g0), (o[nb][rb][1] - mean) * rstd * gn.y * silu_f(g1));
        ov.y = pack2((o[nb][rb][2] - mean) * rstd * gn.z * silu_f(g2), (o[nb][rb][3] - mean) * rstd * gn.w * silu_f(g3));
        ovs[nb] = ov;
      }
#pragma unroll
      for (int k = 0; k < NB / 2; ++k) store_pair16(a.out + tok * a.ldo + a.h * DV + 32 * k, lq, ovs[2 * k], ovs[2 * k + 1]);
    }
  } else {
#pragma unroll
    for (int rb = 0; rb < 2; ++rb) {
      float lt = lrow[rb]; lt += __shfl_xor(lt, 16); lt += __shfl_xor(lt, 32);
      const float inv = __builtin_amdgcn_rcpf(lt);
      bf16* op = a.out + (size_t)(w * 32 + rb * 16 + lr) * a.ldo;
      uint2 ovs[NB];
#pragma unroll
      for (int nb = 0; nb < NB; ++nb) { ovs[nb].x = pack2(o[nb][rb][0] * inv, o[nb][rb][1] * inv); ovs[nb].y = pack2(o[nb][rb][2] * inv, o[nb][rb][3] * inv); }
#pragma unroll
      for (int k = 0; k < NB / 2; ++k) store_pair16(op + 32 * k, lq, ovs[2 * k], ovs[2 * k + 1]);
    }
  }
}

DEV int xcd_item(int item, int per) {
  const int g = item / per, i = item - g * per;
  const int sub = per >> 3;
  return g * per + (i & 7) * sub + (i >> 3);
}

DEV void even_attn_args(const Params& p, AttnArgs& a, int item, int& b, int& h, int& seq0, int& tok0, bool& lat) {
  int qt;
  lat = item < 256;
  if (lat) { b = item >> 5; h = (item >> 2) & 7; qt = item & 3; }
  else { const int i2 = item - 256; b = i2 >> 3; h = i2 & 7; qt = 0; }
  seq0 = lat ? 8192 + b * 1024 : b * 256;
  tok0 = seq0 + qt * 256;
  a.n1 = 0; a.n2 = 0; a.k1 = nullptr; a.vt1 = nullptr; a.vt2 = nullptr; a.ldk1 = 0; a.ldvt1 = 0; a.ldvt2 = 0;
  a.r0 = 0; a.lo = 0; a.scale = 0.125f * LOG2E; a.qpos0 = qt * 256; a.seqN = lat ? 1024 : 256; a.lgf = 0.f; a.lgb = 0.f;
  a.gr = nullptr; a.gn = nullptr; a.tok0 = tok0; a.h = h;
}

DEV void even_mixer_phase(const Params& p, unsigned char* smem) {
  unsigned char* ws = p.ws;
  bf16* MO = (bf16*)(ws + OFF_R1);
  for (int item = blockIdx.x; item < 512; item += gridDim.x) {
    const float* lg2 = (const float*)(ws + OFF_LG2);
    bool lat; int b, h, seq0, tok0; AttnArgs a;
    even_attn_args(p, a, xcd_item(item, 256), b, h, seq0, tok0, lat);
    const size_t hb = lat ? (size_t)8192 * 512 + (size_t)(b * 8 + h) * 1024 * 64 : (size_t)(b * 8 + h) * 256 * 64;
    a.q = (const bf16*)(ws + B_QR) + hb + (size_t)a.qpos0 * 64; a.ldq = 64;
    a.k0 = (const bf16*)(ws + B_KR) + hb; a.ldk0 = 64;
    if (lat) { a.vt0 = (const bf16*)(ws + B_VRT) + (size_t)8192 * 1024 + (size_t)(b * 8 + h) * 16 * 8192; a.ldvt0 = 64; a.n0 = 16;
      a.n1 = 1; a.vt1 = (const bf16*)(ws + S0T_F) + (size_t)(b * 8 + h) * 128 * 64; a.ldvt1 = 64;
      a.n2 = 1; a.vt2 = (const bf16*)(ws + S0T_B) + (size_t)(b * 8 + h) * 128 * 64; a.ldvt2 = 64; }
    else { a.vt0 = (const bf16*)(ws + B_VRT) + (size_t)(b * 8 + h) * 4 * 8192; a.ldvt0 = 64; a.n0 = 4; }
    a.lgf = lg2[h]; a.lgb = lg2[8 + h];
    a.gr = (const bf16*)(ws + B_GR); a.gn = p.ret_gn; a.out = MO; a.ldo = 1536;
    attn_item<128, 2>(a, smem, nullptr);
  }
  for (int item = blockIdx.x; item < 512; item += gridDim.x) {
    bool lat; int b, h, seq0, tok0; AttnArgs a;
    even_attn_args(p, a, xcd_item(item, 256), b, h, seq0, tok0, lat);
    const int kvh = h >> 2;
    const size_t hb = lat ? (size_t)8192 * 512 + (size_t)(b * 8 + h) * 1024 * 64 : (size_t)(b * 8 + h) * 256 * 64;
    a.q = (const bf16*)(ws + B_QA) + hb + (size_t)a.qpos0 * 64; a.ldq = 64;
    a.k0 = (const bf16*)(ws + B_KA) + (lat ? (size_t)8192 * 128 + (size_t)(b * 2 + kvh) * 1024 * 64 : (size_t)(b * 2 + kvh) * 256 * 64); a.ldk0 = 64;
    if (lat) { a.vt0 = (const bf16*)(ws + B_VAT) + (size_t)32 * 2 * 64 * 256 + (size_t)(b * 2 + kvh) * 16 * 4096; a.ldvt0 = 64; a.n0 = 16;
      a.n1 = 4; a.k1 = (const bf16*)(ws + CK_GQA) + (size_t)(b * 2 + kvh) * 256 * 64; a.ldk1 = 64;
      a.vt1 = (const bf16*)(ws + CVT_GQA) + (size_t)(b * 2 + kvh) * 64 * 256; a.ldvt1 = 256; }
    else { a.vt0 = (const bf16*)(ws + B_VAT) + (size_t)(b * 2 + kvh) * 4 * 4096; a.ldvt0 = 64; a.n0 = 4; }
    a.out = MO + (size_t)tok0 * 1536 + 1024 + h * 64; a.ldo = 1536;
    attn_item<64, 0>(a, smem, nullptr);
  }
  for (int item = blockIdx.x; item < 256; item += gridDim.x) {
    const int b = item >> 3, h = item & 7;
    gemm_core((const bf16*)(ws + B_KTFB) + (size_t)(b * 8 + h) * 2 * 64 * 256, 256, (const bf16*)(ws + B_VRT) + (size_t)(b * 8 + h) * 4 * 8192, 64, 8192, 256, smem);
    epi_state(p, b, h, (const float*)smem);
  }
}

DEV void odd_mixer_phase(const Params& p, unsigned char* smem) {
  unsigned char* ws = p.ws;
  bf16* MO = (bf16*)(ws + OFF_R1);
  float* rpbs = (float*)(smem + 65536);
  for (int item = blockIdx.x; item < 1024; item += gridDim.x) {
    AttnArgs a;
    a.n1 = 0; a.n2 = 0; a.k1 = nullptr; a.vt1 = nullptr; a.vt2 = nullptr; a.ldk1 = 0; a.ldvt1 = 0; a.ldvt2 = 0;
    a.r0 = 0; a.lo = 0; a.scale = 0.125f * LOG2E; a.qpos0 = 0; a.seqN = 0; a.lgf = 0.f; a.lgb = 0.f;
    a.gr = nullptr; a.gn = nullptr; a.tok0 = 0; a.h = 0;
    if (item < 512) {
      const int it2 = xcd_item(item, 512);
      const int b = it2 >> 6, h = (it2 >> 2) & 15, rq = (it2 & 3) ^ ((item >> 8) & 1); const int r0 = rq * 4;
      int lo = r0 - 4; lo = lo < 0 ? 0 : (lo > 8 ? 8 : lo);
      int hi = r0 + 3 - 4; hi = hi < 0 ? 0 : (hi > 8 ? 8 : hi); hi += 8;
      const int seq0 = 8192 + b * 1024; const int tok0 = seq0 + r0 * 64;
      for (int idx = threadIdx.x; idx < 465; idx += 512) rpbs[idx] = p.na_rpb[h * 465 + idx] * LOG2E;
      const size_t hb = (size_t)8192 * 1024 + (size_t)(b * 16 + h) * 1024 * 64;
      a.q = (const bf16*)(ws + B_Q) + hb + (size_t)r0 * 64 * 64; a.ldq = 64;
      a.k0 = (const bf16*)(ws + B_K) + hb + (size_t)lo * 64 * 64; a.ldk0 = 64;
      a.vt0 = (const bf16*)(ws + B_VT) + (size_t)8192 * 1024 + ((size_t)(b * 16 + h) * 16 + lo) * 4096; a.ldvt0 = 64; a.n0 = hi - lo;
      a.n1 = 4; a.k1 = (const bf16*)(ws + CK_NA) + (size_t)(b * 16 + h) * 256 * 64; a.ldk1 = 64;
      a.vt1 = (const bf16*)(ws + CVT_NA) + (size_t)(b * 16 + h) * 64 * 256; a.ldvt1 = 256;
      a.r0 = r0; a.lo = lo;
      a.out = MO + (size_t)tok0 * 1024 + h * 64; a.ldo = 1024;
      attn_item<64, 1>(a, smem, rpbs);
    } else {
      const int i2 = item - 512; const int b = i2 >> 4, h = i2 & 15;
      const int seq0 = b * 256; const int tok0 = seq0;
      const size_t hb = (size_t)(b * 16 + h) * 256 * 64;
      a.q = (const bf16*)(ws + B_Q) + hb; a.ldq = 64;
      a.k0 = (const bf16*)(ws + B_K) + hb; a.ldk0 = 64;
      a.vt0 = (const bf16*)(ws + B_VT) + (size_t)(b * 16 + h) * 4 * 4096; a.ldvt0 = 64; a.n0 = 4;
      a.out = MO + (size_t)tok0 * 1024 + h * 64; a.ldo = 1024;
      attn_item<64, 0>(a, smem, nullptr);
    }
  }
}

__global__ void __launch_bounds__(512, 2) mega_kernel(Params p) {
  extern __shared__ __attribute__((aligned(16))) unsigned char smem[];
  if (threadIdx.x == 0) *(uint4*)(smem + SMEM_BYTES) = make_uint4(0u, 0u, 0u, 0u);
  __syncthreads();
  XcdBarrier bar = xcd_barrier_post((unsigned*)(p.ws + OFF_BAR), (volatile LAS unsigned*)(smem + SMEM_BYTES));
  unsigned char* ws = p.ws;

  for (int i = blockIdx.x; i < 785; i += gridDim.x) {
    const int old = i < 192 ? i : (i < 432 ? 384 + (i - 192) : (i < 496 ? 624 + (i - 432) : (i < 752 ? 624 + 576 + (i - 496) : (i < 784 ? 1456 + (i - 752) : 1744))));
    p0_item(p, old, smem);
  }
  xcd_barrier(bar);

  {
    float* mod = (float*)(ws + OFF_MOD); const float* mp = (const float*)(ws + OFF_MODP);
    for (int idx = blockIdx.x * 512 + threadIdx.x; idx < 9 * 6144; idx += gridDim.x * 512) {
      const int l = 0, n = idx % 6144;
      float s = p.ada_b[l * 6144 + n];
#pragma unroll
      for (int kq = 0; kq < 8; ++kq) s += mp[(size_t)kq * 110592 + idx];
      mod[idx] = s;
    }
  }
  norm_phase(p, 0, 0, 1, p.norm_mix, p.x_prompt, p.x_sample, true, smem);
  xcd_barrier(bar);

  gemm_phase<0>(p, (const bf16*)(ws + OFF_R1), (const bf16*)(ws + WT_EIN), 1024, 3840, 0, 0, nullptr, nullptr, smem);
  xcd_barrier(bar);
  even_mixer_phase(p, smem);
  xcd_barrier(bar);
  gemm_phase<2>(p, (const bf16*)(ws + OFF_R1), (const bf16*)(ws + WT_EOUT), 1536, 1024, 0, 2 | 16, p.x_prompt, p.x_sample, smem);
  xcd_barrier(bar);
  norm_phase(p, 0, 3, 4, p.norm_ffn, nullptr, nullptr, false, smem);
  xcd_barrier(bar);
  gemm_phase<3>(p, (const bf16*)(ws + OFF_R1), (const bf16*)(ws + WT_UP), 1024, 5632, 0, 0, nullptr, nullptr, smem);
  xcd_barrier(bar);
  {
    float* mod = (float*)(ws + OFF_MOD); const float* mp = (const float*)(ws + OFF_MODP);
    for (int idx = 55296 + blockIdx.x * 512 + threadIdx.x; idx < 2 * 55296; idx += gridDim.x * 512) {
      float sacc = p.ada_b[6144 + idx % 6144];
#pragma unroll
      for (int kq = 0; kq < 8; ++kq) sacc += mp[(size_t)kq * 110592 + idx];
      mod[idx] = sacc;
    }
  }
  gemm_phase<2>(p, (const bf16*)(ws + B_ACT), (const bf16*)(ws + WT_DN), 2816, 1024, 0, 5 | 16, nullptr, nullptr, smem);
  xcd_barrier(bar);

  norm_phase(p, 1, 0, 1, p.norm_mix + 1024, nullptr, nullptr, false, smem);
  xcd_barrier(bar);
  gemm_phase<1>(p, (const bf16*)(ws + OFF_R1), (const bf16*)(ws + WT_OIN), 1024, 3072, 1, 0, nullptr, nullptr, smem);
  xcd_barrier(bar);
  odd_mixer_phase(p, smem);
  xcd_barrier(bar);
  gemm_phase<2>(p, (const bf16*)(ws + OFF_R1), (const bf16*)(ws + WT_OOUT), 1024, 1024, 1, 2 | 16, nullptr, nullptr, smem);
  xcd_barrier(bar);
  norm_phase(p, 1, 3, 4, p.norm_ffn + 1024, nullptr, nullptr, false, smem);
  xcd_barrier(bar);
  gemm_phase<3>(p, (const bf16*)(ws + OFF_R1), (const bf16*)(ws + WT_UP) + (size_t)5632 * 1024, 1024, 5632, 1, 0, nullptr, nullptr, smem);
  xcd_barrier(bar);
  gemm_phase<2>(p, (const bf16*)(ws + B_ACT), (const bf16*)(ws + WT_DN) + (size_t)1024 * 2816, 2816, 1024, 1, 5 | 16, nullptr, nullptr, smem);
  xcd_barrier(bar);

  final_norm_phase(p);
}

extern "C" void kernel_launch(void* const* d_in, const int* in_sizes, int n_in, void* d_out, int out_size, void* d_ws, size_t ws_size,
                              hipStream_t stream) {
  static int grid_blocks = 0;
  if (!grid_blocks) {
    int dev = 0, cus = 0, per_cu = 0;
    hipGetDevice(&dev);
    hipDeviceGetAttribute(&cus, hipDeviceAttributeMultiprocessorCount, dev);
    if (hipFuncSetAttribute((const void*)mega_kernel, hipFuncAttributeMaxDynamicSharedMemorySize, LDS_TOTAL) != hipSuccess) fprintf(stderr, "hipFuncSetAttribute failed\n");
    hipOccupancyMaxActiveBlocksPerMultiprocessor(&per_cu, mega_kernel, 512, LDS_TOTAL);
    (void)hipGetLastError();
    if (per_cu > 1) per_cu = 1;
    if (per_cu < 1) per_cu = 1;
    grid_blocks = cus * per_cu;
    if (grid_blocks % 8) grid_blocks -= grid_blocks % 8;
  }
  if (ws_size < (size_t)WS_NEEDED) fprintf(stderr, "workspace too small: %zu < %llu\n", ws_size, (unsigned long long)WS_NEEDED);
  Params p{};
  const float** pp = (const float**)&p;
  for (int i = 0; i < 29; ++i) pp[i] = (const float*)d_in[i];
  p.out = (float*)d_out;
  p.ws = (unsigned char*)d_ws;
  hipMemsetAsync(d_ws, 0, XCD_BAR_WORDS * 4, stream);
  void* args[] = {&p};
  hipError_t e = hipLaunchCooperativeKernel((void*)mega_kernel, dim3(grid_blocks), dim3(512), args, LDS_TOTAL, stream);
  if (e != hipSuccess) fprintf(stderr, "cooperative launch failed: %s (grid %d)\n", hipGetErrorString(e), grid_blocks);
}
```
